# Optimizing an MI355X kernel written in HIP

```python
import math, functools
import jax, jax.numpy as jnp
from jax import lax
import numpy as np

D_MODEL = 1024
BATCH = 4
SEQ = 8192
DEPTH = 1

N_ATT_HEADS = 8
HEAD_DIM = 64
ATT_WIDTH = N_ATT_HEADS * HEAD_DIM
CONV_WIDTH = 512
MIX_WIDTH = ATT_WIDTH + CONV_WIDTH
IN_PROJ_WIDTH = 3 * ATT_WIDTH + 3 * CONV_WIDTH
DILATED_PATTERNS = ((128, 1), (512, 4), (2048, 16))
ATT_BLOCK = 128
ROPE_THETA = 10000.0
CONV_TAPS = 3
N_EXPERTS = 32
TOP_K = 4
D_FF_EXPERT = 1024
SWIGLU_ALPHA = 1.702
SWIGLU_LIMIT = 7.0
MOE_BLOCK = 128
NORM_EPS = 1e-5

kernel_name = "hybrid_dilated_attn_shortconv_moe"


def rms_norm(x, g):
    xf = x.astype(jnp.float32)
    y = xf * lax.rsqrt(jnp.mean(xf * xf, axis=-1, keepdims=True) + NORM_EPS)
    return (y * g.astype(jnp.float32)).astype(x.dtype)


def rotary(t):
    S, hd = t.shape[1], t.shape[3]
    inv_freq = 1.0 / (ROPE_THETA ** (jnp.arange(0, hd, 2, dtype=jnp.float32) / hd))
    ang = jnp.arange(S, dtype=jnp.float32)[:, None] * inv_freq[None, :]
    cos = jnp.concatenate([jnp.cos(ang), jnp.cos(ang)], axis=-1)[None, :, None, :]
    sin = jnp.concatenate([jnp.sin(ang), jnp.sin(ang)], axis=-1)[None, :, None, :]
    tf = t.astype(jnp.float32)
    t1, t2 = tf[..., : hd // 2], tf[..., hd // 2:]
    rot = jnp.concatenate([-t2, t1], axis=-1)
    return (tf * cos + rot * sin).astype(t.dtype)


def strided_window_attention(q, k, v, dil, n_taps):
    Bsz, S, H, hd = q.shape
    BLK = ATT_BLOCK
    L = S // dil
    nb = -(-L // BLK)
    Lp = nb * BLK

    def classes(t):
        return t.reshape(Bsz, L, dil, H, hd).transpose(0, 2, 3, 1, 4)

    qc, kc, vc = classes(q), classes(k), classes(v)
    qb = jnp.pad(qc, ((0, 0), (0, 0), (0, 0), (0, Lp - L), (0, 0))).reshape(Bsz, dil, H, nb, BLK, hd)

    def band(t):
        tp = jnp.pad(t, ((0, 0), (0, 0), (0, 0), (BLK, Lp - L), (0, 0)))
        prev = tp[:, :, :, :Lp].reshape(Bsz, dil, H, nb, BLK, hd)
        cur = tp[:, :, :, BLK:].reshape(Bsz, dil, H, nb, BLK, hd)
        return jnp.concatenate([prev, cur], axis=4)

    kb, vb = band(kc), band(vc)
    s = jnp.einsum('brhnqd,brhnkd->brhnqk', qb.astype(jnp.float32), kb.astype(jnp.float32)) * (hd ** -0.5)
    qi = jnp.arange(BLK)[:, None]
    kj = jnp.arange(2 * BLK)[None, :]
    dist = qi - kj + BLK
    kpos = jnp.arange(nb)[:, None, None] * BLK - BLK + kj[None]
    valid = (dist >= 0) & (dist < n_taps) & (kpos >= 0)
    s = jnp.where(valid, s, -jnp.inf)
    lse = jax.nn.logsumexp(s, axis=-1)
    p = jnp.exp(s - lse[..., None])
    o = jnp.einsum('brhnqk,brhnkd->brhnqd', p, vb.astype(jnp.float32))
    o = o.reshape(Bsz, dil, H, Lp, hd)[:, :, :, :L].transpose(0, 3, 1, 2, 4).reshape(Bsz, S, H, hd)
    lse = lse.reshape(Bsz, dil, H, Lp)[..., :L].transpose(0, 3, 1, 2).reshape(Bsz, S, H)
    return o, lse


def hybrid_mixer(hn, w_in, attn_g, conv_w, conv_g, w_out):
    Bsz, S, _ = hn.shape
    proj = hn @ w_in
    q, k, v, u, gate_b, gate_c = jnp.split(proj, 6, axis=-1)
    q = rotary(q.reshape(Bsz, S, N_ATT_HEADS, HEAD_DIM))
    k = rotary(k.reshape(Bsz, S, N_ATT_HEADS, HEAD_DIM))
    v = v.reshape(Bsz, S, N_ATT_HEADS, HEAD_DIM)
    outs, lses = [], []
    for window, dil in DILATED_PATTERNS:
        o, l = strided_window_attention(q, k, v, dil, window // dil + 1)
        outs.append(o)
        lses.append(l)
    mix_w = jax.nn.softmax(jnp.stack(lses), axis=0)
    attn = jnp.einsum('pbsh,pbshd->bshd', mix_w, jnp.stack(outs))
    attn = attn.reshape(Bsz, S, ATT_WIDTH).astype(hn.dtype)

    z = gate_c * u
    zp = jnp.pad(z, ((0, 0), (CONV_TAPS - 1, 0), (0, 0)))
    c = zp[:, 0:S] * conv_w[0] + zp[:, 1:S + 1] * conv_w[1] + zp[:, 2:S + 2] * conv_w[2]
    conv_out = gate_b * c

    mixed = jnp.concatenate([rms_norm(attn, attn_g), rms_norm(conv_out, conv_g)], axis=-1)
    return mixed @ w_out


def moe_ffn(h, w_router, b_router, w_gu, b_gu, w_dn, b_dn):
    Bsz, S, D = h.shape
    T = Bsz * S
    BLK = MOE_BLOCK
    xt = h.reshape(T, D)
    logits = (xt @ w_router + b_router).astype(jnp.float32)
    top_val, top_idx = lax.top_k(logits, TOP_K)
    gates = jax.nn.softmax(top_val, axis=-1)
    M = T * TOP_K
    flat_e = top_idx.reshape(M)
    flat_tok = jnp.arange(M, dtype=jnp.int32) // TOP_K
    flat_g = gates.reshape(M)
    order = jnp.argsort(flat_e)
    se, stok, sg = flat_e[order], flat_tok[order], flat_g[order]
    counts = jnp.bincount(flat_e, length=N_EXPERTS)
    starts = jnp.cumsum(counts) - counts
    pcounts = (counts + BLK - 1) // BLK * BLK
    pends = jnp.cumsum(pcounts)
    pstarts = pends - pcounts
    dest = pstarts[se] + (jnp.arange(M) - starts[se])
    NB = (M + BLK - 1) // BLK + N_EXPERTS
    P = NB * BLK
    row_tok = jnp.full((P,), T, dtype=jnp.int32).at[dest].set(stok)
    row_gate = jnp.zeros((P,), jnp.float32).at[dest].set(sg)
    blk_e = jnp.minimum(jnp.searchsorted(pends, jnp.arange(NB) * BLK, side='right'), N_EXPERTS - 1)
    x_pad = jnp.concatenate([xt, jnp.zeros((1, D), xt.dtype)], axis=0)
    xb = x_pad[row_tok].reshape(NB, BLK, D)

    def expert_block(args):
        xblk, e = args
        gu = xblk @ w_gu[e] + b_gu[e]
        g, up = gu[:, :D_FF_EXPERT], gu[:, D_FF_EXPERT:]
        g = jnp.minimum(g, SWIGLU_LIMIT)
        up = jnp.clip(up, -SWIGLU_LIMIT, SWIGLU_LIMIT)
        act = (up + 1.0) * (g * jax.nn.sigmoid(SWIGLU_ALPHA * g))
        return act @ w_dn[e] + b_dn[e]

    yb = lax.map(expert_block, (xb, blk_e)).reshape(P, D)
    y = jnp.zeros((T + 1, D), h.dtype).at[row_tok].add(yb * row_gate[:, None].astype(h.dtype))
    return y[:T].reshape(Bsz, S, D)


def setup_inputs(seed: int = 0) -> dict:
    key = jax.random.key(seed)
    ks = jax.random.split(key, 16)
    f32 = jnp.float32
    def nrm(k, shape, scale):
        return jax.random.normal(k, shape, f32) * scale
    return {
        "x": nrm(ks[0], (BATCH, SEQ, D_MODEL), 1.0),
        "norm1_g": 1.0 + nrm(ks[1], (DEPTH, D_MODEL), 0.01),
        "w_mix_in": nrm(ks[2], (DEPTH, D_MODEL, IN_PROJ_WIDTH), D_MODEL ** -0.5),
        "attn_norm_g": 1.0 + nrm(ks[3], (DEPTH, ATT_WIDTH), 0.01),
        "conv_w": nrm(ks[4], (DEPTH, CONV_TAPS, CONV_WIDTH), CONV_TAPS ** -0.5),
        "conv_norm_g": 1.0 + nrm(ks[5], (DEPTH, CONV_WIDTH), 0.01),
        "w_mix_out": nrm(ks[6], (DEPTH, MIX_WIDTH, D_MODEL), MIX_WIDTH ** -0.5),
        "norm2_g": 1.0 + nrm(ks[7], (DEPTH, D_MODEL), 0.01),
        "w_router": nrm(ks[8], (DEPTH, D_MODEL, N_EXPERTS), D_MODEL ** -0.5),
        "b_router": nrm(ks[9], (DEPTH, N_EXPERTS), 0.01),
        "w_gate_up": nrm(ks[10], (DEPTH, N_EXPERTS, D_MODEL, 2 * D_FF_EXPERT), D_MODEL ** -0.5),
        "b_gate_up": nrm(ks[11], (DEPTH, N_EXPERTS, 2 * D_FF_EXPERT), 0.01),
        "w_down": nrm(ks[12], (DEPTH, N_EXPERTS, D_FF_EXPERT, D_MODEL), D_FF_EXPERT ** -0.5),
        "b_down": nrm(ks[13], (DEPTH, N_EXPERTS, D_MODEL), 0.01),
        "final_norm_g": 1.0 + nrm(ks[14], (D_MODEL,), 0.01),
    }


def reference(x, norm1_g, w_mix_in, attn_norm_g, conv_w, conv_norm_g, w_mix_out,
              norm2_g, w_router, b_router, w_gate_up, b_gate_up, w_down, b_down,
              final_norm_g):
    h = x
    for layer in range(DEPTH):
        hn = rms_norm(h, norm1_g[layer])
        h = h + hybrid_mixer(hn, w_mix_in[layer], attn_norm_g[layer], conv_w[layer],
                             conv_norm_g[layer], w_mix_out[layer])
        hn = rms_norm(h, norm2_g[layer])
        h = h + moe_ffn(hn, w_router[layer], b_router[layer], w_gate_up[layer],
                        b_gate_up[layer], w_down[layer], b_down[layer])
    return rms_norm(h, final_norm_g)
```

```cpp
#include <hip/hip_runtime.h>
#include <hip/hip_bf16.h>
#include <cstdio>
#include <cstdint>
#include <cmath>

#define MK_N_LAUNCHES 10
#ifndef MK_N_LAUNCHES
#define MK_N_LAUNCHES 1
#endif

constexpr int BATCH = 4, SEQ = 8192, DM = 1024, T = BATCH * SEQ;
constexpr int NH = 8, HD = 64, AW = 512, NPROJ = 3072;
constexpr int NE = 32, TOPK = 4, FF = 1024;
constexpr int MASSIGN = T * TOPK;
constexpr int PMAX = MASSIGN + NE * 256;
constexpr int MAXTILES = PMAX / 256;
constexpr float NORM_EPS = 1e-5f;
constexpr float QSCALE = 0.125f * 1.4426950408889634f;

namespace pg8 {
#define PG8_LAS __attribute__((address_space(3)))
typedef unsigned short bf16_t;
typedef short bf16x8 __attribute__((ext_vector_type(8)));
typedef float f32x4 __attribute__((ext_vector_type(4)));
typedef unsigned u32x4 __attribute__((ext_vector_type(4)));
constexpr int BM = 256, BK = 64, HALF = 128, HTB = HALF * BK * 2  , STAGE_BYTES = 8 * HTB, NXCD = 8, WGM = 8;

__host__ __device__ __forceinline__ int lds_byte(int r, int c) { const int st = (r >> 4) * 2 + (c >> 5), rr = r & 15, cc = c & 31, ob = rr * 64 + cc * 2; return st * 1024 + (ob ^ (((ob >> 9) & 1) << 5)); }
__host__ __device__ __forceinline__ void stage_rc(int b, int& R, int& C) { const int st = b / 1024, sb = b % 1024, swz = sb ^ (((sb >> 9) & 1) << 5); R = (st >> 1) * 16 + swz / 64; C = (st & 1) * 32 + (swz % 64) / 2; }
__host__ __device__ __forceinline__ int perm32(int rho) { const int n = rho >> 4, i = rho & 15; return 8 * (i >> 2) + 4 * n + (i & 3); }

struct Unit { int pm, pn; };
struct Gemm { const bf16_t* A; const bf16_t* Bt; int M, N, K; };

struct StaticOrder {
    int nM, nN, nwg, G, c;
    __host__ __device__ void init(int M, int N, int G_, int c_) { nM = M / BM; nN = N / BM; nwg = nM * nN; G = G_; c = c_; }
    __host__ __device__ bool next(int i, Unit& u) const {
        const long L = (long)i * G + c; if (L >= nwg) return false;
        int wgid = (int)L; { const int q = nwg / NXCD, r = nwg % NXCD, xcd = wgid % NXCD, off = wgid / NXCD; wgid = (xcd < r ? xcd * (q + 1) : r * (q + 1) + (xcd - r) * q) + off; }
        const int nig = WGM * nN, gid = wgid / nig, fm = gid * WGM, gsz = (nM - fm) < WGM ? (nM - fm) : WGM;
        u.pm = fm + ((wgid % nig) % gsz); u.pn = (wgid % nig) / gsz; return true;
    }
    __device__ __forceinline__ void a_ready(const Unit&) const {}
    __device__ __forceinline__ void done(const Unit&) const {}
};

__device__ __forceinline__ unsigned cvt_pk_bf16(float lo, float hi) { unsigned r; asm volatile("v_cvt_pk_bf16_f32 %0, %1, %2" : "=v"(r) : "v"(lo), "v"(hi)); return r; }
typedef float f32x2 __attribute__((ext_vector_type(2)));
__device__ __forceinline__ f32x2 gelu_pk(f32x2 v) {
    const f32x2 av = __builtin_elementwise_abs(v), d = av * 0.2316418882f + 1.0f;
    f32x2 t; t.x = __builtin_amdgcn_rcpf(d.x); t.y = __builtin_amdgcn_rcpf(d.y);
    f32x2 q = t * 0.5307027145f + (-0.7265760135f); q = q * t + 0.7107068705f; q = q * t + (-0.142248368f); q = q * t + 0.127414796f; q = q * t;
    const f32x2 s = (v * v) * (-0.72134752044f);
    f32x2 e; e.x = __builtin_amdgcn_exp2f(s.x); e.y = __builtin_amdgcn_exp2f(s.y);
    const f32x2 m = v * (q * e), r = v - m;
    f32x2 o; o.x = v.x < 0.f ? m.x : r.x; o.y = v.y < 0.f ? m.y : r.y; return o;
}

template <int ACT  > struct EpiBf16 {
    static constexpr bool PERM = true, AFTER_DRAIN = false; static_assert(ACT == 0 || ACT == 1, "EpiBf16: ACT is 0 (none) or 1 (gelu_pk)");
    bf16_t* O; int ldc; const float* bias; int split_cols; size_t split_stride; float scale0;
    __device__ __forceinline__ void operator()(const f32x4 (&acc)[2][2][4][2], const Unit& u, int wr, int wc, int fr, int fq) const {
        const int row0 = u.pm * BM + wr * 64 + fr; int colt = u.pn * BM; bf16_t* base = O;
        float sc = 1.f; if (split_cols) { const int t = colt / split_cols; base += (size_t)t * split_stride; colt -= t * split_cols; if (t == 0) sc = scale0; }
        const int col0 = colt + wc * 32 + 8 * fq, bcol0 = u.pn * BM + wc * 32 + 8 * fq;
        f32x4 bv[2][2];
#pragma unroll
        for (int bj = 0; bj < 2; ++bj)
#pragma unroll
            for (int n = 0; n < 2; ++n) bv[bj][n] = bias ? *(const f32x4*)(bias + bcol0 + bj * HALF + 4 * n) : (f32x4){0.f, 0.f, 0.f, 0.f};
#pragma unroll
        for (int ai = 0; ai < 2; ++ai)
#pragma unroll
            for (int m = 0; m < 4; ++m) { bf16_t* rowp = base + (size_t)(row0 + ai * HALF + m * 16) * ldc + col0;
#pragma unroll
                for (int bj = 0; bj < 2; ++bj) { f32x4 v0 = acc[ai][bj][m][0] + bv[bj][0], v1 = acc[ai][bj][m][1] + bv[bj][1];
                    if (ACT == 1) { f32x2 a = gelu_pk((f32x2){v0[0], v0[1]}), b = gelu_pk((f32x2){v0[2], v0[3]}), c = gelu_pk((f32x2){v1[0], v1[1]}), d = gelu_pk((f32x2){v1[2], v1[3]});
                        v0 = (f32x4){a.x, a.y, b.x, b.y}; v1 = (f32x4){c.x, c.y, d.x, d.y}; }
                    v0 = v0 * sc; v1 = v1 * sc; u32x4 w; w.x = cvt_pk_bf16(v0[0], v0[1]); w.y = cvt_pk_bf16(v0[2], v0[3]); w.z = cvt_pk_bf16(v1[0], v1[1]); w.w = cvt_pk_bf16(v1[2], v1[3]);
                    *(u32x4*)(rowp + bj * HALF) = w; } }
    }
};

typedef unsigned u32x4_t __attribute__((ext_vector_type(4)));
struct EpiQKV {
    static constexpr bool PERM = true, AFTER_DRAIN = false;
    bf16_t* out; const float* cs; size_t bufstride;
    __device__ __forceinline__ void operator()(const f32x4 (&acc)[2][2][4][2], const Unit& u, int wr, int wc, int fr, int fq) const {
        const int buf = u.pn >> 1; bf16_t* base = out + (size_t)buf * bufstride;
        const int row0 = u.pm * BM + wr * 64 + fr;
        if (u.pn < 4) {
            const float sc = (u.pn < 2) ? 0.125f * 1.4426950408889634f : 1.0f;
            const int head = (u.pn & 1) * 4 + wc;
#pragma unroll
            for (int ai = 0; ai < 2; ++ai)
#pragma unroll
                for (int m = 0; m < 4; ++m) {
                    const int row = row0 + ai * HALF + m * 16; const int pos = row & 8191;
                    const f32x4* cp = (const f32x4*)(cs + (size_t)pos * 64 + fq * 16);
                    const f32x4 c0 = cp[0], c1 = cp[1], c2 = cp[2], c3 = cp[3];
                    const f32x4 lo0 = acc[ai][0][m][0], lo1 = acc[ai][0][m][1], hi0 = acc[ai][1][m][0], hi1 = acc[ai][1][m][1];
                    float ol[8], oh[8];
                    ol[0] = lo0[0] * c0[0] - hi0[0] * c0[1]; oh[0] = hi0[0] * c0[0] + lo0[0] * c0[1];
                    ol[1] = lo0[1] * c0[2] - hi0[1] * c0[3]; oh[1] = hi0[1] * c0[2] + lo0[1] * c0[3];
                    ol[2] = lo0[2] * c1[0] - hi0[2] * c1[1]; oh[2] = hi0[2] * c1[0] + lo0[2] * c1[1];
                    ol[3] = lo0[3] * c1[2] - hi0[3] * c1[3]; oh[3] = hi0[3] * c1[2] + lo0[3] * c1[3];
                    ol[4] = lo1[0] * c2[0] - hi1[0] * c2[1]; oh[4] = hi1[0] * c2[0] + lo1[0] * c2[1];
                    ol[5] = lo1[1] * c2[2] - hi1[1] * c2[3]; oh[5] = hi1[1] * c2[2] + lo1[1] * c2[3];
                    ol[6] = lo1[2] * c3[0] - hi1[2] * c3[1]; oh[6] = hi1[2] * c3[0] + lo1[2] * c3[1];
                    ol[7] = lo1[3] * c3[2] - hi1[3] * c3[3]; oh[7] = hi1[3] * c3[2] + lo1[3] * c3[3];
                    u32x4_t wl, wh;
                    wl.x = cvt_pk_bf16(ol[0] * sc, ol[1] * sc); wl.y = cvt_pk_bf16(ol[2] * sc, ol[3] * sc); wl.z = cvt_pk_bf16(ol[4] * sc, ol[5] * sc); wl.w = cvt_pk_bf16(ol[6] * sc, ol[7] * sc);
                    wh.x = cvt_pk_bf16(oh[0] * sc, oh[1] * sc); wh.y = cvt_pk_bf16(oh[2] * sc, oh[3] * sc); wh.z = cvt_pk_bf16(oh[4] * sc, oh[5] * sc); wh.w = cvt_pk_bf16(oh[6] * sc, oh[7] * sc);
                    bf16_t* rowp = base + (size_t)row * 512 + head * 64 + 8 * fq;
                    *(u32x4_t*)(rowp) = wl; *(u32x4_t*)(rowp + 32) = wh;
                }
        } else {
            const int col0 = (u.pn & 1) * 256 + wc * 32 + 8 * fq;
#pragma unroll
            for (int ai = 0; ai < 2; ++ai)
#pragma unroll
                for (int m = 0; m < 4; ++m) { bf16_t* rowp = base + (size_t)(row0 + ai * HALF + m * 16) * 512 + col0;
#pragma unroll
                    for (int bj = 0; bj < 2; ++bj) { const f32x4 v0 = acc[ai][bj][m][0], v1 = acc[ai][bj][m][1];
                        u32x4_t w; w.x = cvt_pk_bf16(v0[0], v0[1]); w.y = cvt_pk_bf16(v0[2], v0[3]); w.z = cvt_pk_bf16(v1[0], v1[1]); w.w = cvt_pk_bf16(v1[2], v1[3]);
                        *(u32x4_t*)(rowp + bj * HALF) = w; } }
        }
    }
};
struct EpiRes {
    static constexpr bool PERM = true, AFTER_DRAIN = false;
    const float* x; float* out;
    __device__ __forceinline__ void operator()(const f32x4 (&acc)[2][2][4][2], const Unit& u, int wr, int wc, int fr, int fq) const {
        const int row0 = u.pm * BM + wr * 64 + fr, col0 = u.pn * BM + wc * 32 + 8 * fq;
#pragma unroll
        for (int ai = 0; ai < 2; ++ai)
#pragma unroll
            for (int m = 0; m < 4; ++m) { const size_t off = (size_t)(row0 + ai * HALF + m * 16) * 1024 + col0;
#pragma unroll
                for (int bj = 0; bj < 2; ++bj) { const f32x4 x0 = *(const f32x4*)(x + off + bj * HALF), x1 = *(const f32x4*)(x + off + bj * HALF + 4);
                    *(f32x4*)(out + off + bj * HALF) = x0 + acc[ai][bj][m][0]; *(f32x4*)(out + off + bj * HALF + 4) = x1 + acc[ai][bj][m][1]; } }
    }
};
struct EpiSwiGLU {
    static constexpr bool PERM = true, AFTER_DRAIN = false;
    bf16_t* act; const float* bgu;
    __device__ __forceinline__ void operator()(const f32x4 (&acc)[2][2][4][2], const Unit& u, int wr, int wc, int fr, int fq) const {
        const int e = u.pn >> 3, pnl = u.pn & 7, f0 = 128 * pnl + 32 * wc + 8 * fq;
        const int row0 = u.pm * BM + wr * 64 + fr;
        f32x4 bg[2], bu[2];
#pragma unroll
        for (int n = 0; n < 2; ++n) { bg[n] = *(const f32x4*)(bgu + (size_t)e * 2048 + f0 + 4 * n); bu[n] = *(const f32x4*)(bgu + (size_t)e * 2048 + 1024 + f0 + 4 * n); }
#pragma unroll
        for (int ai = 0; ai < 2; ++ai)
#pragma unroll
            for (int m = 0; m < 4; ++m) {
                float o[8];
#pragma unroll
                for (int n = 0; n < 2; ++n) { const f32x4 gv = acc[ai][0][m][n] + bg[n], uv = acc[ai][1][m][n] + bu[n];
#pragma unroll
                    for (int j = 0; j < 4; ++j) { const float g = fminf(gv[j], 7.0f); const float up = fminf(fmaxf(uv[j], -7.0f), 7.0f);
                        const float sg = __builtin_amdgcn_rcpf(1.0f + __builtin_amdgcn_exp2f(-1.702f * 1.4426950408889634f * g));
                        o[4 * n + j] = (up + 1.0f) * (g * sg); } }
                u32x4_t w; w.x = cvt_pk_bf16(o[0], o[1]); w.y = cvt_pk_bf16(o[2], o[3]); w.z = cvt_pk_bf16(o[4], o[5]); w.w = cvt_pk_bf16(o[6], o[7]);
                *(u32x4_t*)(act + (size_t)(row0 + ai * HALF + m * 16) * 1024 + f0) = w;
            }
    }
};
struct MoeOrder {
    int ntiles, npn, nwg, G, c; const __attribute__((address_space(3))) int* texp;
    __device__ void init(int ntiles_, int npn_, int G_, int c_, const __attribute__((address_space(3))) int* texp_) { ntiles = ntiles_; npn = npn_; nwg = ntiles_ * npn_; G = G_; c = c_; texp = texp_; }
    __device__ bool next(int i, Unit& u) const {
        const long L = (long)i * G + c; if (L >= nwg) return false;
        int wgid = (int)L; { const int q = nwg / NXCD, r = nwg % NXCD, xcd = wgid % NXCD, off = wgid / NXCD; wgid = (xcd < r ? xcd * (q + 1) : r * (q + 1) + (xcd - r) * q) + off; }
        const int nig = WGM * npn, gid = wgid / nig, fm = gid * WGM, gsz = (ntiles - fm) < WGM ? (ntiles - fm) : WGM;
        const int t = fm + ((wgid % nig) % gsz), pnl = (wgid % nig) / gsz;
        const int e = texp[t];
        u.pm = t; u.pn = e * npn + pnl; return true;
    }
    __device__ __forceinline__ void a_ready(const Unit&) const {}
    __device__ __forceinline__ void done(const Unit&) const {}
};
template <class Epi, class Sched, bool ALIGN_EPI = false, bool SP2 = false>
__device__ __forceinline__ void gemm_phase(PG8_LAS unsigned char* lds, const Gemm g, const Sched& S, const Epi& E) {
    const int tid = threadIdx.x, wid = __builtin_amdgcn_readfirstlane(tid >> 6), lane = tid & 63, wr = wid >> 2, wc = wid & 3, fr = lane & 15, fq = lane >> 4;
    const int K = g.K, nt = K / BK;
    unsigned voffA[2], voffB[2];
#pragma unroll
    for (int i = 0; i < 2; ++i) { int R, C; stage_rc(tid * 16 + i * 8192, R, C); const int Rb = Epi::PERM ? ((R & ~31) + perm32(R & 31)) : R;
        voffA[i] = (unsigned)(R * K + C) * 2u; voffB[i] = (unsigned)(Rb * K + C) * 2u; }
    const size_t kstep = (size_t)(BK * 2);
    const size_t hstep = (size_t)HALF * K * 2;
    const size_t tstep = 2 * hstep;
    const unsigned ldsw = (unsigned)wid * 1024u;
    const int aoff = lds_byte(wr * 64 + fr, fq * 8), boff = lds_byte(wc * 32 + fr, fq * 8);
#define PG8_SA(b, h) (((b) * 2 + (h)) * HTB)
#define PG8_SB(b, h) ((4 + (b) * 2 + (h)) * HTB)
#define PG8_STAGE(bufoff, gbase, voff) do { _Pragma("unroll") for (int _i = 0; _i < 2; ++_i) \
        __builtin_amdgcn_global_load_lds((const unsigned*)((const char*)(gbase) + (voff)[_i]), (PG8_LAS unsigned*)(lds + (bufoff) + ldsw + _i * 8192), 16, 0, 0); } while (0)
#define PG8_LDA(dst, b, h) do { _Pragma("unroll") for (int m = 0; m < 4; ++m) _Pragma("unroll") for (int k = 0; k < 2; ++k) dst[m][k] = *(const PG8_LAS bf16x8*)(lds + PG8_SA(b, h) + aoff + m * 2048 + k * 1024); } while (0)
#define PG8_LDB(dst, b, h) do { _Pragma("unroll") for (int n = 0; n < 2; ++n) _Pragma("unroll") for (int k = 0; k < 2; ++k) dst[n][k] = *(const PG8_LAS bf16x8*)(lds + PG8_SB(b, h) + boff + n * 2048 + k * 1024); } while (0)
#define PG8_MMA(ai, bj, At, Bt) do { __builtin_amdgcn_s_setprio(1); _Pragma("unroll") for (int m = 0; m < 4; ++m) _Pragma("unroll") for (int n = 0; n < 2; ++n) _Pragma("unroll") for (int k = 0; k < 2; ++k) \
        acc[ai][bj][m][n] = __builtin_amdgcn_mfma_f32_16x16x32_bf16(Bt[n][k], At[m][k], acc[ai][bj][m][n], 0, 0, 0); __builtin_amdgcn_s_setprio(0); } while (0)
#define PG8_WAIT_V(n) asm volatile("s_waitcnt vmcnt(" #n ")" ::: "memory")
#define PG8_WAIT_L(n) asm volatile("s_waitcnt lgkmcnt(" #n ")" ::: "memory")
#define PG8_BAR __builtin_amdgcn_s_barrier()
#define PG8_SCHED __builtin_amdgcn_sched_barrier(0)
    Unit cur, nxt; int ui = 0;
    if (!S.next(0, cur)) return;
    f32x4 acc[2][2][4][2];
#pragma unroll
    for (int a = 0; a < 2; ++a)
#pragma unroll
        for (int b = 0; b < 2; ++b)
#pragma unroll
            for (int m = 0; m < 4; ++m)
#pragma unroll
                for (int n = 0; n < 2; ++n) acc[a][b][m][n] = (f32x4){0.f, 0.f, 0.f, 0.f};
    bf16x8 At[4][2], B0[2][2], B1[2][2];
    const char* cA = (const char*)g.A + (size_t)cur.pm * tstep; const char* cB = (const char*)g.Bt + (size_t)cur.pn * tstep;
    S.a_ready(cur);
    if constexpr (SP2) {
        PG8_STAGE(PG8_SB(0, 0), cB, voffB); PG8_STAGE(PG8_SB(0, 1), cB + hstep, voffB); PG8_STAGE(PG8_SA(0, 0), cA, voffA); PG8_STAGE(PG8_SA(0, 1), cA + hstep, voffA);
        if (wr == 1) PG8_BAR;
        PG8_WAIT_V(2); PG8_BAR;
        PG8_STAGE(PG8_SB(1, 0), cB + kstep, voffB); PG8_STAGE(PG8_SA(1, 0), cA + kstep, voffA); PG8_STAGE(PG8_SB(1, 1), cB + hstep + kstep, voffB);
        PG8_WAIT_V(6); PG8_BAR;
    } else {
        PG8_STAGE(PG8_SB(0, 0), cB, voffB); PG8_STAGE(PG8_SA(0, 0), cA, voffA); PG8_STAGE(PG8_SB(0, 1), cB + hstep, voffB); PG8_STAGE(PG8_SA(0, 1), cA + hstep, voffA);
        if (wr == 1) PG8_BAR;
        PG8_WAIT_V(4); PG8_BAR;
        PG8_STAGE(PG8_SB(1, 0), cB + kstep, voffB); PG8_STAGE(PG8_SA(1, 0), cA + kstep, voffA); PG8_STAGE(PG8_SB(1, 1), cB + hstep + kstep, voffB);
        PG8_WAIT_V(6); PG8_BAR;
    }
    for (;;) {
        const bool has_next = S.next(ui + 1, nxt);
        const char* nA = has_next ? (const char*)g.A + (size_t)nxt.pm * tstep : cA; const char* nB = has_next ? (const char*)g.Bt + (size_t)nxt.pn * tstep : cB;
        for (int t = 0; t < nt; t += 2) {
            const bool last = (t == nt - 2);
            const char* a1 = cA + (size_t)(t + 1) * kstep;
            const char* a2 = last ? nA : cA + (size_t)(t + 2) * kstep; const char* b2 = last ? nB : cB + (size_t)(t + 2) * kstep;
            const char* a3 = a2 + kstep; const char* b3 = b2 + kstep;
            if (last && has_next) S.a_ready(nxt);
            if constexpr (SP2) {
            PG8_LDB(B0, 0, 0); PG8_LDB(B1, 0, 1); PG8_SCHED; PG8_LDA(At, 0, 0); PG8_STAGE(PG8_SA(1, 1), a1 + hstep, voffA);
            PG8_WAIT_V(8); PG8_WAIT_L(0); PG8_BAR; PG8_MMA(0, 0, At, B0); PG8_MMA(0, 1, At, B1); PG8_BAR; PG8_SCHED;
            PG8_LDA(At, 0, 1); PG8_STAGE(PG8_SB(0, 0), b2, voffB); PG8_STAGE(PG8_SB(0, 1), b2 + hstep, voffB); PG8_STAGE(PG8_SA(0, 0), a2, voffA);
            PG8_WAIT_V(8); PG8_WAIT_L(0); PG8_BAR; PG8_MMA(1, 0, At, B0); PG8_MMA(1, 1, At, B1); PG8_BAR; PG8_SCHED;
            PG8_LDB(B0, 1, 0); PG8_LDB(B1, 1, 1); PG8_SCHED; PG8_LDA(At, 1, 0); PG8_STAGE(PG8_SA(0, 1), a2 + hstep, voffA);
            PG8_WAIT_V(8); PG8_WAIT_L(0); PG8_BAR; PG8_MMA(0, 0, At, B0); PG8_MMA(0, 1, At, B1); PG8_BAR; PG8_SCHED;
            PG8_LDA(At, 1, 1); PG8_STAGE(PG8_SB(1, 0), b3, voffB); PG8_STAGE(PG8_SB(1, 1), b3 + hstep, voffB); PG8_STAGE(PG8_SA(1, 0), a3, voffA);
            PG8_WAIT_V(8); PG8_WAIT_L(0); PG8_BAR; PG8_MMA(1, 0, At, B0); PG8_MMA(1, 1, At, B1); PG8_BAR; PG8_SCHED;
            } else {
            PG8_LDB(B0, 0, 0); PG8_SCHED; PG8_LDA(At, 0, 0); PG8_STAGE(PG8_SA(1, 1), a1 + hstep, voffA);
            PG8_WAIT_L(8); PG8_BAR; PG8_WAIT_L(0); PG8_MMA(0, 0, At, B0); PG8_BAR; PG8_SCHED;
            PG8_LDB(B1, 0, 1); PG8_STAGE(PG8_SB(0, 0), b2, voffB);
            PG8_BAR; PG8_WAIT_L(0); PG8_MMA(0, 1, At, B1); PG8_BAR;
            PG8_LDA(At, 0, 1); PG8_STAGE(PG8_SA(0, 0), a2, voffA);
            PG8_BAR; PG8_WAIT_L(0); PG8_MMA(1, 0, At, B0); PG8_BAR; PG8_SCHED;
            PG8_STAGE(PG8_SB(0, 1), b2 + hstep, voffB);
            PG8_WAIT_V(6); PG8_BAR; PG8_MMA(1, 1, At, B1); PG8_BAR;
            PG8_LDB(B0, 1, 0); PG8_SCHED; PG8_LDA(At, 1, 0); PG8_STAGE(PG8_SA(0, 1), a2 + hstep, voffA);
            PG8_WAIT_L(8); PG8_BAR; PG8_WAIT_L(0); PG8_MMA(0, 0, At, B0); PG8_BAR; PG8_SCHED;
            PG8_LDB(B1, 1, 1); PG8_STAGE(PG8_SB(1, 0), b3, voffB);
            PG8_BAR; PG8_WAIT_L(0); PG8_MMA(0, 1, At, B1); PG8_BAR;
            PG8_LDA(At, 1, 1); PG8_STAGE(PG8_SA(1, 0), a3, voffA);
            PG8_BAR; PG8_WAIT_L(0); PG8_MMA(1, 0, At, B0); PG8_BAR; PG8_SCHED;
            PG8_STAGE(PG8_SB(1, 1), b3 + hstep, voffB);
            PG8_WAIT_V(6); PG8_BAR; PG8_MMA(1, 1, At, B1); PG8_BAR;
            }
        }
        if constexpr (ALIGN_EPI) { if (wr == 0) PG8_BAR; }
        if constexpr (!Epi::AFTER_DRAIN) { E(acc, cur, wr, wc, fr, fq); S.done(cur); }
        if (!has_next) break;
#pragma unroll
        for (int a = 0; a < 2; ++a)
#pragma unroll
            for (int b = 0; b < 2; ++b)
#pragma unroll
                for (int m = 0; m < 4; ++m)
#pragma unroll
                    for (int n = 0; n < 2; ++n) acc[a][b][m][n] = (f32x4){0.f, 0.f, 0.f, 0.f};
        cur = nxt; cA = nA; cB = nB; ++ui;
        if constexpr (ALIGN_EPI) { if (wr == 1) PG8_BAR; }
    }
    PG8_WAIT_V(0);
    if constexpr (!ALIGN_EPI) { if (wr == 0) PG8_BAR; }
    PG8_BAR;
    if constexpr (Epi::AFTER_DRAIN) { E.fused(acc, cur, wr, wc, fr, fq, lds, wid, lane); S.done(cur); }
#undef PG8_SA
#undef PG8_SB
#undef PG8_STAGE
#undef PG8_LDA
#undef PG8_LDB
#undef PG8_MMA
#undef PG8_WAIT_V
#undef PG8_WAIT_L
#undef PG8_BAR
#undef PG8_SCHED
}
}
#define GAS __attribute__((address_space(1)))
#define LAS __attribute__((address_space(3)))
typedef unsigned short bf16;
typedef unsigned v4u __attribute__((ext_vector_type(4)));
typedef float f32x4 __attribute__((ext_vector_type(4)));
typedef short bf16x8 __attribute__((ext_vector_type(8)));
typedef GAS unsigned gu32;
typedef GAS unsigned long long gu64;
#define RLX_AGENT __ATOMIC_RELAXED, __HIP_MEMORY_SCOPE_AGENT
#define LDS_WAIT() asm volatile("s_waitcnt lgkmcnt(0)" ::: "memory")
#define VM_WAIT() asm volatile("s_waitcnt vmcnt(0)" ::: "memory")
__device__ __forceinline__ unsigned long long rt() { return __builtin_amdgcn_s_memrealtime(); }
__device__ __forceinline__ unsigned f2bf(float f) { unsigned u = __builtin_bit_cast(unsigned, f); return (u + 0x7fffu + ((u >> 16) & 1u)) >> 16; }
__device__ __forceinline__ unsigned pk2(float lo, float hi) { return f2bf(lo) | (f2bf(hi) << 16); }

#define XB_TMO      128
#define XB_XCNT(j)  (256  + 64 * (j))
#define XB_XSUB(j)  (1280 + 64 * (j))
#define XB_XGEN(j)  (2304 + 64 * (j))
#define XB_TOP      3328
#define XB_TOPGEN   3392
#define XCD_BAR_WORDS 3456
#define XB_SPIN_CAP (1u << 18)

__device__ __forceinline__ unsigned xb_ld(unsigned* p)              { return __hip_atomic_load(p, __ATOMIC_RELAXED, __HIP_MEMORY_SCOPE_AGENT); }
__device__ __forceinline__ unsigned xb_add(unsigned* p, unsigned v) { return __hip_atomic_fetch_add(p, v, __ATOMIC_RELAXED, __HIP_MEMORY_SCOPE_AGENT); }
__device__ __forceinline__ unsigned xb_xcc_id() { return (unsigned)__builtin_amdgcn_s_getreg((3 << 11) | 20) & 0xFu; }
#define XB_SPIN(cond, bar) do { unsigned _sp = 0; while (cond) { __builtin_amdgcn_s_sleep(1); \
    if ((++_sp & 255u) == 0u) { if (xb_ld(&(bar)[XB_TMO])) break; if (_sp > XB_SPIN_CAP) { atomicAdd(&(bar)[XB_TMO], 1u); break; } } } } while (0)

struct XcdBarrier {
    unsigned* bar; unsigned x;
    volatile LAS unsigned* st;
};

__device__ __forceinline__ XcdBarrier xcd_barrier_post(unsigned* bar, volatile LAS unsigned* st) {
    XcdBarrier b; b.bar = bar; b.x = xb_xcc_id(); b.st = st;
    if (threadIdx.x == 0) (void)xb_add(&bar[XB_XCNT(b.x)], 1u);
    return b;
}
__device__ __forceinline__ void xcd_barrier_complete(unsigned* bar, unsigned x, unsigned& nloc, unsigned& nx) {
    const unsigned G = gridDim.x * gridDim.y * gridDim.z;
    unsigned sum, cnt, mine, sp = 0u;
    for (;;) {
        sum = 0u; cnt = 0u; mine = 0u;
#pragma unroll
        for (unsigned j = 0; j < 16; ++j) { const unsigned c = xb_ld(&bar[XB_XCNT(j)]); sum += c; cnt += (c > 0u) ? 1u : 0u; mine = (j == x) ? c : mine; }
        if (sum == G) break;
        __builtin_amdgcn_s_sleep(1);
        if ((++sp & 255u) == 0u) { if (xb_ld(&bar[XB_TMO])) break; if (sp > XB_SPIN_CAP) { atomicAdd(&bar[XB_TMO], 1u); break; } }
    }
    nloc = mine > 0u ? mine : 1u; nx = cnt > 0u ? cnt : 1u;
}

__device__ __forceinline__ void xcd_barrier(const XcdBarrier& b) {
    asm volatile("s_waitcnt vmcnt(0)" ::: "memory");
    __syncthreads();
    if (threadIdx.x == 0) {
        unsigned* bar = b.bar;
        __builtin_amdgcn_s_waitcnt(0);
        unsigned nloc = b.st[0], nx = b.st[1];
        if (nloc == 0u) { xcd_barrier_complete(bar, b.x, nloc, nx); b.st[0] = nloc; b.st[1] = nx; }
        const unsigned old = xb_add(&bar[XB_XSUB(b.x)], 1u);
        const unsigned gen = old / nloc;
        if (old + 1u == (gen + 1u) * nloc) {
            __builtin_amdgcn_fence(__ATOMIC_RELEASE, "agent");
            asm volatile("s_waitcnt vmcnt(0)" ::: "memory");
            const unsigned og = xb_add(&bar[XB_TOP], 1u);
            const unsigned tg = og / nx;
            if (og + 1u == (tg + 1u) * nx) xb_add(&bar[XB_TOPGEN], 1u);
            else XB_SPIN(xb_ld(&bar[XB_TOPGEN]) == tg, bar);
            __builtin_amdgcn_fence(__ATOMIC_ACQUIRE, "agent");
            xb_add(&bar[XB_XGEN(b.x)], 1u);
            asm volatile("s_waitcnt vmcnt(0)" ::: "memory");
        } else {
            XB_SPIN(xb_ld(&bar[XB_XGEN(b.x)]) == gen, bar);
            __builtin_amdgcn_fence(__ATOMIC_ACQUIRE, "agent");
            asm volatile("s_waitcnt vmcnt(0)" ::: "memory");
        }
    }
    __syncthreads();
}

constexpr size_t MiB = 1u << 20;
constexpr size_t WS_CTL = 0, CTL_ZERO_BYTES = 1 * MiB;
constexpr size_t WS_ROPE = 1 * MiB;
constexpr size_t WS_WRT = 3 * MiB;
constexpr size_t WS_RSTD = 4 * MiB;
constexpr size_t WS_TOPI = WS_RSTD + 256 * 1024;
constexpr size_t WS_GATE = WS_TOPI + 512 * 1024;
constexpr size_t WS_OFF = WS_GATE + 512 * 1024;
constexpr size_t WS_DEST = WS_OFF + 512 * 1024;
constexpr size_t WS_WIN = 8 * MiB;
constexpr size_t WS_WOUT = 14 * MiB;
constexpr size_t WS_WGU = 16 * MiB;
constexpr size_t WS_WDN = 144 * MiB;
constexpr size_t WS_XN = 208 * MiB;
constexpr size_t WS_QKV = 272 * MiB;
constexpr size_t WS_OP = 464 * MiB;
constexpr size_t WS_LSE = 560 * MiB;
constexpr size_t WS_XB = 272 * MiB;
constexpr size_t WS_ACT = 564 * MiB;
constexpr size_t WS_END = 836 * MiB;
static_assert(WS_DEST + 512 * 1024 <= WS_WIN && WS_XB + (size_t)PMAX * 2048 <= WS_LSE + 3 * MiB && WS_LSE + 3 * MiB <= WS_ACT && WS_ACT + (size_t)PMAX * 2048 <= WS_END, "ws map");
constexpr size_t QKV_STRIDE = (size_t)T * 512;
constexpr int CW_FILL = 64;
constexpr int CW_BAR = 4096;

constexpr int RING_OFF = 0, RING_BYTES = 131072;
constexpr int MISC_OFF = RING_BYTES;
constexpr int LDS_TSTART = MISC_OFF + 256;
constexpr int LDS_TEXP = MISC_OFF + 512;
constexpr int LDS_WSC = MISC_OFF + 4096;
constexpr int LDS_BYTES = 147456;

typedef float f32x16 __attribute__((ext_vector_type(16)));
typedef short s16x4 __attribute__((ext_vector_type(4)));
typedef unsigned u32x2 __attribute__((ext_vector_type(2)));
__device__ __forceinline__ float bflo(unsigned w) { return __builtin_bit_cast(float, w << 16); }
__device__ __forceinline__ float bfhi(unsigned w) { return __builtin_bit_cast(float, w & 0xffff0000u); }
__device__ __forceinline__ float wave_sum(float v) {
#pragma unroll
    for (int o = 1; o < 64; o <<= 1) v += __shfl_xor(v, o);
    return v;
}

struct Frame {
    LAS unsigned char* lds;
    int tid, lane, wave, vcu, G;
    const float *x, *g1, *w_in, *attn_g, *conv_w, *conv_g, *w_out, *g2, *w_r, *b_r, *w_gu, *b_gu, *w_dn, *b_dn, *gf;
    float* out; unsigned char* ws; gu32* ctl;
};

__device__ __forceinline__ void p0_transpose_item(const float* W, int K, int N, bf16* WT, int k0, int n0, int drow0, LAS float* scr, int lane) {
#pragma unroll 8
    for (int i = 0; i < 32; ++i) { const int kk = 2 * i + (lane >> 5); scr[kk * 33 + (lane & 31)] = W[(size_t)(k0 + kk) * N + n0 + (lane & 31)]; }
    LDS_WAIT(); asm volatile("" ::: "memory");
    const int c = lane & 7;
#pragma unroll
    for (int j = 0; j < 4; ++j) { const int n = (lane >> 3) + 8 * j; const LAS float* s = scr + (8 * c) * 33 + n;
        v4u o; o.x = pk2(s[0 * 33], s[1 * 33]); o.y = pk2(s[2 * 33], s[3 * 33]); o.z = pk2(s[4 * 33], s[5 * 33]); o.w = pk2(s[6 * 33], s[7 * 33]);
        *(v4u*)(WT + (size_t)(drow0 + n) * K + k0 + 8 * c) = o; }
    LDS_WAIT(); asm volatile("" ::: "memory");
}
__device__ const double INV_FREQ_REV[32] = {
    1.0 / 6.283185307179586, 0.7498942093324559 / 6.283185307179586, 0.5623413251903491 / 6.283185307179586, 0.4216965034285822 / 6.283185307179586,
    0.31622776601683794 / 6.283185307179586, 0.23713737056616552 / 6.283185307179586, 0.1778279410038923 / 6.283185307179586, 0.1333521432163324 / 6.283185307179586,
    0.1 / 6.283185307179586, 0.07498942093324558 / 6.283185307179586, 0.05623413251903491 / 6.283185307179586, 0.042169650342858224 / 6.283185307179586,
    0.03162277660168379 / 6.283185307179586, 0.023713737056616554 / 6.283185307179586, 0.01778279410038923 / 6.283185307179586, 0.01333521432163324 / 6.283185307179586,
    0.01 / 6.283185307179586, 0.007498942093324558 / 6.283185307179586, 0.005623413251903491 / 6.283185307179586, 0.004216965034285823 / 6.283185307179586,
    0.0031622776601683794 / 6.283185307179586, 0.0023713737056616554 / 6.283185307179586, 0.0017782794100389228 / 6.283185307179586, 0.001333521432163324 / 6.283185307179586,
    0.001 / 6.283185307179586, 0.0007498942093324559 / 6.283185307179586, 0.0005623413251903491 / 6.283185307179586, 0.00042169650342858224 / 6.283185307179586,
    0.00031622776601683794 / 6.283185307179586, 0.00023713737056616554 / 6.283185307179586, 0.00017782794100389227 / 6.283185307179586, 0.0001333521432163324 / 6.283185307179586};

__device__ __forceinline__ void p0_prologue(Frame& F) {
    LAS float* scr = (LAS float*)(F.lds + RING_OFF + F.wave * 16384);
    const int gw = F.vcu * 8 + F.wave, NGW = F.G * 8;
    bf16* win_t = (bf16*)(F.ws + WS_WIN); bf16* wout_t = (bf16*)(F.ws + WS_WOUT); bf16* wgu_t = (bf16*)(F.ws + WS_WGU); bf16* wdn_t = (bf16*)(F.ws + WS_WDN);
    constexpr int I_IN = 16 * 96, I_OUT = 16 * 32, I_GU = 16 * 64, I_DN = 16 * 32;
    constexpr int NITEMS = I_IN + I_OUT + NE * I_GU + NE * I_DN;
    for (int it = gw; it < NITEMS; it += NGW) {
        int r = it;
        if (r < I_IN) { const int kb = r / 96, nb = r % 96, n0 = 32 * nb; int drow = n0;
            if (n0 < 1024) { const int pn = n0 >> 8, w = n0 & 255, hh = w >> 6, bj = (w >> 5) & 1; drow = 256 * pn + 128 * bj + 32 * hh; }
            p0_transpose_item(F.w_in, 1024, NPROJ, win_t, 64 * kb, n0, drow, scr, F.lane); continue; }
        r -= I_IN;
        if (r < I_OUT) { const int kb = r / 32, nb = r % 32; p0_transpose_item(F.w_out, 1024, 1024, wout_t, 64 * kb, 32 * nb, 32 * nb, scr, F.lane); continue; }
        r -= I_OUT;
        if (r < NE * I_GU) { const int e = r / I_GU, q = r % I_GU, kb = q / 64, nb = q % 64, n0 = 32 * nb; const int up = n0 >> 10, f = n0 & 1023;
            const int drow = 256 * (f >> 7) + 128 * up + (f & 127);
            p0_transpose_item(F.w_gu + (size_t)e * 1024 * 2048, 1024, 2048, wgu_t + (size_t)e * 2048 * 1024, 64 * kb, n0, drow, scr, F.lane); continue; }
        r -= NE * I_GU;
        { const int e = r / I_DN, q = r % I_DN, kb = q / 32, nb = q % 32;
            p0_transpose_item(F.w_dn + (size_t)e * 1024 * 1024, 1024, 1024, wdn_t + (size_t)e * 1024 * 1024, 64 * kb, 32 * nb, 32 * nb, scr, F.lane); }
    }
    { const int gt = F.vcu * 512 + F.tid, NGT = F.G * 512;
      float* rope = (float*)(F.ws + WS_ROPE);
      for (int i = gt; i < SEQ * 32; i += NGT) { const int pos = i >> 5, fi = i & 31; const double rev = (double)pos * INV_FREQ_REV[fi]; const float fr = (float)(rev - __builtin_rint(rev));
          rope[2 * i] = __builtin_amdgcn_cosf(fr); rope[2 * i + 1] = __builtin_amdgcn_sinf(fr); }
      float* wrt = (float*)(F.ws + WS_WRT);
      for (int i = gt; i < NE * 1024; i += NGT) { const int e = i >> 10, k = i & 1023; wrt[i] = F.g2[k] * F.w_r[k * NE + e]; }
    }
    bf16* XN = (bf16*)(F.ws + WS_XN);
    f32x4 gv[4];
#pragma unroll
    for (int j = 0; j < 4; ++j) gv[j] = ((const f32x4*)F.g1)[F.lane + 64 * j];
    for (int m = gw; m < T; m += NGW) {
        const f32x4* xr = (const f32x4*)(F.x + (size_t)m * DM) + F.lane;
        f32x4 v[4]; float s2 = 0.f;
#pragma unroll
        for (int j = 0; j < 4; ++j) { v[j] = xr[64 * j]; s2 += (v[j].x * v[j].x + v[j].y * v[j].y) + (v[j].z * v[j].z + v[j].w * v[j].w); }
        const float rstd = 1.0f / sqrtf(wave_sum(s2) * (1.f / DM) + NORM_EPS);
        u32x2* o8 = (u32x2*)(XN + (size_t)m * DM) + F.lane;
#pragma unroll
        for (int j = 0; j < 4; ++j) { u32x2 w; w.x = pk2(v[j].x * rstd * gv[j].x, v[j].y * rstd * gv[j].y); w.y = pk2(v[j].z * rstd * gv[j].z, v[j].w * rstd * gv[j].w); o8[64 * j] = w; }
    }
}

constexpr int ATT_SLOT = 32768, ATT_NSEG = BATCH * NH * 48;
__device__ __forceinline__ s16x4 tr_read(const LAS unsigned char* p) { typedef short v4i16_t __attribute__((ext_vector_type(4))); return __builtin_bit_cast(s16x4, __builtin_amdgcn_ds_read_tr16_b64_v4i16((LAS v4i16_t*)p)); }

__device__ __forceinline__ void p2_attention(Frame& F) {
    const int tid = F.tid, lane = F.lane, w = F.wave, li = lane & 15, g = lane >> 4;
    LAS unsigned char* ring = F.lds + RING_OFF;
    const bf16* Qb = (const bf16*)(F.ws + WS_QKV); const bf16* Kb = Qb + QKV_STRIDE; const bf16* Vb = Kb + QKV_STRIDE;
    bf16* OP = (bf16*)(F.ws + WS_OP); float* LSE = (float*)(F.ws + WS_LSE);
    const int srow = tid >> 3, scc = tid & 7;
    const int per = (ATT_NSEG + F.G - 1) / F.G;
    const int s_lo = F.vcu * per, s_hi = (s_lo + per < ATT_NSEG) ? s_lo + per : ATT_NSEG;
    const int fk = li >> 1;
    const int kc0 = ((g ^ fk) << 4), kc1 = (((g + 4) ^ fk) << 4);
    const int vq = li >> 2, vp = li & 3;
    const int fv = (((2 * g + (li >> 3)) & 3) << 1);
    for (int s = s_lo; s < s_hi; ++s) {
        const int bh = s / 48, ws_ = s % 48, b = bh >> 3, h = bh & 7, p = ws_ >> 4, j = ws_ & 15;
        int dil, r, n0;
        if (p == 0) { dil = 1; r = 0; n0 = 4 * j; } else if (p == 1) { dil = 4; r = j >> 2; n0 = 4 * (j & 3); } else { dil = 16; r = j; n0 = 0; }
        const size_t tok0 = (size_t)b * SEQ + r;
        const bf16* Kg = Kb + tok0 * 512 + h * 64 + scc * 8; const bf16* Vg = Vb + tok0 * 512 + h * 64 + scc * 8;
        const size_t rstride = (size_t)dil * 512;
        {
            const int nbp = (n0 > 0) ? n0 - 1 : 0;
            v4u kr[2][2], vr[2][2];
#pragma unroll
            for (int i = 0; i < 2; ++i) { const size_t o0 = (size_t)(128 * nbp + srow + 64 * i) * rstride, o1 = (size_t)(128 * n0 + srow + 64 * i) * rstride;
                kr[0][i] = *(const v4u*)(Kg + o0); vr[0][i] = *(const v4u*)(Vg + o0); kr[1][i] = *(const v4u*)(Kg + o1); vr[1][i] = *(const v4u*)(Vg + o1); }
#pragma unroll
            for (int q = 0; q < 2; ++q) { const int slot = (n0 + q) % 3;
#pragma unroll
                for (int i = 0; i < 2; ++i) { const int row = srow + 64 * i;
                    *(LAS v4u*)(ring + slot * ATT_SLOT + row * 128 + ((scc ^ ((row >> 1) & 7)) << 4)) = kr[q][i];
                    *(LAS v4u*)(ring + slot * ATT_SLOT + 16384 + row * 128 + ((scc ^ (((row >> 1) & 3) << 1)) << 4)) = vr[q][i]; } }
        }
        __syncthreads();
        for (int n = n0; n < n0 + 4; ++n) {
            const bool more = (n + 1 < n0 + 4);
            v4u kn[2], vn[2];
            if (more) {
#pragma unroll
                for (int i = 0; i < 2; ++i) { const size_t o = (size_t)(128 * (n + 1) + srow + 64 * i) * rstride; kn[i] = *(const v4u*)(Kg + o); vn[i] = *(const v4u*)(Vg + o); }
            }
            const int q0 = 128 * n + 16 * w;
            const size_t tokq = tok0 + (size_t)(q0 + li) * dil;
            const bf16* qp = Qb + tokq * 512 + h * 64 + 8 * g;
            const bf16x8 qf0 = *(const bf16x8*)(qp), qf1 = *(const bf16x8*)(qp + 32);
            const int slot_prev = n % 3, slot_cur = (n + 1) % 3;
            f32x4 sc[9];
#pragma unroll
            for (int kt = 0; kt < 9; ++kt) {
                const int t = w + kt; const int slot = (t < 8) ? slot_prev : slot_cur;
                const LAS unsigned char* kb = ring + slot * ATT_SLOT + (16 * (t & 7) + li) * 128;
                const bf16x8 a0 = *(const LAS bf16x8*)(kb + kc0), a1 = *(const LAS bf16x8*)(kb + kc1);
                f32x4 z = {0.f, 0.f, 0.f, 0.f};
                z = __builtin_amdgcn_mfma_f32_16x16x32_bf16(a0, qf0, z, 0, 0, 0);
                sc[kt] = __builtin_amdgcn_mfma_f32_16x16x32_bf16(a1, qf1, z, 0, 0, 0);
            }
            const float NEG = -INFINITY;
#pragma unroll
            for (int i = 0; i < 4; ++i) { const int ik = 4 * g + i; if (ik < li) sc[0][i] = NEG; if (ik > li) sc[8][i] = NEG; }
            if (n == 0) {
#pragma unroll
                for (int kt = 0; kt < 8; ++kt) if (w + kt < 8) sc[kt] = (f32x4){NEG, NEG, NEG, NEG};
            }
            float mx = NEG;
#pragma unroll
            for (int kt = 0; kt < 9; ++kt) mx = fmaxf(fmaxf(fmaxf(mx, sc[kt][0]), fmaxf(sc[kt][1], sc[kt][2])), sc[kt][3]);
            mx = fmaxf(mx, __shfl_xor(mx, 16)); mx = fmaxf(mx, __shfl_xor(mx, 32));
            float lsum = 0.f;
#pragma unroll
            for (int kt = 0; kt < 9; ++kt)
#pragma unroll
                for (int i = 0; i < 4; ++i) { const float pv = __builtin_amdgcn_exp2f(sc[kt][i] - mx); sc[kt][i] = pv; lsum += pv; }
            lsum += __shfl_xor(lsum, 16); lsum += __shfl_xor(lsum, 32);
            f32x4 oacc[4];
#pragma unroll
            for (int d0 = 0; d0 < 4; ++d0) oacc[d0] = (f32x4){0.f, 0.f, 0.f, 0.f};
#pragma unroll
            for (int ks = 0; ks < 5; ++ks) {
                v4u pw; pw.x = pk2(sc[2 * ks][0], sc[2 * ks][1]); pw.y = pk2(sc[2 * ks][2], sc[2 * ks][3]);
                if (ks < 4) { pw.z = pk2(sc[2 * ks + 1][0], sc[2 * ks + 1][1]); pw.w = pk2(sc[2 * ks + 1][2], sc[2 * ks + 1][3]); } else { pw.z = 0u; pw.w = 0u; }
                const bf16x8 pf = __builtin_bit_cast(bf16x8, pw);
                const int tA = w + 2 * ks, tB = (ks < 4) ? tA + 1 : tA;
                const LAS unsigned char* va = ring + ((tA < 8) ? slot_prev : slot_cur) * ATT_SLOT + 16384 + (16 * (tA & 7) + 4 * g + vq) * 128 + 8 * (vp & 1);
                const LAS unsigned char* vb = ring + ((tB < 8) ? slot_prev : slot_cur) * ATT_SLOT + 16384 + (16 * (tB & 7) + 4 * g + vq) * 128 + 8 * (vp & 1);
#pragma unroll
                for (int d0 = 0; d0 < 4; ++d0) { const int co = (((2 * d0 + (vp >> 1)) ^ fv) << 4);
                    const s16x4 xa = tr_read(va + co), xb = tr_read(vb + co);
                    const bf16x8 vf = (bf16x8){xa[0], xa[1], xa[2], xa[3], xb[0], xb[1], xb[2], xb[3]};
                    oacc[d0] = __builtin_amdgcn_mfma_f32_16x16x32_bf16(vf, pf, oacc[d0], 0, 0, 0); }
            }
            const float inv = 1.0f / lsum;
            bf16* op = OP + ((size_t)p * T + tokq) * 512 + h * 64 + 4 * g;
#pragma unroll
            for (int d0 = 0; d0 < 4; ++d0) { u32x2 o; o.x = pk2(oacc[d0][0] * inv, oacc[d0][1] * inv); o.y = pk2(oacc[d0][2] * inv, oacc[d0][3] * inv); *(u32x2*)(op + 16 * d0) = o; }
            if (g == 0) LSE[((size_t)p * T + tokq) * 8 + h] = mx + __builtin_amdgcn_logf(lsum);
            if (more) { const int slot = (n + 2) % 3;
#pragma unroll
                for (int i = 0; i < 2; ++i) { const int row = srow + 64 * i;
                    *(LAS v4u*)(ring + slot * ATT_SLOT + row * 128 + ((scc ^ ((row >> 1) & 7)) << 4)) = kn[i];
                    *(LAS v4u*)(ring + slot * ATT_SLOT + 16384 + row * 128 + ((scc ^ (((row >> 1) & 3) << 1)) << 4)) = vn[i]; } }
            __syncthreads();
        }
    }
}

__device__ __forceinline__ void unpack8(const v4u w, float (&f)[8]) { f[0] = bflo(w.x); f[1] = bfhi(w.x); f[2] = bflo(w.y); f[3] = bfhi(w.y); f[4] = bflo(w.z); f[5] = bfhi(w.z); f[6] = bflo(w.w); f[7] = bfhi(w.w); }
__device__ __forceinline__ void p3_merge(Frame& F) {
    const int lane = F.lane, c0 = 8 * lane, head = lane >> 3;
    const int gw = F.vcu * 8 + F.wave, NGW = F.G * 8;
    const bf16* QKV = (const bf16*)(F.ws + WS_QKV);
    const bf16* Ub = QKV + 3 * QKV_STRIDE; const bf16* Bb = QKV + 4 * QKV_STRIDE; const bf16* Cb = QKV + 5 * QKV_STRIDE;
    const bf16* OP = (const bf16*)(F.ws + WS_OP); const float* LSE = (const float*)(F.ws + WS_LSE);
    bf16* MX = (bf16*)(F.ws + WS_XN);
    float ag[8], cg[8], w0[8], w1[8], w2[8];
#pragma unroll
    for (int j = 0; j < 8; ++j) { ag[j] = F.attn_g[c0 + j]; cg[j] = F.conv_g[c0 + j]; w0[j] = F.conv_w[c0 + j]; w1[j] = F.conv_w[512 + c0 + j]; w2[j] = F.conv_w[1024 + c0 + j]; }
    for (int run = gw; run < T / 16; run += NGW) {
        const int t0 = run * 16;
        float z1[8], z2[8];
        if ((t0 & (SEQ - 1)) != 0) {
            float a[8], c[8];
            unpack8(*(const v4u*)(Ub + (size_t)(t0 - 1) * 512 + c0), a); unpack8(*(const v4u*)(Cb + (size_t)(t0 - 1) * 512 + c0), c);
#pragma unroll
            for (int j = 0; j < 8; ++j) z1[j] = a[j] * c[j];
            unpack8(*(const v4u*)(Ub + (size_t)(t0 - 2) * 512 + c0), a); unpack8(*(const v4u*)(Cb + (size_t)(t0 - 2) * 512 + c0), c);
#pragma unroll
            for (int j = 0; j < 8; ++j) z2[j] = a[j] * c[j];
        } else {
#pragma unroll
            for (int j = 0; j < 8; ++j) { z1[j] = 0.f; z2[j] = 0.f; }
        }
        for (int tt = 0; tt < 16; ++tt) {
            const size_t t = (size_t)t0 + tt;
            const float l0 = LSE[t * 8 + head], l1 = LSE[((size_t)T + t) * 8 + head], l2 = LSE[((size_t)2 * T + t) * 8 + head];
            const float lm = fmaxf(l0, fmaxf(l1, l2));
            float e0 = __builtin_amdgcn_exp2f(l0 - lm), e1 = __builtin_amdgcn_exp2f(l1 - lm), e2 = __builtin_amdgcn_exp2f(l2 - lm);
            const float es = 1.0f / (e0 + e1 + e2); e0 *= es; e1 *= es; e2 *= es;
            float o0[8], o1[8], o2[8], at[8];
            unpack8(*(const v4u*)(OP + t * 512 + c0), o0); unpack8(*(const v4u*)(OP + ((size_t)T + t) * 512 + c0), o1); unpack8(*(const v4u*)(OP + ((size_t)2 * T + t) * 512 + c0), o2);
            float sa = 0.f;
#pragma unroll
            for (int j = 0; j < 8; ++j) { at[j] = e0 * o0[j] + e1 * o1[j] + e2 * o2[j]; sa += at[j] * at[j]; }
            float uu[8], cc[8], bb[8], co[8];
            unpack8(*(const v4u*)(Ub + t * 512 + c0), uu); unpack8(*(const v4u*)(Cb + t * 512 + c0), cc); unpack8(*(const v4u*)(Bb + t * 512 + c0), bb);
            float sv = 0.f;
#pragma unroll
            for (int j = 0; j < 8; ++j) { const float z0 = cc[j] * uu[j]; const float cv = z2[j] * w0[j] + z1[j] * w1[j] + z0 * w2[j]; co[j] = bb[j] * cv; sv += co[j] * co[j]; z2[j] = z1[j]; z1[j] = z0; }
            sa = wave_sum(sa); sv = wave_sum(sv);
            const float ra = 1.0f / sqrtf(sa * (1.f / 512.f) + NORM_EPS), rc = 1.0f / sqrtf(sv * (1.f / 512.f) + NORM_EPS);
            v4u wa, wc;
            wa.x = pk2(at[0] * ra * ag[0], at[1] * ra * ag[1]); wa.y = pk2(at[2] * ra * ag[2], at[3] * ra * ag[3]); wa.z = pk2(at[4] * ra * ag[4], at[5] * ra * ag[5]); wa.w = pk2(at[6] * ra * ag[6], at[7] * ra * ag[7]);
            wc.x = pk2(co[0] * rc * cg[0], co[1] * rc * cg[1]); wc.y = pk2(co[2] * rc * cg[2], co[3] * rc * cg[3]); wc.z = pk2(co[4] * rc * cg[4], co[5] * rc * cg[5]); wc.w = pk2(co[6] * rc * cg[6], co[7] * rc * cg[7]);
            *(v4u*)(MX + t * 1024 + c0) = wa; *(v4u*)(MX + t * 1024 + 512 + c0) = wc;
        }
    }
}

__device__ __forceinline__ void p5_router(Frame& F) {
    if (F.wave >= 4) return;
    const int lane = F.lane, r32 = lane & 31, kk = lane >> 5;
    const float* H = F.out; const float* WRT = (const float*)(F.ws + WS_WRT);
    float* RSTD = (float*)(F.ws + WS_RSTD); int* TOPI = (int*)(F.ws + WS_TOPI); float* GATE = (float*)(F.ws + WS_GATE); int* OFF = (int*)(F.ws + WS_OFF);
    LAS unsigned* wsc = (LAS unsigned*)(F.lds + LDS_WSC + F.wave * 512);
    float br[16];
#pragma unroll
    for (int r = 0; r < 16; ++r) br[r] = F.b_r[(r & 3) + 8 * (r >> 2) + 4 * kk];
    for (int tile = blockIdx.x * 4 + F.wave; tile < T / 32; tile += F.G * 4) {
        const int tok = tile * 32 + r32;
        const f32x4* hp = (const f32x4*)(H + (size_t)tok * 1024 + 4 * kk);
        const f32x4* wp = (const f32x4*)(WRT + (size_t)r32 * 1024 + 4 * kk);
        f32x16 acc;
#pragma unroll
        for (int r = 0; r < 16; ++r) acc[r] = 0.f;
        float ssq = 0.f;
#pragma unroll 4
        for (int j = 0; j < 128; ++j) {
            const f32x4 hv = hp[2 * j], wv = wp[2 * j];
            ssq += (hv.x * hv.x + hv.y * hv.y) + (hv.z * hv.z + hv.w * hv.w);
            acc = __builtin_amdgcn_mfma_f32_32x32x2f32(wv.x, hv.x, acc, 0, 0, 0);
            acc = __builtin_amdgcn_mfma_f32_32x32x2f32(wv.y, hv.y, acc, 0, 0, 0);
            acc = __builtin_amdgcn_mfma_f32_32x32x2f32(wv.z, hv.z, acc, 0, 0, 0);
            acc = __builtin_amdgcn_mfma_f32_32x32x2f32(wv.w, hv.w, acc, 0, 0, 0);
        }
        ssq += __shfl_xor(ssq, 32);
        const float rstd = 1.0f / sqrtf(ssq * (1.f / 1024.f) + NORM_EPS);
        float lg[16];
#pragma unroll
        for (int r = 0; r < 16; ++r) lg[r] = acc[r] * rstd + br[r];
        float tv[4]; int te[4];
#pragma unroll
        for (int k = 0; k < 4; ++k) {
            float bv = lg[0]; int bi = 0;
#pragma unroll
            for (int r = 1; r < 16; ++r) if (lg[r] > bv) { bv = lg[r]; bi = r; }
            const int be = (bi & 3) + 8 * (bi >> 2) + 4 * kk;
            const float ov = __shfl_xor(bv, 32); const int oe = __shfl_xor(be, 32);
            const bool mine = (bv > ov) || (bv == ov && be < oe);
            tv[k] = mine ? bv : ov; te[k] = mine ? be : oe;
#pragma unroll
            for (int r = 0; r < 16; ++r) if (mine && r == bi) lg[r] = -INFINITY;
        }
        const float e1 = __builtin_amdgcn_exp2f((tv[1] - tv[0]) * 1.4426950408889634f), e2 = __builtin_amdgcn_exp2f((tv[2] - tv[0]) * 1.4426950408889634f), e3 = __builtin_amdgcn_exp2f((tv[3] - tv[0]) * 1.4426950408889634f);
        const float gs = 1.0f / (1.0f + e1 + e2 + e3);
        if (lane < 32) wsc[lane] = 0u;
        LDS_WAIT();
        unsigned rk[4] = {0u, 0u, 0u, 0u};
        if (lane < 32) {
#pragma unroll
            for (int k = 0; k < 4; ++k) rk[k] = __hip_atomic_fetch_add(&wsc[te[k]], 1u, __ATOMIC_RELAXED, __HIP_MEMORY_SCOPE_WORKGROUP);
        }
        LDS_WAIT();
        if (lane < 32) { const unsigned c = wsc[lane]; unsigned base = 0u; if (c) base = __hip_atomic_fetch_add(F.ctl + CW_FILL + 64 * lane, c, __ATOMIC_RELAXED, __HIP_MEMORY_SCOPE_AGENT); wsc[32 + lane] = base; }
        LDS_WAIT();
        if (lane < 32) {
            typedef int i32x4 __attribute__((ext_vector_type(4)));
            i32x4 o; o.x = (int)(wsc[32 + te[0]] + rk[0]); o.y = (int)(wsc[32 + te[1]] + rk[1]); o.z = (int)(wsc[32 + te[2]] + rk[2]); o.w = (int)(wsc[32 + te[3]] + rk[3]);
            *(i32x4*)(OFF + (size_t)tok * 4) = o;
            *(i32x4*)(TOPI + (size_t)tok * 4) = (i32x4){te[0], te[1], te[2], te[3]};
            *(f32x4*)(GATE + (size_t)tok * 4) = (f32x4){gs, e1 * gs, e2 * gs, e3 * gs};
            RSTD[tok] = rstd;
        }
        LDS_WAIT();
    }
}

__device__ __forceinline__ int build_tiles(Frame& F) {
    LAS int* tstart = (LAS int*)(F.lds + LDS_TSTART); LAS int* texp = (LAS int*)(F.lds + LDS_TEXP);
    __syncthreads();
    if (F.tid == 0) { int acc = 0;
        for (int e = 0; e < NE; ++e) { const unsigned c = __hip_atomic_load(F.ctl + CW_FILL + 64 * e, __ATOMIC_RELAXED, __HIP_MEMORY_SCOPE_AGENT); tstart[e] = acc; acc += (int)((c + 255u) >> 8); }
        tstart[NE] = acc; }
    __syncthreads();
    if (F.tid < NE) { const int a = tstart[F.tid], b = tstart[F.tid + 1]; for (int t = a; t < b; ++t) texp[t] = F.tid; }
    __syncthreads();
    return tstart[NE];
}

__device__ __forceinline__ void p6_scatter(Frame& F) {
    build_tiles(F);
    const LAS int* tstart = (const LAS int*)(F.lds + LDS_TSTART);
    const int lane = F.lane, gw = F.vcu * 8 + F.wave, NGW = F.G * 8;
    const float* H = F.out; const float* RSTD = (const float*)(F.ws + WS_RSTD); const int* TOPI = (const int*)(F.ws + WS_TOPI); const int* OFF = (const int*)(F.ws + WS_OFF);
    int* DEST = (int*)(F.ws + WS_DEST); bf16* XB = (bf16*)(F.ws + WS_XB);
    f32x4 gg[2][2];
#pragma unroll
    for (int j = 0; j < 2; ++j) { gg[j][0] = *(const f32x4*)(F.g2 + 512 * j + 8 * lane); gg[j][1] = *(const f32x4*)(F.g2 + 512 * j + 8 * lane + 4); }
    typedef int i32x4 __attribute__((ext_vector_type(4)));
    for (int tok = gw; tok < T; tok += NGW) {
        const i32x4 te = *(const i32x4*)(TOPI + (size_t)tok * 4), of = *(const i32x4*)(OFF + (size_t)tok * 4);
        i32x4 d; d.x = 256 * tstart[te.x] + of.x; d.y = 256 * tstart[te.y] + of.y; d.z = 256 * tstart[te.z] + of.z; d.w = 256 * tstart[te.w] + of.w;
        if (lane == 0) *(i32x4*)(DEST + (size_t)tok * 4) = d;
        const float rs = RSTD[tok];
#pragma unroll
        for (int j = 0; j < 2; ++j) { const float* hp = H + (size_t)tok * 1024 + 512 * j + 8 * lane;
            const f32x4 a = *(const f32x4*)hp * rs * gg[j][0], b = *(const f32x4*)(hp + 4) * rs * gg[j][1];
            v4u wv; wv.x = pk2(a.x, a.y); wv.y = pk2(a.z, a.w); wv.z = pk2(b.x, b.y); wv.w = pk2(b.z, b.w);
            const size_t co = 512 * j + 8 * lane;
            *(v4u*)(XB + (size_t)d.x * 1024 + co) = wv; *(v4u*)(XB + (size_t)d.y * 1024 + co) = wv; *(v4u*)(XB + (size_t)d.z * 1024 + co) = wv; *(v4u*)(XB + (size_t)d.w * 1024 + co) = wv; }
    }
}

__device__ __forceinline__ void p9_combine(Frame& F) {
    const int lane = F.lane, gw = F.vcu * 8 + F.wave, NGW = F.G * 8;
    const int* DEST = (const int*)(F.ws + WS_DEST); const float* GATE = (const float*)(F.ws + WS_GATE); const bf16* YB = (const bf16*)(F.ws + WS_XB);
    f32x4 gg[2][2];
#pragma unroll
    for (int j = 0; j < 2; ++j) { gg[j][0] = *(const f32x4*)(F.gf + 512 * j + 8 * lane); gg[j][1] = *(const f32x4*)(F.gf + 512 * j + 8 * lane + 4); }
    typedef int i32x4 __attribute__((ext_vector_type(4)));
    for (int tok = gw; tok < T; tok += NGW) {
        const i32x4 d = *(const i32x4*)(DEST + (size_t)tok * 4); const f32x4 gt = *(const f32x4*)(GATE + (size_t)tok * 4);
        float hv[2][8]; float ssq = 0.f;
#pragma unroll
        for (int j = 0; j < 2; ++j) { float* hp = F.out + (size_t)tok * 1024 + 512 * j + 8 * lane; const size_t co = 512 * j + 8 * lane;
            const f32x4 a = *(const f32x4*)hp, b = *(const f32x4*)(hp + 4);
            float y0[8], y1[8], y2[8], y3[8];
            unpack8(*(const v4u*)(YB + (size_t)d.x * 1024 + co), y0); unpack8(*(const v4u*)(YB + (size_t)d.y * 1024 + co), y1); unpack8(*(const v4u*)(YB + (size_t)d.z * 1024 + co), y2); unpack8(*(const v4u*)(YB + (size_t)d.w * 1024 + co), y3);
            const float h8[8] = {a.x, a.y, a.z, a.w, b.x, b.y, b.z, b.w};
#pragma unroll
            for (int i = 0; i < 8; ++i) { const float v = h8[i] + (gt.x * y0[i] + gt.y * y1[i]) + (gt.z * y2[i] + gt.w * y3[i]); hv[j][i] = v; ssq += v * v; } }
        const float rstd = 1.0f / sqrtf(wave_sum(ssq) * (1.f / 1024.f) + NORM_EPS);
#pragma unroll
        for (int j = 0; j < 2; ++j) { float* hp = F.out + (size_t)tok * 1024 + 512 * j + 8 * lane;
            f32x4 a, b; a.x = hv[j][0] * rstd * gg[j][0].x; a.y = hv[j][1] * rstd * gg[j][0].y; a.z = hv[j][2] * rstd * gg[j][0].z; a.w = hv[j][3] * rstd * gg[j][0].w;
            b.x = hv[j][4] * rstd * gg[j][1].x; b.y = hv[j][5] * rstd * gg[j][1].y; b.z = hv[j][6] * rstd * gg[j][1].z; b.w = hv[j][7] * rstd * gg[j][1].w;
            *(f32x4*)hp = a; *(f32x4*)(hp + 4) = b; }
    }
}

constexpr int N_LAUNCHES = MK_N_LAUNCHES;
constexpr int PER_PHASE = 10;
struct Args { const float* in[15]; float* out; unsigned char* ws; int ph_lo, ph_hi; };
__global__ void __launch_bounds__(512, 2) hyb_fwd(Args args) {
    extern __shared__ __attribute__((aligned(16))) unsigned char lds[];
    Frame F;
    F.lds = (LAS unsigned char*)lds;
    F.tid = threadIdx.x; F.lane = F.tid & 63; F.wave = __builtin_amdgcn_readfirstlane(F.tid >> 6);
    F.G = gridDim.x; { const int bx = blockIdx.x; F.vcu = (F.G % 8 == 0) ? (bx % 8) * (F.G / 8) + bx / 8 : bx; }
    F.x = args.in[0]; F.g1 = args.in[1]; F.w_in = args.in[2]; F.attn_g = args.in[3]; F.conv_w = args.in[4]; F.conv_g = args.in[5]; F.w_out = args.in[6]; F.g2 = args.in[7];
    F.w_r = args.in[8]; F.b_r = args.in[9]; F.w_gu = args.in[10]; F.b_gu = args.in[11]; F.w_dn = args.in[12]; F.b_dn = args.in[13]; F.gf = args.in[14];
    F.out = args.out; F.ws = args.ws; F.ctl = (gu32*)(args.ws + WS_CTL);
    for (int u = F.tid; u < (LDS_BYTES - MISC_OFF) / 4; u += 512) ((LAS unsigned*)(F.lds + MISC_OFF))[u] = 0u;
    __syncthreads();
    XcdBarrier bar; bar.bar = (unsigned*)(F.ctl + CW_BAR); bar.x = 0; bar.st = nullptr;
    if (N_LAUNCHES == 1) bar = xcd_barrier_post((unsigned*)(F.ctl + CW_BAR), (volatile LAS unsigned*)(F.lds + MISC_OFF + 32));
    const int lo = args.ph_lo, hi = args.ph_hi;
#define IN(k) (lo <= (k) && (k) < hi)
#define SEAM(k) do { if (IN(k) && IN((k) + 1)) xcd_barrier(bar); } while (0)

    if (IN(0)) { p0_prologue(F); SEAM(0); }
    if (IN(1)) {
        pg8::Gemm g{(const pg8::bf16_t*)(F.ws + WS_XN), (const pg8::bf16_t*)(F.ws + WS_WIN), T, NPROJ, DM}; pg8::StaticOrder S; S.init(T, NPROJ, F.G, (int)blockIdx.x);
        pg8::EpiQKV E{(pg8::bf16_t*)(F.ws + WS_QKV), (const float*)(F.ws + WS_ROPE), QKV_STRIDE};
        pg8::gemm_phase<pg8::EpiQKV, pg8::StaticOrder, true, true>(F.lds + RING_OFF, g, S, E);
        SEAM(1);
    }
    if (IN(2)) { p2_attention(F); SEAM(2); }
    if (IN(3)) { p3_merge(F); SEAM(3); }
    if (IN(4)) {
        pg8::Gemm g{(const pg8::bf16_t*)(F.ws + WS_XN), (const pg8::bf16_t*)(F.ws + WS_WOUT), T, DM, DM}; pg8::StaticOrder S; S.init(T, DM, F.G, (int)blockIdx.x);
        pg8::EpiRes E{F.x, F.out};
        pg8::gemm_phase<pg8::EpiRes, pg8::StaticOrder, true, true>(F.lds + RING_OFF, g, S, E);
        SEAM(4);
    }
    if (IN(5)) { p5_router(F); SEAM(5); }
    if (IN(6)) { p6_scatter(F); SEAM(6); }
    if (IN(7)) {
        const int ntiles = build_tiles(F);
        pg8::Gemm g{(const pg8::bf16_t*)(F.ws + WS_XB), (const pg8::bf16_t*)(F.ws + WS_WGU), PMAX, NE * 2048, DM};
        pg8::MoeOrder S; S.init(ntiles, 8, F.G, (int)blockIdx.x, (const LAS int*)(F.lds + LDS_TEXP));
        pg8::EpiSwiGLU E{(pg8::bf16_t*)(F.ws + WS_ACT), F.b_gu};
        pg8::gemm_phase<pg8::EpiSwiGLU, pg8::MoeOrder, true, true>(F.lds + RING_OFF, g, S, E);
        SEAM(7);
    }
    if (IN(8)) {
        const int ntiles = build_tiles(F);
        pg8::Gemm g{(const pg8::bf16_t*)(F.ws + WS_ACT), (const pg8::bf16_t*)(F.ws + WS_WDN), PMAX, NE * 1024, FF};
        pg8::MoeOrder S; S.init(ntiles, 4, F.G, (int)blockIdx.x, (const LAS int*)(F.lds + LDS_TEXP));
        pg8::EpiBf16<0> E{(pg8::bf16_t*)(F.ws + WS_XB), DM, F.b_dn, 1024, 0, 1.0f};
        pg8::gemm_phase<pg8::EpiBf16<0>, pg8::MoeOrder, true, true>(F.lds + RING_OFF, g, S, E);
        SEAM(8);
    }
    if (IN(9)) { p9_combine(F); }
#undef IN
#undef SEAM
}

extern "C" void kernel_launch(void* const* d_in, const int* in_sizes, int n_in, void* d_out, int out_size, void* d_ws, size_t ws_size, hipStream_t stream) {
    static int grid = 0;
    if (grid == 0) {
        if (n_in != 15 || in_sizes[0] != T * DM || out_size != T * DM || ws_size < WS_END) { fprintf(stderr, "kernel_launch: unexpected shapes/workspace (n_in %d, ws %zu)\n", n_in, ws_size); grid = -1; return; }
        int dev = 0, cus = 0, per_cu = 0;
        if (hipGetDevice(&dev) != hipSuccess || hipDeviceGetAttribute(&cus, hipDeviceAttributeMultiprocessorCount, dev) != hipSuccess) { grid = -1; return; }
        if (hipFuncSetAttribute((const void*)hyb_fwd, hipFuncAttributeMaxDynamicSharedMemorySize, LDS_BYTES) != hipSuccess) { fprintf(stderr, "kernel_launch: hipFuncSetAttribute failed\n"); grid = -1; return; }
        if (hipOccupancyMaxActiveBlocksPerMultiprocessor(&per_cu, (const void*)hyb_fwd, 512, LDS_BYTES) != hipSuccess || per_cu < 1) { fprintf(stderr, "kernel_launch: occupancy query says %d\n", per_cu); per_cu = 1; }
        (void)hipGetLastError();
        grid = cus;
    }
    if (grid < 0) return;
    if (hipMemsetAsync((char*)d_ws + WS_CTL, 0, CTL_ZERO_BYTES, stream) != hipSuccess) { fprintf(stderr, "kernel_launch: memset failed\n"); return; }
    Args a{};
    for (int i = 0; i < 15; ++i) a.in[i] = (const float*)d_in[i];
    a.out = (float*)d_out; a.ws = (unsigned char*)d_ws;
    if (N_LAUNCHES == 1) {
        a.ph_lo = 0; a.ph_hi = PER_PHASE;
        void* kargs[] = {&a};
        const hipError_t le = hipLaunchCooperativeKernel((const void*)hyb_fwd, dim3(grid), dim3(512), kargs, LDS_BYTES, stream);
        if (le != hipSuccess) fprintf(stderr, "kernel_launch: cooperative launch failed: %s (grid %d)\n", hipGetErrorName(le), grid);
    } else {
        for (int li = 0; li < PER_PHASE; ++li) {
            a.ph_lo = li; a.ph_hi = li + 1;
            hipLaunchKernelGGL(hyb_fwd, dim3(grid), dim3(512), LDS_BYTES, stream, a);
        }
    }
}
```

```cpp
#include <hip/hip_runtime.h>
#include <hip/hip_bf16.h>
#include <cstdio>
#include <cstdint>
#include <cmath>

#ifndef MK_N_LAUNCHES
#define MK_N_LAUNCHES 1
#endif

constexpr int N_LAUNCHES = MK_N_LAUNCHES;
constexpr int BATCH = 4, SEQ = 8192, DM = 1024, T = BATCH * SEQ;
constexpr int NH = 8, HD = 64, AW = 512, NPROJ = 3072;
constexpr int NE = 32, TOPK = 4, FF = 1024;
constexpr int MASSIGN = T * TOPK;
constexpr int PMAX = MASSIGN + NE * 256;
constexpr int MAXTILES = PMAX / 256;
constexpr float NORM_EPS = 1e-5f;
constexpr float QSCALE = 0.125f * 1.4426950408889634f;

namespace pg8 {
#define PG8_LAS __attribute__((address_space(3)))
typedef unsigned short bf16_t;
typedef short bf16x8 __attribute__((ext_vector_type(8)));
typedef float f32x4 __attribute__((ext_vector_type(4)));
typedef unsigned u32x4 __attribute__((ext_vector_type(4)));
constexpr int BM = 256, BK = 64, HALF = 128, HTB = HALF * BK * 2  , STAGE_BYTES = 8 * HTB, NXCD = 8, WGM = 8;

__host__ __device__ __forceinline__ int lds_byte(int r, int c) { const int st = (r >> 4) * 2 + (c >> 5), rr = r & 15, cc = c & 31, ob = rr * 64 + cc * 2; return st * 1024 + (ob ^ (((ob >> 9) & 1) << 5)); }
__host__ __device__ __forceinline__ void stage_rc(int b, int& R, int& C) { const int st = b / 1024, sb = b % 1024, swz = sb ^ (((sb >> 9) & 1) << 5); R = (st >> 1) * 16 + swz / 64; C = (st & 1) * 32 + (swz % 64) / 2; }
__host__ __device__ __forceinline__ int perm32(int rho) { const int n = rho >> 4, i = rho & 15; return 8 * (i >> 2) + 4 * n + (i & 3); }

struct Unit { int pm, pn; };
struct Gemm { const bf16_t* A; const bf16_t* Bt; int M, N, K; };

struct StaticOrder {
    int nM, nN, nwg, G, c;
    __host__ __device__ void init(int M, int N, int G_, int c_) { nM = M / BM; nN = N / BM; nwg = nM * nN; G = G_; c = c_; }
    __host__ __device__ bool next(int i, Unit& u) const {
        const long L = (long)i * G + c; if (L >= nwg) return false;
        int wgid = (int)L; { const int q = nwg / NXCD, r = nwg % NXCD, xcd = wgid % NXCD, off = wgid / NXCD; wgid = (xcd < r ? xcd * (q + 1) : r * (q + 1) + (xcd - r) * q) + off; }
        const int nig = WGM * nN, gid = wgid / nig, fm = gid * WGM, gsz = (nM - fm) < WGM ? (nM - fm) : WGM;
        u.pm = fm + ((wgid % nig) % gsz); u.pn = (wgid % nig) / gsz; return true;
    }
    __device__ __forceinline__ void a_ready(const Unit&) const {}
    __device__ __forceinline__ void done(const Unit&) const {}
};

struct RangeOrder {
    StaticOrder base; int lo, hi;
    __host__ __device__ bool next(int i, Unit& u) const { return (lo + i < hi) && base.next(lo + i, u); }
    __device__ __forceinline__ void a_ready(const Unit&) const {}
    __device__ __forceinline__ void done(const Unit&) const {}
};
__device__ __forceinline__ unsigned cvt_pk_bf16(float lo, float hi) { unsigned r; asm volatile("v_cvt_pk_bf16_f32 %0, %1, %2" : "=v"(r) : "v"(lo), "v"(hi)); return r; }
typedef float f32x2 __attribute__((ext_vector_type(2)));
__device__ __forceinline__ f32x2 gelu_pk(f32x2 v) {
    const f32x2 av = __builtin_elementwise_abs(v), d = av * 0.2316418882f + 1.0f;
    f32x2 t; t.x = __builtin_amdgcn_rcpf(d.x); t.y = __builtin_amdgcn_rcpf(d.y);
    f32x2 q = t * 0.5307027145f + (-0.7265760135f); q = q * t + 0.7107068705f; q = q * t + (-0.142248368f); q = q * t + 0.127414796f; q = q * t;
    const f32x2 s = (v * v) * (-0.72134752044f);
    f32x2 e; e.x = __builtin_amdgcn_exp2f(s.x); e.y = __builtin_amdgcn_exp2f(s.y);
    const f32x2 m = v * (q * e), r = v - m;
    f32x2 o; o.x = v.x < 0.f ? m.x : r.x; o.y = v.y < 0.f ? m.y : r.y; return o;
}

template <int ACT  > struct EpiBf16 {
    static constexpr bool PERM = true, AFTER_DRAIN = false; static_assert(ACT == 0 || ACT == 1, "EpiBf16: ACT is 0 (none) or 1 (gelu_pk)");
    bf16_t* O; int ldc; const float* bias; int split_cols; size_t split_stride; float scale0;
    __device__ __forceinline__ void operator()(const f32x4 (&acc)[2][2][4][2], const Unit& u, int wr, int wc, int fr, int fq) const {
        const int row0 = u.pm * BM + wr * 64 + fr; int colt = u.pn * BM; bf16_t* base = O;
        float sc = 1.f; if (split_cols) { const int t = colt / split_cols; base += (size_t)t * split_stride; colt -= t * split_cols; if (t == 0) sc = scale0; }
        const int col0 = colt + wc * 32 + 8 * fq, bcol0 = u.pn * BM + wc * 32 + 8 * fq;
        f32x4 bv[2][2];
#pragma unroll
        for (int bj = 0; bj < 2; ++bj)
#pragma unroll
            for (int n = 0; n < 2; ++n) bv[bj][n] = bias ? *(const f32x4*)(bias + bcol0 + bj * HALF + 4 * n) : (f32x4){0.f, 0.f, 0.f, 0.f};
#pragma unroll
        for (int ai = 0; ai < 2; ++ai)
#pragma unroll
            for (int m = 0; m < 4; ++m) { bf16_t* rowp = base + (size_t)(row0 + ai * HALF + m * 16) * ldc + col0;
#pragma unroll
                for (int bj = 0; bj < 2; ++bj) { f32x4 v0 = acc[ai][bj][m][0] + bv[bj][0], v1 = acc[ai][bj][m][1] + bv[bj][1];
                    if (ACT == 1) { f32x2 a = gelu_pk((f32x2){v0[0], v0[1]}), b = gelu_pk((f32x2){v0[2], v0[3]}), c = gelu_pk((f32x2){v1[0], v1[1]}), d = gelu_pk((f32x2){v1[2], v1[3]});
                        v0 = (f32x4){a.x, a.y, b.x, b.y}; v1 = (f32x4){c.x, c.y, d.x, d.y}; }
                    v0 = v0 * sc; v1 = v1 * sc; u32x4 w; w.x = cvt_pk_bf16(v0[0], v0[1]); w.y = cvt_pk_bf16(v0[2], v0[3]); w.z = cvt_pk_bf16(v1[0], v1[1]); w.w = cvt_pk_bf16(v1[2], v1[3]);
                    *(u32x4*)(rowp + bj * HALF) = w; } }
    }
};

typedef unsigned u32x4_t __attribute__((ext_vector_type(4)));
typedef unsigned u32x2_t __attribute__((ext_vector_type(2)));
__device__ __forceinline__ unsigned pk4_fp8(float a, float b, float c, float d);
__device__ __forceinline__ u32x4_t widen_rows16(const u32x2_t wa, const u32x2_t wb) {
    const auto r0 = __builtin_amdgcn_permlane16_swap(wa.x, wb.x, false, false); const auto r1 = __builtin_amdgcn_permlane16_swap(wa.y, wb.y, false, false);
    u32x4_t o; o.x = r0[0]; o.y = r1[0]; o.z = r0[1]; o.w = r1[1]; return o;
}
__device__ __forceinline__ unsigned pk4_fp8(float a, float b, float c, float d) { int r = __builtin_amdgcn_cvt_pk_fp8_f32(a, b, 0, false); r = __builtin_amdgcn_cvt_pk_fp8_f32(c, d, r, true); return (unsigned)r; }
struct EpiQKV {
    static constexpr bool PERM = true, AFTER_DRAIN = false;
    bf16_t* __restrict__ out; const float* __restrict__ cs; size_t bufstride;
    __device__ __forceinline__ void operator()(const f32x4 (&acc)[2][2][4][2], const Unit& u, int wr, int wc, int fr, int fq) const {
        const int buf = u.pn >> 1; bf16_t* base = out + (size_t)buf * bufstride;
        const int row0 = u.pm * BM + wr * 64 + fr;
        if (u.pn < 4) {
            const float sc = (u.pn < 2) ? 0.125f * 1.4426950408889634f : 1.0f;
            const int head = (u.pn & 1) * 4 + wc;
#pragma unroll
            for (int ai = 0; ai < 2; ++ai) {
                f32x4 cv[4][4];
#pragma unroll
                for (int m = 0; m < 4; ++m) { const int pos = (row0 + ai * HALF + m * 16) & 8191; const f32x4* cp = (const f32x4*)(cs + (size_t)pos * 64 + fq * 16);
                    cv[m][0] = cp[0]; cv[m][1] = cp[1]; cv[m][2] = cp[2]; cv[m][3] = cp[3]; }
#pragma unroll
                for (int m = 0; m < 4; ++m) {
                    const int row = row0 + ai * HALF + m * 16;
                    const f32x4 c0 = cv[m][0], c1 = cv[m][1], c2 = cv[m][2], c3 = cv[m][3];
                    const f32x4 lo0 = acc[ai][0][m][0], lo1 = acc[ai][0][m][1], hi0 = acc[ai][1][m][0], hi1 = acc[ai][1][m][1];
                    float ol[8], oh[8];
                    ol[0] = lo0[0] * c0[0] - hi0[0] * c0[1]; oh[0] = hi0[0] * c0[0] + lo0[0] * c0[1];
                    ol[1] = lo0[1] * c0[2] - hi0[1] * c0[3]; oh[1] = hi0[1] * c0[2] + lo0[1] * c0[3];
                    ol[2] = lo0[2] * c1[0] - hi0[2] * c1[1]; oh[2] = hi0[2] * c1[0] + lo0[2] * c1[1];
                    ol[3] = lo0[3] * c1[2] - hi0[3] * c1[3]; oh[3] = hi0[3] * c1[2] + lo0[3] * c1[3];
                    ol[4] = lo1[0] * c2[0] - hi1[0] * c2[1]; oh[4] = hi1[0] * c2[0] + lo1[0] * c2[1];
                    ol[5] = lo1[1] * c2[2] - hi1[1] * c2[3]; oh[5] = hi1[1] * c2[2] + lo1[1] * c2[3];
                    ol[6] = lo1[2] * c3[0] - hi1[2] * c3[1]; oh[6] = hi1[2] * c3[0] + lo1[2] * c3[1];
                    ol[7] = lo1[3] * c3[2] - hi1[3] * c3[3]; oh[7] = hi1[3] * c3[2] + lo1[3] * c3[3];
                    u32x4_t wl, wh;
                    wl.x = cvt_pk_bf16(ol[0] * sc, ol[1] * sc); wl.y = cvt_pk_bf16(ol[2] * sc, ol[3] * sc); wl.z = cvt_pk_bf16(ol[4] * sc, ol[5] * sc); wl.w = cvt_pk_bf16(ol[6] * sc, ol[7] * sc);
                    wh.x = cvt_pk_bf16(oh[0] * sc, oh[1] * sc); wh.y = cvt_pk_bf16(oh[2] * sc, oh[3] * sc); wh.z = cvt_pk_bf16(oh[4] * sc, oh[5] * sc); wh.w = cvt_pk_bf16(oh[6] * sc, oh[7] * sc);
                    bf16_t* rowp = base + (size_t)row * 512 + head * 64 + 8 * fq;
                    *(u32x4_t*)(rowp) = wl; *(u32x4_t*)(rowp + 32) = wh;
                }
            }
        } else if (u.pn == 6 || u.pn == 7 || u.pn >= 10) {
            const int j = (u.pn >= 10) ? u.pn - 8 : u.pn - 6; bf16_t* zb = out + 3 * bufstride;
#pragma unroll
            for (int ai = 0; ai < 2; ++ai)
#pragma unroll
                for (int m = 0; m < 4; ++m) { const f32x4 z0 = acc[ai][0][m][0] * acc[ai][1][m][0], z1 = acc[ai][0][m][1] * acc[ai][1][m][1];
                    u32x4_t w; w.x = cvt_pk_bf16(z0[0], z0[1]); w.y = cvt_pk_bf16(z0[2], z0[3]); w.z = cvt_pk_bf16(z1[0], z1[1]); w.w = cvt_pk_bf16(z1[2], z1[3]);
                    *(u32x4_t*)(zb + (size_t)(row0 + ai * HALF + m * 16) * 512 + 128 * j + wc * 32 + 8 * fq) = w; }
        } else {
            const int col0 = (u.pn & 1) * 256 + wc * 32 + 8 * fq;
#pragma unroll
            for (int ai = 0; ai < 2; ++ai)
#pragma unroll
                for (int m = 0; m < 4; ++m) { bf16_t* rowp = base + (size_t)(row0 + ai * HALF + m * 16) * 512 + col0;
#pragma unroll
                    for (int bj = 0; bj < 2; ++bj) { const f32x4 v0 = acc[ai][bj][m][0], v1 = acc[ai][bj][m][1];
                        u32x4_t w; w.x = cvt_pk_bf16(v0[0], v0[1]); w.y = cvt_pk_bf16(v0[2], v0[3]); w.z = cvt_pk_bf16(v1[0], v1[1]); w.w = cvt_pk_bf16(v1[2], v1[3]);
                        *(u32x4_t*)(rowp + bj * HALF) = w; } }
        }
    }
};
struct EpiRes {
    static constexpr bool PERM = true, AFTER_DRAIN = false;
    const bf16_t* __restrict__ xn; const float* __restrict__ rinv; const float* __restrict__ ginv; bf16_t* __restrict__ out; unsigned char* __restrict__ out8;
    __device__ __forceinline__ void operator()(const f32x4 (&acc)[2][2][4][2], const Unit& u, int wr, int wc, int fr, int fq) const {
        const int row0 = u.pm * BM + wr * 64 + fr, col0 = u.pn * BM + wc * 32 + 8 * fq;
        f32x4 gi[2][2];
#pragma unroll
        for (int bj = 0; bj < 2; ++bj) { gi[bj][0] = *(const f32x4*)(ginv + col0 + bj * HALF); gi[bj][1] = *(const f32x4*)(ginv + col0 + bj * HALF + 4); }
#pragma unroll
        for (int ai = 0; ai < 2; ++ai) {
            u32x4_t xw[4][2]; float ri[4];
#pragma unroll
            for (int m = 0; m < 4; ++m) { const int row = row0 + ai * HALF + m * 16; ri[m] = rinv[row];
#pragma unroll
                for (int bj = 0; bj < 2; ++bj) xw[m][bj] = *(const u32x4_t*)(xn + (size_t)row * 1024 + col0 + bj * HALF); }
            u32x2_t w8[2][2];
#pragma unroll
            for (int m = 0; m < 4; ++m) { const int row = row0 + ai * HALF + m * 16; const size_t off = (size_t)row * 1024 + col0;
#pragma unroll
                for (int bj = 0; bj < 2; ++bj) { const u32x4_t q = xw[m][bj];
                    f32x4 xa, xb;
                    xa[0] = __builtin_bit_cast(float, q.x << 16); xa[1] = __builtin_bit_cast(float, q.x & 0xffff0000u); xa[2] = __builtin_bit_cast(float, q.y << 16); xa[3] = __builtin_bit_cast(float, q.y & 0xffff0000u);
                    xb[0] = __builtin_bit_cast(float, q.z << 16); xb[1] = __builtin_bit_cast(float, q.z & 0xffff0000u); xb[2] = __builtin_bit_cast(float, q.w << 16); xb[3] = __builtin_bit_cast(float, q.w & 0xffff0000u);
                    const f32x4 x0 = xa * gi[bj][0] * ri[m] + acc[ai][bj][m][0], x1 = xb * gi[bj][1] * ri[m] + acc[ai][bj][m][1];
                    u32x4_t w; w.x = cvt_pk_bf16(x0[0], x0[1]); w.y = cvt_pk_bf16(x0[2], x0[3]); w.z = cvt_pk_bf16(x1[0], x1[1]); w.w = cvt_pk_bf16(x1[2], x1[3]);
                    *(u32x4_t*)(out + off + bj * HALF) = w;
                    w8[m & 1][bj].x = pk4_fp8(x0[0], x0[1], x0[2], x0[3]); w8[m & 1][bj].y = pk4_fp8(x1[0], x1[1], x1[2], x1[3]); }
                if (m & 1) {
#pragma unroll
                    for (int bj = 0; bj < 2; ++bj) *(u32x4_t*)(out8 + (size_t)(row0 + ai * HALF + ((m & ~1) + (fq & 1)) * 16) * 1024 + u.pn * BM + wc * 32 + 8 * (fq & ~1) + bj * HALF) = widen_rows16(w8[0][bj], w8[1][bj]); } }
        }
    }
};
struct EpiSwiGLU {
    static constexpr bool PERM = true, AFTER_DRAIN = false;
    unsigned char* act; const float* bgu; const float* rscale; const __attribute__((address_space(3))) int* tstart;
    __device__ __forceinline__ void prefetch(const Unit& nu, PG8_LAS unsigned char* buf, int wid, int lane) const {
        const int e = nu.pn >> 3, pnl = nu.pn & 7;
        if (wid == 0) { const float* src = bgu + (size_t)e * 2048 + 128 * pnl + ((lane < 32) ? 4 * lane : 1024 + 4 * (lane - 32));
            __builtin_amdgcn_global_load_lds((const unsigned*)src, (PG8_LAS unsigned*)buf, 16, 0, 0); }
        if (wid == 1) { const float* src = rscale + (size_t)e * 32768 + (size_t)(nu.pm - tstart[e]) * BM + 4 * lane;
            __builtin_amdgcn_global_load_lds((const unsigned*)src, (PG8_LAS unsigned*)(buf + 1024), 16, 0, 0); }
    }
    __device__ __forceinline__ void operator()(const f32x4 (&acc)[2][2][4][2], const Unit& u, int wr, int wc, int fr, int fq, const PG8_LAS unsigned char* buf) const {
        const int pnl = u.pn & 7;
        const int row0 = u.pm * BM + wr * 64 + fr;
        f32x4 bg[2], bu[2];
#pragma unroll
        for (int n = 0; n < 2; ++n) { bg[n] = *(const PG8_LAS f32x4*)(buf + (32 * wc + 8 * fq + 4 * n) * 4); bu[n] = *(const PG8_LAS f32x4*)(buf + 512 + (32 * wc + 8 * fq + 4 * n) * 4); }
        float rsv[2][4]; u32x2_t wq[2];
#pragma unroll
        for (int ai = 0; ai < 2; ++ai)
#pragma unroll
            for (int m = 0; m < 4; ++m) rsv[ai][m] = *(const PG8_LAS float*)(buf + 1024 + (ai * HALF + wr * 64 + m * 16 + fr) * 4);
#pragma unroll
        for (int ai = 0; ai < 2; ++ai)
#pragma unroll
            for (int m = 0; m < 4; ++m) {
                const float rs = rsv[ai][m] * 0.03125f;
                f32x2 o[4];
#pragma unroll
                for (int n = 0; n < 2; ++n)
#pragma unroll
                    for (int h = 0; h < 2; ++h) {
                        const f32x2 a = {acc[ai][0][m][n][2 * h], acc[ai][0][m][n][2 * h + 1]}, b = {acc[ai][1][m][n][2 * h], acc[ai][1][m][n][2 * h + 1]};
                        const f32x2 bgp = {bg[n][2 * h], bg[n][2 * h + 1]}, bup = {bu[n][2 * h], bu[n][2 * h + 1]};
                        const f32x2 gv = a * rs + bgp, uv = b * rs + bup;
                        f32x2 g, up; g.x = fminf(gv.x, 7.0f); g.y = fminf(gv.y, 7.0f); up.x = __builtin_amdgcn_fmed3f(uv.x, -7.0f, 7.0f); up.y = __builtin_amdgcn_fmed3f(uv.y, -7.0f, 7.0f);
                        const f32x2 tt = g * (-1.702f * 1.4426950408889634f);
                        f32x2 ex; ex.x = __builtin_amdgcn_exp2f(tt.x); ex.y = __builtin_amdgcn_exp2f(tt.y);
                        const f32x2 dd = ex + 1.0f;
                        f32x2 rr; rr.x = __builtin_amdgcn_rcpf(dd.x); rr.y = __builtin_amdgcn_rcpf(dd.y);
                        o[2 * n + h] = (up + 1.0f) * (g * rr);
                    }
                wq[m & 1].x = pk4_fp8(o[0].x, o[0].y, o[1].x, o[1].y); wq[m & 1].y = pk4_fp8(o[2].x, o[2].y, o[3].x, o[3].y);
                if (m & 1) *(u32x4_t*)(act + (size_t)(row0 + ai * HALF + ((m & ~1) + (fq & 1)) * 16) * 1024 + 128 * pnl + 32 * wc + 8 * (fq & ~1)) = widen_rows16(wq[0], wq[1]);
            }
    }
};
struct EpiOut8 {
    static constexpr bool PERM = true, AFTER_DRAIN = false;
    unsigned char* out; const float* bias32;
    __device__ __forceinline__ void prefetch(const Unit& nu, PG8_LAS unsigned char* buf, int wid, int lane) const {
        if (wid == 0) { const float* src = bias32 + (size_t)(nu.pn >> 2) * 1024 + 256 * (nu.pn & 3) + 4 * lane;
            __builtin_amdgcn_global_load_lds((const unsigned*)src, (PG8_LAS unsigned*)buf, 16, 0, 0); }
    }
    __device__ __forceinline__ void operator()(const f32x4 (&acc)[2][2][4][2], const Unit& u, int wr, int wc, int fr, int fq, const PG8_LAS unsigned char* buf) const {
        const int pnl = u.pn & 3;
        const int row0 = u.pm * BM + wr * 64 + fr;
        f32x4 bv[2][2];
#pragma unroll
        for (int bj = 0; bj < 2; ++bj)
#pragma unroll
            for (int n = 0; n < 2; ++n) bv[bj][n] = *(const PG8_LAS f32x4*)(buf + (bj * HALF + 32 * wc + 8 * fq + 4 * n) * 4);
        const int odd = fq & 1, colw = 256 * pnl + 32 * wc + 8 * (fq & ~1);
#pragma unroll
        for (int ai = 0; ai < 2; ++ai)
#pragma unroll
            for (int mp = 0; mp < 2; ++mp) { unsigned char* rowp = out + (size_t)(row0 + ai * HALF + (2 * mp + odd) * 16) * 1024 + colw;
#pragma unroll
                for (int bj = 0; bj < 2; ++bj) { u32x2_t w[2];
#pragma unroll
                    for (int q = 0; q < 2; ++q) { const int m = 2 * mp + q; const f32x4 v0 = (acc[ai][bj][m][0] + bv[bj][0]) * 0.25f, v1 = (acc[ai][bj][m][1] + bv[bj][1]) * 0.25f;
                        w[q].x = pk4_fp8(v0[0], v0[1], v0[2], v0[3]); w[q].y = pk4_fp8(v1[0], v1[1], v1[2], v1[3]); }
                    *(u32x4_t*)(rowp + bj * HALF) = widen_rows16(w[0], w[1]); } }
    }
};
struct MoeOrder {
    int ntiles, npn, nwg, G, c; const __attribute__((address_space(3))) int* texp;
    __device__ void init(int ntiles_, int npn_, int G_, int c_, const __attribute__((address_space(3))) int* texp_) { ntiles = ntiles_; npn = npn_; nwg = ntiles_ * npn_; G = G_; c = c_; texp = texp_; }
    __device__ bool next(int i, Unit& u) const {
        const long L = (long)i * G + c; if (L >= nwg) return false;
        int wgid = (int)L; { const int q = nwg / NXCD, r = nwg % NXCD, xcd = wgid % NXCD, off = wgid / NXCD; wgid = (xcd < r ? xcd * (q + 1) : r * (q + 1) + (xcd - r) * q) + off; }
        constexpr int WG2 = 4; const int nig = WG2 * npn, gid = wgid / nig, fm = gid * WG2, gsz = (ntiles - fm) < WG2 ? (ntiles - fm) : WG2;
        const int t = fm + ((wgid % nig) % gsz), pnl = (wgid % nig) / gsz;
        const int e = texp[t];
        u.pm = t; u.pn = e * npn + pnl; return true;
    }
    __device__ __forceinline__ void a_ready(const Unit&) const {}
    __device__ __forceinline__ void done(const Unit&) const {}
};
template <class Epi, class Sched, bool ALIGN_EPI = false, bool SP2 = false>
__device__ __forceinline__ void gemm_phase(PG8_LAS unsigned char* lds, const Gemm g, const Sched& S, const Epi& E) {
    const int tid = threadIdx.x, wid = __builtin_amdgcn_readfirstlane(tid >> 6), lane = tid & 63, wr = wid >> 2, wc = wid & 3, fr = lane & 15, fq = lane >> 4;
    const int K = g.K, nt = K / BK;
    unsigned voffA[2], voffB[2];
#pragma unroll
    for (int i = 0; i < 2; ++i) { int R, C; stage_rc(tid * 16 + i * 8192, R, C); const int Rb = Epi::PERM ? ((R & ~31) + perm32(R & 31)) : R;
        voffA[i] = (unsigned)(R * K + C) * 2u; voffB[i] = (unsigned)(Rb * K + C) * 2u; }
    const size_t kstep = (size_t)(BK * 2);
    const size_t hstep = (size_t)HALF * K * 2;
    const size_t tstep = 2 * hstep;
    const unsigned ldsw = (unsigned)wid * 1024u;
    const int aoff = lds_byte(wr * 64 + fr, fq * 8), boff = lds_byte(wc * 32 + fr, fq * 8);
#define PG8_SA(b, h) (((b) * 2 + (h)) * HTB)
#define PG8_SB(b, h) ((4 + (b) * 2 + (h)) * HTB)
#define PG8_STAGE(bufoff, gbase, voff) do { _Pragma("unroll") for (int _i = 0; _i < 2; ++_i) \
        __builtin_amdgcn_global_load_lds((const unsigned*)((const char*)(gbase) + (voff)[_i]), (PG8_LAS unsigned*)(lds + (bufoff) + ldsw + _i * 8192), 16, 0, 0); } while (0)
#define PG8_LDA(dst, b, h) do { _Pragma("unroll") for (int m = 0; m < 4; ++m) _Pragma("unroll") for (int k = 0; k < 2; ++k) dst[m][k] = *(const PG8_LAS bf16x8*)(lds + PG8_SA(b, h) + aoff + m * 2048 + k * 1024); } while (0)
#define PG8_LDB(dst, b, h) do { _Pragma("unroll") for (int n = 0; n < 2; ++n) _Pragma("unroll") for (int k = 0; k < 2; ++k) dst[n][k] = *(const PG8_LAS bf16x8*)(lds + PG8_SB(b, h) + boff + n * 2048 + k * 1024); } while (0)
#define PG8_MMA(ai, bj, At, Bt) do { __builtin_amdgcn_s_setprio(1); _Pragma("unroll") for (int m = 0; m < 4; ++m) _Pragma("unroll") for (int n = 0; n < 2; ++n) _Pragma("unroll") for (int k = 0; k < 2; ++k) \
        acc[ai][bj][m][n] = __builtin_amdgcn_mfma_f32_16x16x32_bf16(Bt[n][k], At[m][k], acc[ai][bj][m][n], 0, 0, 0); __builtin_amdgcn_s_setprio(0); } while (0)
#define PG8_WAIT_V(n) asm volatile("s_waitcnt vmcnt(" #n ")" ::: "memory")
#define PG8_WAIT_L(n) asm volatile("s_waitcnt lgkmcnt(" #n ")" ::: "memory")
#define PG8_BAR __builtin_amdgcn_s_barrier()
#define PG8_SCHED __builtin_amdgcn_sched_barrier(0)
    Unit cur, nxt; int ui = 0;
    if (!S.next(0, cur)) return;
    f32x4 acc[2][2][4][2];
#pragma unroll
    for (int a = 0; a < 2; ++a)
#pragma unroll
        for (int b = 0; b < 2; ++b)
#pragma unroll
            for (int m = 0; m < 4; ++m)
#pragma unroll
                for (int n = 0; n < 2; ++n) acc[a][b][m][n] = (f32x4){0.f, 0.f, 0.f, 0.f};
    bf16x8 At[4][2], B0[2][2], B1[2][2];
    const char* cA = (const char*)g.A + (size_t)cur.pm * tstep; const char* cB = (const char*)g.Bt + (size_t)cur.pn * tstep;
    S.a_ready(cur);
    if constexpr (SP2) {
        PG8_STAGE(PG8_SB(0, 0), cB, voffB); PG8_STAGE(PG8_SB(0, 1), cB + hstep, voffB); PG8_STAGE(PG8_SA(0, 0), cA, voffA); PG8_STAGE(PG8_SA(0, 1), cA + hstep, voffA);
        if (wr == 1) PG8_BAR;
        PG8_WAIT_V(2); PG8_BAR;
        PG8_STAGE(PG8_SB(1, 0), cB + kstep, voffB); PG8_STAGE(PG8_SA(1, 0), cA + kstep, voffA); PG8_STAGE(PG8_SB(1, 1), cB + hstep + kstep, voffB);
        PG8_WAIT_V(6); PG8_BAR;
    } else {
        PG8_STAGE(PG8_SB(0, 0), cB, voffB); PG8_STAGE(PG8_SA(0, 0), cA, voffA); PG8_STAGE(PG8_SB(0, 1), cB + hstep, voffB); PG8_STAGE(PG8_SA(0, 1), cA + hstep, voffA);
        if (wr == 1) PG8_BAR;
        PG8_WAIT_V(4); PG8_BAR;
        PG8_STAGE(PG8_SB(1, 0), cB + kstep, voffB); PG8_STAGE(PG8_SA(1, 0), cA + kstep, voffA); PG8_STAGE(PG8_SB(1, 1), cB + hstep + kstep, voffB);
        PG8_WAIT_V(6); PG8_BAR;
    }
    for (;;) {
        const bool has_next = S.next(ui + 1, nxt);
        const char* nA = has_next ? (const char*)g.A + (size_t)nxt.pm * tstep : cA; const char* nB = has_next ? (const char*)g.Bt + (size_t)nxt.pn * tstep : cB;
        for (int t = 0; t < nt; t += 2) {
            const bool last = (t == nt - 2);
            const char* a1 = cA + (size_t)(t + 1) * kstep;
            const char* a2 = last ? nA : cA + (size_t)(t + 2) * kstep; const char* b2 = last ? nB : cB + (size_t)(t + 2) * kstep;
            const char* a3 = a2 + kstep; const char* b3 = b2 + kstep;
            if (last && has_next) S.a_ready(nxt);
            if constexpr (SP2) {
            PG8_LDB(B0, 0, 0); PG8_LDB(B1, 0, 1); PG8_SCHED; PG8_LDA(At, 0, 0); PG8_STAGE(PG8_SA(1, 1), a1 + hstep, voffA);
            PG8_WAIT_V(8); PG8_WAIT_L(0); PG8_BAR; PG8_MMA(0, 0, At, B0); PG8_MMA(0, 1, At, B1); PG8_BAR; PG8_SCHED;
            PG8_LDA(At, 0, 1); PG8_STAGE(PG8_SB(0, 0), b2, voffB); PG8_STAGE(PG8_SB(0, 1), b2 + hstep, voffB); PG8_STAGE(PG8_SA(0, 0), a2, voffA);
            PG8_WAIT_V(8); PG8_WAIT_L(0); PG8_BAR; PG8_MMA(1, 0, At, B0); PG8_MMA(1, 1, At, B1); PG8_BAR; PG8_SCHED;
            PG8_LDB(B0, 1, 0); PG8_LDB(B1, 1, 1); PG8_SCHED; PG8_LDA(At, 1, 0); PG8_STAGE(PG8_SA(0, 1), a2 + hstep, voffA);
            PG8_WAIT_V(8); PG8_WAIT_L(0); PG8_BAR; PG8_MMA(0, 0, At, B0); PG8_MMA(0, 1, At, B1); PG8_BAR; PG8_SCHED;
            PG8_LDA(At, 1, 1); PG8_STAGE(PG8_SB(1, 0), b3, voffB); PG8_STAGE(PG8_SB(1, 1), b3 + hstep, voffB); PG8_STAGE(PG8_SA(1, 0), a3, voffA);
            PG8_WAIT_V(8); PG8_WAIT_L(0); PG8_BAR; PG8_MMA(1, 0, At, B0); PG8_MMA(1, 1, At, B1); PG8_BAR; PG8_SCHED;
            } else {
            PG8_LDB(B0, 0, 0); PG8_SCHED; PG8_LDA(At, 0, 0); PG8_STAGE(PG8_SA(1, 1), a1 + hstep, voffA);
            PG8_WAIT_L(8); PG8_BAR; PG8_WAIT_L(0); PG8_MMA(0, 0, At, B0); PG8_BAR; PG8_SCHED;
            PG8_LDB(B1, 0, 1); PG8_STAGE(PG8_SB(0, 0), b2, voffB);
            PG8_BAR; PG8_WAIT_L(0); PG8_MMA(0, 1, At, B1); PG8_BAR;
            PG8_LDA(At, 0, 1); PG8_STAGE(PG8_SA(0, 0), a2, voffA);
            PG8_BAR; PG8_WAIT_L(0); PG8_MMA(1, 0, At, B0); PG8_BAR; PG8_SCHED;
            PG8_STAGE(PG8_SB(0, 1), b2 + hstep, voffB);
            PG8_WAIT_V(6); PG8_BAR; PG8_MMA(1, 1, At, B1); PG8_BAR;
            PG8_LDB(B0, 1, 0); PG8_SCHED; PG8_LDA(At, 1, 0); PG8_STAGE(PG8_SA(0, 1), a2 + hstep, voffA);
            PG8_WAIT_L(8); PG8_BAR; PG8_WAIT_L(0); PG8_MMA(0, 0, At, B0); PG8_BAR; PG8_SCHED;
            PG8_LDB(B1, 1, 1); PG8_STAGE(PG8_SB(1, 0), b3, voffB);
            PG8_BAR; PG8_WAIT_L(0); PG8_MMA(0, 1, At, B1); PG8_BAR;
            PG8_LDA(At, 1, 1); PG8_STAGE(PG8_SA(1, 0), a3, voffA);
            PG8_BAR; PG8_WAIT_L(0); PG8_MMA(1, 0, At, B0); PG8_BAR; PG8_SCHED;
            PG8_STAGE(PG8_SB(1, 1), b3 + hstep, voffB);
            PG8_WAIT_V(6); PG8_BAR; PG8_MMA(1, 1, At, B1); PG8_BAR;
            }
        }
        if constexpr (ALIGN_EPI) { if (wr == 0) PG8_BAR; }
        if constexpr (!Epi::AFTER_DRAIN) { E(acc, cur, wr, wc, fr, fq); S.done(cur); }
        if (!has_next) break;
#pragma unroll
        for (int a = 0; a < 2; ++a)
#pragma unroll
            for (int b = 0; b < 2; ++b)
#pragma unroll
                for (int m = 0; m < 4; ++m)
#pragma unroll
                    for (int n = 0; n < 2; ++n) acc[a][b][m][n] = (f32x4){0.f, 0.f, 0.f, 0.f};
        cur = nxt; cA = nA; cB = nB; ++ui;
        if constexpr (ALIGN_EPI) { if (wr == 1) PG8_BAR; }
    }
    PG8_WAIT_V(0);
    if constexpr (!ALIGN_EPI) { if (wr == 0) PG8_BAR; }
    PG8_BAR;
    if constexpr (Epi::AFTER_DRAIN) { E.fused(acc, cur, wr, wc, fr, fq, lds, wid, lane); S.done(cur); }
#undef PG8_SA
#undef PG8_SB
#undef PG8_STAGE
#undef PG8_LDA
#undef PG8_LDB
#undef PG8_CAT
#undef PG8_MMA
#undef PG8_WAIT_V
#undef PG8_WAIT_L
#undef PG8_BAR
#undef PG8_SCHED
}

typedef int i32x4_t __attribute__((ext_vector_type(4)));
typedef int i32x8_t __attribute__((ext_vector_type(8)));
template <class Epi, class Sched, bool GATHER, bool FP8, int SCALE_B = 127>
__device__ __forceinline__ void gemm_phase2(PG8_LAS unsigned char* lds, const void* Aptr, const void* Btptr, int pitchA, int pitchB, int nt, const Sched& S, const Epi& E, const PG8_LAS unsigned* idxtab, PG8_LAS unsigned char* ebuf) {
    const int tid = threadIdx.x, wid = __builtin_amdgcn_readfirstlane(tid >> 6), lane = tid & 63, wr = wid >> 2, wc = wid & 3, fr = lane & 15, fq = lane >> 4;
    unsigned voffB[2], cA2[2]; int RA[2];
#pragma unroll
    for (int i = 0; i < 2; ++i) { int R, C; stage_rc(tid * 16 + i * 8192, R, C); const int Rb = Epi::PERM ? ((R & ~31) + perm32(R & 31)) : R;
        voffB[i] = (unsigned)(Rb * pitchB + C * 2); RA[i] = R; cA2[i] = (unsigned)(C * 2); }
    const size_t kstep = 128;
    const size_t hstepB = (size_t)HALF * pitchB, tstepB = 2 * hstepB, tstepA = (size_t)BM * pitchA;
    const unsigned ldsw = (unsigned)wid * 1024u;
    const int aoff = lds_byte(wr * 64 + fr, fq * 8), boff = lds_byte(wc * 32 + fr, fq * 8);
#define PG8_SA(b, h) (((b) * 2 + (h)) * HTB)
#define PG8_SB(b, h) ((4 + (b) * 2 + (h)) * HTB)
#define PG8_STAGE(bufoff, gbase, voff) do { _Pragma("unroll") for (int _i = 0; _i < 2; ++_i) \
        __builtin_amdgcn_global_load_lds((const unsigned*)((const char*)(gbase) + (voff)[_i]), (PG8_LAS unsigned*)(lds + (bufoff) + ldsw + _i * 8192), 16, 0, 0); } while (0)
#define PG8_LDA(dst, b, h) do { _Pragma("unroll") for (int m = 0; m < 4; ++m) _Pragma("unroll") for (int k = 0; k < 2; ++k) dst[m][k] = *(const PG8_LAS bf16x8*)(lds + PG8_SA(b, h) + aoff + m * 2048 + k * 1024); } while (0)
#define PG8_LDB(dst, b, h) do { _Pragma("unroll") for (int n = 0; n < 2; ++n) _Pragma("unroll") for (int k = 0; k < 2; ++k) dst[n][k] = *(const PG8_LAS bf16x8*)(lds + PG8_SB(b, h) + boff + n * 2048 + k * 1024); } while (0)
#define PG8_CAT(x0, x1) __builtin_shufflevector(__builtin_bit_cast(i32x4_t, x0), __builtin_bit_cast(i32x4_t, x1), 0, 1, 2, 3, 4, 5, 6, 7)
#define PG8_MMA(ai, bj, At, Bt) do { __builtin_amdgcn_s_setprio(1); \
        if constexpr (FP8) { _Pragma("unroll") for (int m = 0; m < 4; ++m) _Pragma("unroll") for (int n = 0; n < 2; ++n) \
            asm volatile("s_nop 1\n\tv_mfma_f32_16x16x128_f8f6f4 %0, %1, %2, %0" : "+v"(acc[ai][bj][m][n]) : "v"(PG8_CAT(Bt[n][0], Bt[n][1])), "v"(PG8_CAT(At[m][0], At[m][1]))); } \
        else { _Pragma("unroll") for (int m = 0; m < 4; ++m) _Pragma("unroll") for (int n = 0; n < 2; ++n) _Pragma("unroll") for (int k = 0; k < 2; ++k) \
            acc[ai][bj][m][n] = __builtin_amdgcn_mfma_f32_16x16x32_bf16(Bt[n][k], At[m][k], acc[ai][bj][m][n], 0, 0, 0); } \
        __builtin_amdgcn_s_setprio(0); } while (0)
#define PG8_WAIT_V(n) asm volatile("s_waitcnt vmcnt(" #n ")" ::: "memory")
#define PG8_WAIT_L(n) asm volatile("s_waitcnt lgkmcnt(" #n ")" ::: "memory")
#define PG8_BAR __builtin_amdgcn_s_barrier()
#define PG8_SCHED __builtin_amdgcn_sched_barrier(0)
    Unit cur, nxt; int ui = 0;
    if (!S.next(0, cur)) return;
    f32x4 acc[2][2][4][2];
#pragma unroll
    for (int a = 0; a < 2; ++a)
#pragma unroll
        for (int b = 0; b < 2; ++b)
#pragma unroll
            for (int m = 0; m < 4; ++m)
#pragma unroll
                for (int n = 0; n < 2; ++n) acc[a][b][m][n] = (f32x4){0.f, 0.f, 0.f, 0.f};
    bf16x8 At[4][2], B0[2][2], B1[2][2];
    unsigned va[2][2], vn[2][2];
#pragma unroll
    for (int h = 0; h < 2; ++h)
#pragma unroll
        for (int i = 0; i < 2; ++i) { va[h][i] = GATHER ? idxtab[h * HALF + RA[i]] + cA2[i] : (unsigned)((RA[i] + h * HALF) * pitchA) + cA2[i]; vn[h][i] = va[h][i]; }
    const char* cA = (const char*)Aptr + (GATHER ? (size_t)0 : (size_t)cur.pm * tstepA); const char* cB = (const char*)Btptr + (size_t)cur.pn * tstepB;
    S.a_ready(cur);
    E.prefetch(cur, ebuf, wid, lane);
    PG8_STAGE(PG8_SB(0, 0), cB, voffB); PG8_STAGE(PG8_SB(0, 1), cB + hstepB, voffB); PG8_STAGE(PG8_SA(0, 0), cA, va[0]); PG8_STAGE(PG8_SA(0, 1), cA, va[1]);
    if (wr == 1) PG8_BAR;
    PG8_WAIT_V(2); PG8_BAR;
    PG8_STAGE(PG8_SB(1, 0), cB + kstep, voffB); PG8_STAGE(PG8_SA(1, 0), cA + kstep, va[0]); PG8_STAGE(PG8_SB(1, 1), cB + hstepB + kstep, voffB);
    PG8_WAIT_V(6); PG8_BAR;
    for (;;) {
        const bool has_next = S.next(ui + 1, nxt);
        const char* nA = (GATHER || !has_next) ? cA : (const char*)Aptr + (size_t)nxt.pm * tstepA; const char* nB = has_next ? (const char*)Btptr + (size_t)nxt.pn * tstepB : cB;
        if (GATHER && has_next) {
#pragma unroll
            for (int h = 0; h < 2; ++h)
#pragma unroll
                for (int i = 0; i < 2; ++i) vn[h][i] = idxtab[(ui + 1) * BM + h * HALF + RA[i]] + cA2[i];
        }
#pragma unroll 1
        for (int t = 0; t < nt; t += 2) {
            const bool last = (t == nt - 2);
            const char* a1 = cA + (size_t)(t + 1) * kstep;
            const char* a2 = last ? nA : cA + (size_t)(t + 2) * kstep; const char* b2 = last ? nB : cB + (size_t)(t + 2) * kstep;
            const char* a3 = a2 + kstep; const char* b3 = b2 + kstep;
            unsigned s2[2][2];
#pragma unroll
            for (int h = 0; h < 2; ++h)
#pragma unroll
                for (int i = 0; i < 2; ++i) s2[h][i] = (GATHER && last) ? vn[h][i] : va[h][i];
            if (last && has_next) S.a_ready(nxt);
            PG8_LDB(B0, 0, 0); PG8_LDB(B1, 0, 1); PG8_SCHED; PG8_LDA(At, 0, 0); PG8_STAGE(PG8_SA(1, 1), a1, va[1]);
            PG8_WAIT_V(8); PG8_WAIT_L(0); PG8_BAR; PG8_MMA(0, 0, At, B0); PG8_MMA(0, 1, At, B1); PG8_BAR; PG8_SCHED;
            PG8_LDA(At, 0, 1); PG8_STAGE(PG8_SB(0, 0), b2, voffB); PG8_STAGE(PG8_SB(0, 1), b2 + hstepB, voffB); PG8_STAGE(PG8_SA(0, 0), a2, s2[0]);
            PG8_WAIT_V(8); PG8_WAIT_L(0); PG8_BAR; PG8_MMA(1, 0, At, B0); PG8_MMA(1, 1, At, B1); PG8_BAR; PG8_SCHED;
            PG8_LDB(B0, 1, 0); PG8_LDB(B1, 1, 1); PG8_SCHED; PG8_LDA(At, 1, 0); PG8_STAGE(PG8_SA(0, 1), a2, s2[1]);
            PG8_WAIT_V(8); PG8_WAIT_L(0); PG8_BAR; PG8_MMA(0, 0, At, B0); PG8_MMA(0, 1, At, B1); PG8_BAR; PG8_SCHED;
            PG8_LDA(At, 1, 1); PG8_STAGE(PG8_SB(1, 0), b3, voffB); PG8_STAGE(PG8_SB(1, 1), b3 + hstepB, voffB); PG8_STAGE(PG8_SA(1, 0), a3, s2[0]);
            PG8_WAIT_V(8); PG8_WAIT_L(0); PG8_BAR; PG8_MMA(1, 0, At, B0); PG8_MMA(1, 1, At, B1); PG8_BAR; PG8_SCHED;
        }
        if (wr == 0) PG8_BAR;
        if constexpr (FP8) { asm volatile("s_nop 15\n\ts_nop 7" ::: "memory"); PG8_SCHED; }
        if (has_next) E.prefetch(nxt, ebuf + ((ui + 1) & 1) * 2048, wid, lane);
        E(acc, cur, wr, wc, fr, fq, ebuf + (ui & 1) * 2048); S.done(cur);
        if (!has_next) break;
#pragma unroll
        for (int a = 0; a < 2; ++a)
#pragma unroll
            for (int b = 0; b < 2; ++b)
#pragma unroll
                for (int m = 0; m < 4; ++m)
#pragma unroll
                    for (int n = 0; n < 2; ++n) acc[a][b][m][n] = (f32x4){0.f, 0.f, 0.f, 0.f};
        cur = nxt; cA = nA; cB = nB; ++ui;
#pragma unroll
        for (int h = 0; h < 2; ++h)
#pragma unroll
            for (int i = 0; i < 2; ++i) va[h][i] = vn[h][i];
        if (wr == 1) PG8_BAR;
    }
    PG8_WAIT_V(0);
    PG8_BAR;
#undef PG8_SA
#undef PG8_SB
#undef PG8_STAGE
#undef PG8_LDA
#undef PG8_LDB
#undef PG8_CAT
#undef PG8_MMA
#undef PG8_WAIT_V
#undef PG8_WAIT_L
#undef PG8_BAR
#undef PG8_SCHED
}
}
#define GAS __attribute__((address_space(1)))
#define LAS __attribute__((address_space(3)))
typedef unsigned short bf16;
typedef unsigned v4u __attribute__((ext_vector_type(4)));
typedef float f32x4 __attribute__((ext_vector_type(4)));
typedef short bf16x8 __attribute__((ext_vector_type(8)));
typedef GAS unsigned gu32;
typedef GAS unsigned long long gu64;
#define RLX_AGENT __ATOMIC_RELAXED, __HIP_MEMORY_SCOPE_AGENT
#define LDS_WAIT() asm volatile("s_waitcnt lgkmcnt(0)" ::: "memory")
#define VM_WAIT() asm volatile("s_waitcnt vmcnt(0)" ::: "memory")
__device__ __forceinline__ unsigned long long rt() { return __builtin_amdgcn_s_memrealtime(); }
__device__ __forceinline__ unsigned f2bf(float f) { unsigned u = __builtin_bit_cast(unsigned, f); return (u + 0x7fffu + ((u >> 16) & 1u)) >> 16; }
__device__ __forceinline__ unsigned pk2(float lo, float hi) { return f2bf(lo) | (f2bf(hi) << 16); }

#define XB_TMO      128
#define XB_XCNT(j)  (256  + 64 * (j))
#define XB_XSUB(j)  (1280 + 64 * (j))
#define XB_XGEN(j)  (2304 + 64 * (j))
#define XB_TOP      3328
#define XB_TOPGEN   3392
#define XCD_BAR_WORDS 3456
#define XB_SPIN_CAP (1u << 18)

__device__ __forceinline__ unsigned xb_ld(unsigned* p)              { return __hip_atomic_load(p, __ATOMIC_RELAXED, __HIP_MEMORY_SCOPE_AGENT); }
__device__ __forceinline__ unsigned xb_add(unsigned* p, unsigned v) { return __hip_atomic_fetch_add(p, v, __ATOMIC_RELAXED, __HIP_MEMORY_SCOPE_AGENT); }
__device__ __forceinline__ unsigned xb_xcc_id() { return (unsigned)__builtin_amdgcn_s_getreg((3 << 11) | 20) & 0xFu; }
#define XB_SPIN(cond, bar) do { unsigned _sp = 0; while (cond) { __builtin_amdgcn_s_sleep(1); \
    if ((++_sp & 255u) == 0u) { if (xb_ld(&(bar)[XB_TMO])) break; if (_sp > XB_SPIN_CAP) { atomicAdd(&(bar)[XB_TMO], 1u); break; } } } } while (0)

struct XcdBarrier {
    unsigned* bar; unsigned x;
    volatile LAS unsigned* st;
};

__device__ __forceinline__ XcdBarrier xcd_barrier_post(unsigned* bar, volatile LAS unsigned* st) {
    XcdBarrier b; b.bar = bar; b.x = xb_xcc_id(); b.st = st;
    if (threadIdx.x == 0) (void)xb_add(&bar[XB_XCNT(b.x)], 1u);
    return b;
}
__device__ __forceinline__ void xcd_barrier_complete(unsigned* bar, unsigned x, unsigned& nloc, unsigned& nx) {
    const unsigned G = gridDim.x * gridDim.y * gridDim.z;
    unsigned sum, cnt, mine, sp = 0u;
    for (;;) {
        sum = 0u; cnt = 0u; mine = 0u;
#pragma unroll
        for (unsigned j = 0; j < 16; ++j) { const unsigned c = xb_ld(&bar[XB_XCNT(j)]); sum += c; cnt += (c > 0u) ? 1u : 0u; mine = (j == x) ? c : mine; }
        if (sum == G) break;
        __builtin_amdgcn_s_sleep(1);
        if ((++sp & 255u) == 0u) { if (xb_ld(&bar[XB_TMO])) break; if (sp > XB_SPIN_CAP) { atomicAdd(&bar[XB_TMO], 1u); break; } }
    }
    nloc = mine > 0u ? mine : 1u; nx = cnt > 0u ? cnt : 1u;
}

__device__ __forceinline__ void xcd_barrier(const XcdBarrier& b) {
    asm volatile("s_waitcnt vmcnt(0)" ::: "memory");
    __syncthreads();
    if (threadIdx.x == 0) {
        unsigned* bar = b.bar;
        __builtin_amdgcn_s_waitcnt(0);
        unsigned nloc = b.st[0], nx = b.st[1];
        if (nloc == 0u) { xcd_barrier_complete(bar, b.x, nloc, nx); b.st[0] = nloc; b.st[1] = nx; }
        const unsigned old = xb_add(&bar[XB_XSUB(b.x)], 1u);
        const unsigned gen = old / nloc;
        if (old + 1u == (gen + 1u) * nloc) {
            __builtin_amdgcn_fence(__ATOMIC_RELEASE, "agent");
            asm volatile("s_waitcnt vmcnt(0)" ::: "memory");
            const unsigned og = xb_add(&bar[XB_TOP], 1u);
            const unsigned tg = og / nx;
            if (og + 1u == (tg + 1u) * nx) xb_add(&bar[XB_TOPGEN], 1u);
            else XB_SPIN(xb_ld(&bar[XB_TOPGEN]) == tg, bar);
            __builtin_amdgcn_fence(__ATOMIC_ACQUIRE, "agent");
            xb_add(&bar[XB_XGEN(b.x)], 1u);
            asm volatile("s_waitcnt vmcnt(0)" ::: "memory");
        } else {
            XB_SPIN(xb_ld(&bar[XB_XGEN(b.x)]) == gen, bar);
            __builtin_amdgcn_fence(__ATOMIC_ACQUIRE, "agent");
            asm volatile("s_waitcnt vmcnt(0)" ::: "memory");
        }
    }
    __syncthreads();
}

constexpr size_t MiB = 1u << 20;
constexpr size_t WS_CTL = 0, CTL_ZERO_BYTES = 1 * MiB;
constexpr size_t WS_ROPE = 1 * MiB;
constexpr size_t WS_WRH = 3 * MiB;
constexpr size_t WS_BDN32 = 3 * MiB + 256 * 1024;
constexpr size_t WS_ONES = 3 * MiB + 512 * 1024;
constexpr size_t WS_GINV = 3 * MiB + 640 * 1024;
constexpr size_t WS_RINV = 3 * MiB + 768 * 1024;
constexpr size_t WS_TOPI = 4 * MiB;
constexpr size_t WS_GATE = WS_TOPI + 512 * 1024;
constexpr size_t WS_OFF = WS_GATE + 512 * 1024;
constexpr size_t WS_WIN = 8 * MiB;
constexpr size_t WS_WOUT = 14 * MiB;
constexpr size_t WS_WGU = 16 * MiB;
constexpr size_t WS_WDN = 144 * MiB;
constexpr size_t WS_XN = 208 * MiB;
constexpr size_t WS_QKV = 272 * MiB;
constexpr size_t WS_OP = 464 * MiB;
constexpr size_t WS_LSE = 560 * MiB;
constexpr size_t WS_XB = 272 * MiB;
constexpr size_t WS_ACT = 564 * MiB;
constexpr size_t WS_H16 = 836 * MiB;
constexpr size_t WS_H8 = 908 * MiB;
constexpr size_t WS_ROWTOK = 900 * MiB;
constexpr size_t WS_RSCALE = 904 * MiB;
constexpr size_t WS_MIX = 940 * MiB;
constexpr size_t WS_END = 1004 * MiB;
static_assert(WS_OFF + 512 * 1024 <= WS_WIN && WS_XB + (size_t)PMAX * 2048 <= WS_LSE + 3 * MiB && WS_LSE + 3 * MiB <= WS_ACT && WS_ACT + (size_t)PMAX * 2048 <= WS_H16, "ws map");
constexpr size_t QKV_STRIDE = (size_t)T * 512;
constexpr int CW_FILL = 64;
constexpr int CW_BAR = 4096;

constexpr int RING_OFF = 0, RING_BYTES = 131072;
constexpr int MISC_OFF = RING_BYTES;
constexpr int LDS_TSTART = MISC_OFF + 256;
constexpr int LDS_TEXP = MISC_OFF + 512;
constexpr int LDS_TCNT = MISC_OFF + 128;
constexpr int LDS_WSC = MISC_OFF + 4096;
constexpr int LDS_IDX = MISC_OFF + 8192;
constexpr int LDS_BYTES = 163840;

typedef float f32x16 __attribute__((ext_vector_type(16)));
typedef short s16x4 __attribute__((ext_vector_type(4)));
typedef unsigned u32x2 __attribute__((ext_vector_type(2)));
__device__ __forceinline__ float bflo(unsigned w) { return __builtin_bit_cast(float, w << 16); }
__device__ __forceinline__ float bfhi(unsigned w) { return __builtin_bit_cast(float, w & 0xffff0000u); }
__device__ __forceinline__ float wave_sum(float v) {
#pragma unroll
    for (int o = 1; o < 64; o <<= 1) v += __shfl_xor(v, o);
    return v;
}

struct Frame {
    LAS unsigned char* lds;
    int tid, lane, wave, vcu, G;
    const float *x, *g1, *w_in, *attn_g, *conv_w, *conv_g, *w_out, *g2, *w_r, *b_r, *w_gu, *b_gu, *w_dn, *b_dn, *gf;
    float* out; unsigned char* ws; gu32* ctl;
};

__device__ __forceinline__ void p0_transpose_item(const float* W, int K, int N, bf16* WT, int k0, int n0, int drow0, LAS float* scr, int lane, const float* kscale) {
#pragma unroll 8
    for (int i = 0; i < 32; ++i) { const int kk = 2 * i + (lane >> 5); scr[kk * 33 + (lane & 31)] = W[(size_t)(k0 + kk) * N + n0 + (lane & 31)]; }
    const int c = lane & 7;
    f32x4 s0 = {1.f, 1.f, 1.f, 1.f}, s1 = {1.f, 1.f, 1.f, 1.f};
    if (kscale) { s0 = *(const f32x4*)(kscale + k0 + 8 * c); s1 = *(const f32x4*)(kscale + k0 + 8 * c + 4); }
    LDS_WAIT(); asm volatile("" ::: "memory");
#pragma unroll
    for (int j = 0; j < 4; ++j) { const int n = (lane >> 3) + 8 * j; const LAS float* s = scr + (8 * c) * 33 + n;
        v4u o; o.x = pk2(s[0 * 33] * s0.x, s[1 * 33] * s0.y); o.y = pk2(s[2 * 33] * s0.z, s[3 * 33] * s0.w); o.z = pk2(s[4 * 33] * s1.x, s[5 * 33] * s1.y); o.w = pk2(s[6 * 33] * s1.z, s[7 * 33] * s1.w);
        *(v4u*)(WT + (size_t)(drow0 + n) * K + k0 + 8 * c) = o; }
    LDS_WAIT(); asm volatile("" ::: "memory");
}
struct Item8 { const float* W; unsigned char* WT; const float* ks; int N, k0, n0, drow; };
__device__ __forceinline__ void item8_load(const Item8& d, int lane, f32x4 (&v)[8], f32x4 (&s)[2]) {
    const int kq = lane >> 3, n4 = lane & 7;
#pragma unroll
    for (int ci = 0; ci < 2; ++ci) {
#pragma unroll
        for (int r = 0; r < 4; ++r) { const float* p = d.W + (size_t)(d.k0 + 4 * (kq + 8 * ci) + r) * d.N + d.n0 + 4 * n4; asm volatile("global_load_dwordx4 %0, %1, off nt" : "=v"(v[4 * ci + r]) : "v"(p) : "memory"); }
        { const float* p = d.ks + d.k0 + 4 * (kq + 8 * ci); asm volatile("global_load_dwordx4 %0, %1, off" : "=v"(s[ci]) : "v"(p) : "memory"); }
    }
}
#define ITEM8_WAIT(N, v, s) asm volatile("s_waitcnt vmcnt(" #N ")" : "+v"(v[0]), "+v"(v[1]), "+v"(v[2]), "+v"(v[3]), "+v"(v[4]), "+v"(v[5]), "+v"(v[6]), "+v"(v[7]), "+v"(s[0]), "+v"(s[1]) :: "memory")
__device__ __forceinline__ void item8_store(const Item8& d, LAS float* scr, int lane, const f32x4 (&v)[8], const f32x4 (&s)[2], float wscale) {
    const int kq = lane >> 3, n4 = lane & 7;
    LAS unsigned char* tile = (LAS unsigned char*)scr;
#pragma unroll
    for (int ci = 0; ci < 2; ++ci) { const f32x4 sc = s[ci] * wscale;
#pragma unroll
        for (int e = 0; e < 4; ++e)
            *(LAS unsigned*)(tile + (4 * n4 + e) * 72 + 4 * (kq + 8 * ci)) = pg8::pk4_fp8(v[4 * ci + 0][e] * sc.x, v[4 * ci + 1][e] * sc.y, v[4 * ci + 2][e] * sc.z, v[4 * ci + 3][e] * sc.w); }
    LDS_WAIT(); asm volatile("" ::: "memory");
    const int c = lane & 3;
#pragma unroll
    for (int j = 0; j < 2; ++j) { const int n = (lane >> 2) + 16 * j; const LAS unsigned char* p = tile + n * 72 + 16 * c;
        const pg8::u32x2_t lo = *(const LAS pg8::u32x2_t*)p, hi = *(const LAS pg8::u32x2_t*)(p + 8);
        v4u o; o.x = lo.x; o.y = lo.y; o.z = hi.x; o.w = hi.y;
        *(v4u*)(d.WT + (size_t)(d.drow + n) * 1024 + d.k0 + 16 * c) = o; }
    LDS_WAIT(); asm volatile("" ::: "memory");
}
__device__ const double INV_FREQ_REV[32] = {
    1.0 / 6.283185307179586, 0.7498942093324559 / 6.283185307179586, 0.5623413251903491 / 6.283185307179586, 0.4216965034285822 / 6.283185307179586,
    0.31622776601683794 / 6.283185307179586, 0.23713737056616552 / 6.283185307179586, 0.1778279410038923 / 6.283185307179586, 0.1333521432163324 / 6.283185307179586,
    0.1 / 6.283185307179586, 0.07498942093324558 / 6.283185307179586, 0.05623413251903491 / 6.283185307179586, 0.042169650342858224 / 6.283185307179586,
    0.03162277660168379 / 6.283185307179586, 0.023713737056616554 / 6.283185307179586, 0.01778279410038923 / 6.283185307179586, 0.01333521432163324 / 6.283185307179586,
    0.01 / 6.283185307179586, 0.007498942093324558 / 6.283185307179586, 0.005623413251903491 / 6.283185307179586, 0.004216965034285823 / 6.283185307179586,
    0.0031622776601683794 / 6.283185307179586, 0.0023713737056616554 / 6.283185307179586, 0.0017782794100389228 / 6.283185307179586, 0.001333521432163324 / 6.283185307179586,
    0.001 / 6.283185307179586, 0.0007498942093324559 / 6.283185307179586, 0.0005623413251903491 / 6.283185307179586, 0.00042169650342858224 / 6.283185307179586,
    0.00031622776601683794 / 6.283185307179586, 0.00023713737056616554 / 6.283185307179586, 0.00017782794100389227 / 6.283185307179586, 0.0001333521432163324 / 6.283185307179586};

__device__ __forceinline__ void p0_prologue(Frame& F) {
    LAS float* scr = (LAS float*)(F.lds + RING_OFF + F.wave * 16384);
    const int gw = F.vcu * 8 + F.wave, NGW = F.G * 8;
    bf16* win_t = (bf16*)(F.ws + WS_WIN); bf16* wout_t = (bf16*)(F.ws + WS_WOUT);
    constexpr int I_IN = 16 * 96, I_OUT = 16 * 32, I_GU = 16 * 64, I_DN = 16 * 32;
    constexpr int NITEMS = I_IN + I_OUT;
    for (int it = gw; it < NITEMS; it += NGW) {
        int r = it;
        if (r < I_IN) { const int kb = r / 96, nb = r % 96, n0 = 32 * nb; int drow = n0;
            if (n0 < 1024) { const int pn = n0 >> 8, w = n0 & 255, hh = w >> 6, bj = (w >> 5) & 1; drow = 256 * pn + 128 * bj + 32 * hh; }
            else if (n0 >= 1536 && n0 < 2048) { const int c = n0 - 1536, j = c >> 7; drow = 256 * (j < 2 ? 6 + j : 8 + j) + (c & 127); }
            else if (n0 >= 2560) { const int c = n0 - 2560, j = c >> 7; drow = 256 * (j < 2 ? 6 + j : 8 + j) + 128 + (c & 127); }
            p0_transpose_item(F.w_in, 1024, NPROJ, win_t, 64 * kb, n0, drow, scr, F.lane, nullptr); continue; }
        r -= I_IN;
        { const int kb = r / 32, nb = r % 32; p0_transpose_item(F.w_out, 1024, 1024, wout_t, 64 * kb, 32 * nb, 32 * nb, scr, F.lane, nullptr); }
    }
    { const int gt = F.vcu * 512 + F.tid, NGT = F.G * 512;
      float* rope = (float*)(F.ws + WS_ROPE);
      for (int i = gt; i < SEQ * 32; i += NGT) { const int pos = i >> 5, fi = i & 31; const double rev = (double)pos * INV_FREQ_REV[fi]; const float fr = (float)(rev - __builtin_rint(rev));
          rope[2 * i] = __builtin_amdgcn_cosf(fr); rope[2 * i + 1] = __builtin_amdgcn_sinf(fr); }
      float* ginv = (float*)(F.ws + WS_GINV);
      for (int i = gt; i < 1024; i += NGT) ginv[i] = 1.0f / F.g1[i];
      float* ones = (float*)(F.ws + WS_ONES);
      for (int i = gt; i < 1024; i += NGT) ones[i] = 1.0f;
      float* bdn32 = (float*)(F.ws + WS_BDN32);
      for (int i = gt; i < NE * 1024; i += NGT) bdn32[i] = 32.0f * F.b_dn[i];
      bf16* wrh = (bf16*)(F.ws + WS_WRH);
      for (int i = gt; i < NE * 1024; i += NGT) { const int e = i >> 10, k = i & 1023; const float v = F.g2[k] * F.w_r[k * NE + e]; const unsigned hi = f2bf(v); const float rem = v - __builtin_bit_cast(float, hi << 16);
          wrh[i] = (bf16)hi; wrh[NE * 1024 + i] = (bf16)f2bf(rem); }
    }
    bf16* XN = (bf16*)(F.ws + WS_XN);
    f32x4 gv[4];
#pragma unroll
    for (int j = 0; j < 4; ++j) gv[j] = ((const f32x4*)F.g1)[F.lane + 64 * j];
    for (int m = gw; m < T; m += 2 * NGW) {
        const int m2 = m + NGW; const bool two = m2 < T;
        const f32x4* xr = (const f32x4*)(F.x + (size_t)m * DM) + F.lane; const f32x4* xr2 = (const f32x4*)(F.x + (size_t)(two ? m2 : m) * DM) + F.lane;
        f32x4 v[4], v2[4]; float s2 = 0.f, t2 = 0.f;
#pragma unroll
        for (int j = 0; j < 4; ++j) { v[j] = __builtin_nontemporal_load(xr + 64 * j); v2[j] = __builtin_nontemporal_load(xr2 + 64 * j); }
#pragma unroll
        for (int j = 0; j < 4; ++j) { s2 += (v[j].x * v[j].x + v[j].y * v[j].y) + (v[j].z * v[j].z + v[j].w * v[j].w); t2 += (v2[j].x * v2[j].x + v2[j].y * v2[j].y) + (v2[j].z * v2[j].z + v2[j].w * v2[j].w); }
#pragma unroll
        for (int o = 1; o < 64; o <<= 1) { s2 += __shfl_xor(s2, o); t2 += __shfl_xor(t2, o); }
        const float rstd = 1.0f / sqrtf(s2 * (1.f / DM) + NORM_EPS), rstd2 = 1.0f / sqrtf(t2 * (1.f / DM) + NORM_EPS);
        if (F.lane == 0) { float* rinv = (float*)(F.ws + WS_RINV); rinv[m] = sqrtf(s2 * (1.f / DM) + NORM_EPS); if (two) rinv[m2] = sqrtf(t2 * (1.f / DM) + NORM_EPS); }
        if (two) {
            const int odd = F.lane & 1; bf16* rowp = XN + (size_t)(odd ? m2 : m) * DM + 4 * (F.lane & ~1);
#pragma unroll
            for (int j = 0; j < 4; ++j) {
                const unsigned a0 = pg8::cvt_pk_bf16(v[j].x * rstd * gv[j].x, v[j].y * rstd * gv[j].y), a1 = pg8::cvt_pk_bf16(v[j].z * rstd * gv[j].z, v[j].w * rstd * gv[j].w);
                const unsigned b0 = pg8::cvt_pk_bf16(v2[j].x * rstd2 * gv[j].x, v2[j].y * rstd2 * gv[j].y), b1 = pg8::cvt_pk_bf16(v2[j].z * rstd2 * gv[j].z, v2[j].w * rstd2 * gv[j].w);
                const unsigned s0 = odd ? a0 : b0, s1 = odd ? a1 : b1;
                const unsigned n0 = (unsigned)__builtin_amdgcn_mov_dpp((int)s0, 0xB1, 0xF, 0xF, true), n1 = (unsigned)__builtin_amdgcn_mov_dpp((int)s1, 0xB1, 0xF, 0xF, true);
                v4u w; if (odd) { w.x = n0; w.y = n1; w.z = b0; w.w = b1; } else { w.x = a0; w.y = a1; w.z = n0; w.w = n1; }
                *(v4u*)(rowp + 256 * j) = w; }
        } else {
            u32x2* o8 = (u32x2*)(XN + (size_t)m * DM) + F.lane;
#pragma unroll
            for (int j = 0; j < 4; ++j) { u32x2 w; w.x = pg8::cvt_pk_bf16(v[j].x * rstd * gv[j].x, v[j].y * rstd * gv[j].y); w.y = pg8::cvt_pk_bf16(v[j].z * rstd * gv[j].z, v[j].w * rstd * gv[j].w); o8[64 * j] = w; }
        }
    }
}

__device__ __forceinline__ Item8 moe_item(const Frame& F, int r) {
    constexpr int I_GU = 16 * 64, I_DN = 16 * 32;
    Item8 d;
    if (r < NE * I_GU) { const int e = r / I_GU, q = r % I_GU, kb = q / 64, nb = q % 64, n0 = 32 * nb; const int up = n0 >> 10, f = n0 & 1023;
        d.W = F.w_gu + (size_t)e * 1024 * 2048; d.WT = F.ws + WS_WGU + (size_t)e * 2048 * 1024; d.ks = F.g2; d.N = 2048; d.k0 = 64 * kb; d.n0 = n0; d.drow = 256 * (f >> 7) + 128 * up + (f & 127); }
    else { const int r2 = r - NE * I_GU, e = r2 / I_DN, q = r2 % I_DN, kb = q / 32, nb = q % 32;
        d.W = F.w_dn + (size_t)e * 1024 * 1024; d.WT = F.ws + WS_WDN + (size_t)e * 1024 * 1024; d.ks = (const float*)(F.ws + WS_ONES); d.N = 1024; d.k0 = 64 * kb; d.n0 = 32 * nb; d.drow = 32 * nb; }
    return d;
}
__device__ __forceinline__ void p0_moe_slice(Frame& F) {
    const float wsc = 32.0f;
    LAS float* scr = (LAS float*)(F.lds + RING_OFF + F.wave * 16384);
    constexpr int NMOE = NE * (16 * 64 + 16 * 32);
    const int per = (NMOE + F.G - 1) / F.G, lo = F.vcu * per, hi = (lo + per < NMOE) ? lo + per : NMOE;
    const int r0 = lo + F.wave;
    if (r0 >= hi) return;
    const int cnt = (hi - r0 + 7) / 8, last = r0 + 8 * (cnt - 1), quads = (cnt + 3) / 4;
    Item8 d0 = moe_item(F, r0), d1 = moe_item(F, r0 + 8 < last ? r0 + 8 : last), d2 = moe_item(F, r0 + 16 < last ? r0 + 16 : last), d3 = d0; f32x4 va[8], vb[8], vc[8], vd[8], sa[2], sb[2], sc[2], sd[2];
    item8_load(d0, F.lane, va, sa); item8_load(d1, F.lane, vb, sb); item8_load(d2, F.lane, vc, sc);
    for (int p = 0; p < quads; ++p) {
        const int rb = r0 + 32 * p;
#define MOE_IT(o_) moe_item(F, rb + 8 * (o_) < last ? rb + 8 * (o_) : last)
        d3 = MOE_IT(3); item8_load(d3, F.lane, vd, sd);
        ITEM8_WAIT(30, va, sa); item8_store(d0, scr, F.lane, va, sa, wsc);
        d0 = MOE_IT(4); item8_load(d0, F.lane, va, sa);
        ITEM8_WAIT(32, vb, sb); item8_store(d1, scr, F.lane, vb, sb, wsc);
        d1 = MOE_IT(5); item8_load(d1, F.lane, vb, sb);
        ITEM8_WAIT(34, vc, sc); item8_store(d2, scr, F.lane, vc, sc, wsc);
        d2 = MOE_IT(6); item8_load(d2, F.lane, vc, sc);
        ITEM8_WAIT(36, vd, sd); item8_store(d3, scr, F.lane, vd, sd, wsc);
#undef MOE_IT
    }
    asm volatile("s_waitcnt vmcnt(0)" ::: "memory");
}

constexpr int ATT_NSEG = BATCH * NH * 48, ATT_VREG = 0, ATT_KREG = 65536;
__device__ __forceinline__ s16x4 tr_read(const LAS unsigned char* p) { typedef short v4i16_t __attribute__((ext_vector_type(4))); return __builtin_bit_cast(s16x4, __builtin_amdgcn_ds_read_tr16_b64_v4i16((LAS v4i16_t*)p)); }
__device__ __forceinline__ float max3f(float a, float b, float c) { float r; asm("v_max3_f32 %0, %1, %2, %3" : "=v"(r) : "v"(a), "v"(b), "v"(c)); return r; }
struct AttSeg { int p, dil, n0, key; unsigned base, tok0, h; };
__device__ __forceinline__ void att_decode(int s, AttSeg& d) {
    const int bh = s / 48, ws = s % 48, j = ws & 15, b = bh >> 3, h = bh & 7; int r;
    d.p = ws >> 4;
    if (d.p == 0) { d.dil = 1; r = 0; d.n0 = 4 * j; } else if (d.p == 1) { d.dil = 4; r = j >> 2; d.n0 = 4 * (j & 3); } else { d.dil = 16; r = j; d.n0 = 0; }
    d.key = s - (d.n0 >> 2); d.tok0 = (unsigned)(b * SEQ + r); d.h = (unsigned)h; d.base = (d.tok0 * 512u + (unsigned)h * 64u) * 2u;
}

__device__ __forceinline__ void p2_attention(Frame& F) {
    const int lane = F.lane, w = __builtin_amdgcn_readfirstlane(F.wave), li = lane & 15, g = lane >> 4;
    LAS unsigned char* ring = F.lds + RING_OFF;
    const char* Qc = (const char*)(F.ws + WS_QKV); const char* Kc = Qc + QKV_STRIDE * 2; const char* Vc = Kc + QKV_STRIDE * 2;
    char* OPc = (char*)(F.ws + WS_OP); char* LSEc = (char*)(F.ws + WS_LSE);
    const int per = (ATT_NSEG + F.G - 1) / F.G;
    const int s_lo = F.vcu * per, s_hi = (s_lo + per < ATT_NSEG) ? s_lo + per : ATT_NSEG;
    if (s_lo >= s_hi) return;
    const bool xl = (F.G % 8 == 0) && (ATT_NSEG % F.G == 0);
    const int cpx = F.G / 8, xq = xl ? F.vcu / cpx : 0, xr = xl ? F.vcu % cpx : 0;
#define ATT_SEG(i_) (xl ? (xq * per * cpx + ((i_) - s_lo) * cpx + xr) : (i_))
    const int fk = li >> 1;
    const unsigned ringa = (unsigned)(unsigned long)ring;
    const unsigned ka0 = ringa + ATT_KREG + w * 2048 + li * 128 + ((g ^ fk) << 4), ka1 = ringa + ATT_KREG + w * 2048 + li * 128 + (((g + 4) ^ fk) << 4);
    const int vq = li >> 2, vp = li & 3;
    const int fv = (((2 * g + (li >> 3)) & 3) << 1);
    unsigned va[4];
#pragma unroll
    for (int d0 = 0; d0 < 4; ++d0) va[d0] = (unsigned)(unsigned long)ring + ATT_VREG + w * 2048 + (4 * g + vq) * 128 + 8 * (vp & 1) + (((2 * d0 + (vp >> 1)) ^ fv) << 4);
    unsigned drow[2], dck[2], dcv[2];
#pragma unroll
    for (int j = 0; j < 2; ++j) { const int row = 16 * w + 8 * j + (lane >> 3), ps = lane & 7; drow[j] = (unsigned)row; dck[j] = (unsigned)((ps ^ ((row >> 1) & 7)) << 4); dcv[j] = (unsigned)((ps ^ (((row >> 1) & 3) << 1)) << 4); }
    const unsigned qrow = (unsigned)(16 * w + li);
#define ATT_DMA(sd_, blk_, slot_) do { const unsigned bo_ = (sd_).base + (unsigned)(blk_) * ((unsigned)(sd_).dil << 17); const char* kg_ = Kc + bo_; const char* vg_ = Vc + bo_; \
        _Pragma("unroll") for (int j_ = 0; j_ < 2; ++j_) { const unsigned ro_ = drow[j_] * ((unsigned)(sd_).dil << 10); \
            __builtin_amdgcn_global_load_lds((const unsigned*)(kg_ + (ro_ + dck[j_])), (LAS unsigned*)(ring + ATT_KREG + (slot_) * 16384 + w * 2048 + j_ * 1024), 16, 0, 0); \
            __builtin_amdgcn_global_load_lds((const unsigned*)(vg_ + (ro_ + dcv[j_])), (LAS unsigned*)(ring + ATT_VREG + (slot_) * 16384 + w * 2048 + j_ * 1024), 16, 0, 0); } } while (0)
#define ATT_QLD(sd_, blk_, dst_) do { const char* qg_ = Qc + ((sd_).base + (unsigned)(blk_) * ((unsigned)(sd_).dil << 17)); const unsigned qo_ = qrow * ((unsigned)(sd_).dil << 10) + 16 * g; \
        dst_[0] = *(const bf16x8*)(qg_ + qo_); dst_[1] = *(const bf16x8*)(qg_ + qo_ + 64); } while (0)
#define ATT_SCV(k_) sc[(k_) >> 2][(k_) & 3]
#define ATT_WAITV(imm_) do { asm volatile("" ::: "memory"); __builtin_amdgcn_s_waitcnt(imm_); asm volatile("" ::: "memory"); } while (0)
#define ATT_BAR asm volatile("s_barrier" ::: "memory")
    AttSeg cur, nxt; att_decode(ATT_SEG(s_lo), cur);
    bf16x8 q[4][2]; v4u kr[2], vr[2];
    { const int nb0 = cur.n0 > 0 ? cur.n0 - 1 : 0; ATT_DMA(cur, nb0, 0); ATT_DMA(cur, cur.n0, 1); ATT_DMA(cur, cur.n0 + 1, 2); ATT_QLD(cur, cur.n0, q[0]); ATT_QLD(cur, cur.n0 + 1, q[1]); }
    ATT_WAITV(0x0F70); ATT_BAR;
    for (int s = s_lo; s < s_hi; ++s) {
        const int sn = (s + 1 < s_hi) ? s + 1 : s; att_decode(ATT_SEG(sn), nxt);
#pragma unroll
        for (int i = 0; i < 4; ++i) {
            if (i == 0) { ATT_DMA(cur, cur.n0 + 2, 3); ATT_QLD(cur, cur.n0 + 2, q[2]); }
            else if (i == 1) { ATT_DMA(cur, cur.n0 + 3, 0); ATT_QLD(cur, cur.n0 + 3, q[3]); }
            else if (i == 2) { ATT_DMA(nxt, nxt.n0, 1); ATT_QLD(nxt, nxt.n0, q[0]);
                const unsigned bo = nxt.base + (unsigned)(nxt.n0 > 0 ? nxt.n0 - 1 : 0) * ((unsigned)nxt.dil << 17);
#pragma unroll
                for (int j = 0; j < 2; ++j) { const unsigned ro = drow[j] * ((unsigned)nxt.dil << 10); kr[j] = *(const v4u*)(Kc + bo + (ro + dck[j])); vr[j] = *(const v4u*)(Vc + bo + (ro + dcv[j])); } }
            else { ATT_DMA(nxt, nxt.n0 + 1, 2); ATT_QLD(nxt, nxt.n0 + 1, q[1]); }
#define ATT_TOFF(kt_) ((i < 3) ? (8 * i + (kt_)) * 2048 : (((kt_) == 8 || w + (kt_) >= 8) ? ((kt_) - 8) * 2048 : (24 + (kt_)) * 2048))
            const bf16x8 qf0 = q[i][0], qf1 = q[i][1];
            f32x4 sc[9];
            v4u kf[6][2];
#define ATT_KRD(kt_) do { if (i < 3) { asm volatile("ds_read_b128 %0, %1 offset:%2" : "=v"(kf[(kt_) % 6][0]) : "v"(ka0), "i"((8 * i + (kt_)) * 2048) : "memory"); \
            asm volatile("ds_read_b128 %0, %1 offset:%2" : "=v"(kf[(kt_) % 6][1]) : "v"(ka1), "i"((8 * i + (kt_)) * 2048) : "memory"); } \
        else { const unsigned a0_ = ka0 + ATT_TOFF(kt_), a1_ = ka1 + ATT_TOFF(kt_); asm volatile("ds_read_b128 %0, %1" : "=v"(kf[(kt_) % 6][0]) : "v"(a0_) : "memory"); asm volatile("ds_read_b128 %0, %1" : "=v"(kf[(kt_) % 6][1]) : "v"(a1_) : "memory"); } } while (0)
#define ATT_KWAIT(n_, s_) asm volatile("s_waitcnt lgkmcnt(" #n_ ")" : "+v"(kf[s_][0]), "+v"(kf[s_][1]) :: "memory")
            ATT_KRD(0); ATT_KRD(1); ATT_KRD(2); ATT_KRD(3); ATT_KRD(4);
#pragma unroll
            for (int kt = 0; kt < 9; ++kt) {
                if (kt + 5 < 9) ATT_KRD(kt + 5);
                if (kt < 4) { if (kt % 6 == 0) ATT_KWAIT(10, 0); else if (kt % 6 == 1) ATT_KWAIT(10, 1); else if (kt % 6 == 2) ATT_KWAIT(10, 2); else ATT_KWAIT(10, 3); }
                else if (kt == 4) ATT_KWAIT(8, 4); else if (kt == 5) ATT_KWAIT(6, 5); else if (kt == 6) ATT_KWAIT(4, 0); else if (kt == 7) ATT_KWAIT(2, 1); else ATT_KWAIT(0, 2);
                f32x4 z = {0.f, 0.f, 0.f, 0.f};
                z = __builtin_amdgcn_mfma_f32_16x16x32_bf16(__builtin_bit_cast(bf16x8, kf[kt % 6][0]), qf0, z, 0, 0, 0);
                sc[kt] = __builtin_amdgcn_mfma_f32_16x16x32_bf16(__builtin_bit_cast(bf16x8, kf[kt % 6][1]), qf1, z, 0, 0, 0);
            }
#undef ATT_KRD
#undef ATT_KWAIT
            u32x2 xr[3][8];
#define ATT_TR(dst_, kt_, d0_) do { if (i < 3) asm volatile("ds_read_b64_tr_b16 %0, %1 offset:%2" : "=v"(dst_) : "v"(va[d0_]), "i"((8 * i + (kt_)) * 2048) : "memory"); \
        else { const unsigned ad_ = va[d0_] + ATT_TOFF(kt_); asm volatile("ds_read_b64_tr_b16 %0, %1" : "=v"(dst_) : "v"(ad_) : "memory"); } } while (0)
#define ATT_ISSUE(ks_) do { _Pragma("unroll") for (int d0 = 0; d0 < 4; ++d0) { ATT_TR(xr[(ks_) % 3][2 * d0], 2 * (ks_), d0); if ((ks_) < 4) ATT_TR(xr[(ks_) % 3][2 * d0 + 1], 2 * (ks_) + 1, d0); } } while (0)
#define ATT_WAITL(n_, s_) asm volatile("s_waitcnt lgkmcnt(" #n_ ")" : "+v"(xr[s_][0]), "+v"(xr[s_][1]), "+v"(xr[s_][2]), "+v"(xr[s_][3]), "+v"(xr[s_][4]), "+v"(xr[s_][5]), "+v"(xr[s_][6]), "+v"(xr[s_][7]) :: "memory")
            ATT_ISSUE(0); ATT_ISSUE(1);
            const float NEG = -INFINITY;
#pragma unroll
            for (int e = 0; e < 4; ++e) { const int ik = 4 * g + e; if (ik < li) sc[0][e] = NEG; if (ik > li) sc[8][e] = NEG; }
            if (i == 0 && cur.n0 == 0) {
#pragma unroll
                for (int kt = 0; kt < 8; ++kt) if (w + kt < 8) sc[kt] = (f32x4){NEG, NEG, NEG, NEG};
            }
            float mx = max3f(ATT_SCV(0), ATT_SCV(1), ATT_SCV(2));
#pragma unroll
            for (int k = 3; k < 35; k += 2) mx = max3f(mx, ATT_SCV(k), ATT_SCV(k + 1));
            mx = max3f(mx, ATT_SCV(35), ATT_SCV(35));
            { auto r16 = __builtin_amdgcn_permlane16_swap(__float_as_uint(mx), __float_as_uint(mx), false, false); mx = max3f(__uint_as_float(r16[0]), __uint_as_float(r16[1]), __uint_as_float(r16[1]));
              auto r32 = __builtin_amdgcn_permlane32_swap(__float_as_uint(mx), __float_as_uint(mx), false, false); mx = max3f(__uint_as_float(r32[0]), __uint_as_float(r32[1]), __uint_as_float(r32[1])); }
            pg8::f32x2 ls2 = {0.f, 0.f}; const pg8::f32x2 mx2 = {mx, mx};
#pragma unroll
            for (int kt = 0; kt < 9; ++kt)
#pragma unroll
                for (int hh = 0; hh < 2; ++hh) { const pg8::f32x2 d = (pg8::f32x2){sc[kt][2 * hh], sc[kt][2 * hh + 1]} - mx2; pg8::f32x2 e; e.x = __builtin_amdgcn_exp2f(d.x); e.y = __builtin_amdgcn_exp2f(d.y);
                    ls2 += e; sc[kt][2 * hh] = e.x; sc[kt][2 * hh + 1] = e.y; }
            float lsum = ls2.x + ls2.y;
            { auto r16 = __builtin_amdgcn_permlane16_swap(__float_as_uint(lsum), __float_as_uint(lsum), false, false); lsum = __uint_as_float(r16[0]) + __uint_as_float(r16[1]);
              auto r32 = __builtin_amdgcn_permlane32_swap(__float_as_uint(lsum), __float_as_uint(lsum), false, false); lsum = __uint_as_float(r32[0]) + __uint_as_float(r32[1]); }
            f32x4 oacc[4];
#pragma unroll
            for (int d0 = 0; d0 < 4; ++d0) oacc[d0] = (f32x4){0.f, 0.f, 0.f, 0.f};
#pragma unroll
            for (int ks = 0; ks < 5; ++ks) {
                v4u pw; pw.x = pg8::cvt_pk_bf16(sc[2 * ks][0], sc[2 * ks][1]); pw.y = pg8::cvt_pk_bf16(sc[2 * ks][2], sc[2 * ks][3]);
                if (ks < 4) { pw.z = pg8::cvt_pk_bf16(sc[2 * ks + 1][0], sc[2 * ks + 1][1]); pw.w = pg8::cvt_pk_bf16(sc[2 * ks + 1][2], sc[2 * ks + 1][3]); } else { pw.z = 0u; pw.w = 0u; }
                const bf16x8 pf = __builtin_bit_cast(bf16x8, pw);
                if (ks == 0) ATT_WAITL(8, 0); else if (ks == 1) ATT_WAITL(8, 1); else if (ks == 2) ATT_WAITL(8, 2); else if (ks == 3) ATT_WAITL(4, 0); else { ATT_WAITL(0, 1); xr[1][1] = xr[1][0]; xr[1][3] = xr[1][2]; xr[1][5] = xr[1][4]; xr[1][7] = xr[1][6]; }
#pragma unroll
                for (int d0 = 0; d0 < 4; ++d0) {
                    const u32x2 xa = xr[ks % 3][2 * d0], xb = xr[ks % 3][2 * d0 + 1];
                    const v4u vw = {xa.x, xa.y, xb.x, xb.y};
                    oacc[d0] = __builtin_amdgcn_mfma_f32_16x16x32_bf16(__builtin_bit_cast(bf16x8, vw), pf, oacc[d0], 0, 0, 0); }
                if (ks == 0) ATT_ISSUE(2); else if (ks == 1) ATT_ISSUE(3); else if (ks == 2) ATT_ISSUE(4);
            }
#undef ATT_TR
#undef ATT_ISSUE
#undef ATT_WAITL
#undef ATT_TOFF
            if (i == 2) ATT_WAITV(0x0F7A); else ATT_WAITV(0x0F76);
            const float inv = __builtin_amdgcn_rcpf(lsum);
            const unsigned nb = (unsigned)(cur.n0 + i) * ((unsigned)cur.dil << 17);
            char* opu = OPc + ((size_t)cur.p * T * 1024 + cur.base + nb);
            const unsigned olane = qrow * ((unsigned)cur.dil << 10) + 8 * (g & ~1) + 32 * (g & 1);
            pg8::u32x2_t ow[4];
#pragma unroll
            for (int d0 = 0; d0 < 4; ++d0) { ow[d0].x = pg8::cvt_pk_bf16(oacc[d0][0] * inv, oacc[d0][1] * inv); ow[d0].y = pg8::cvt_pk_bf16(oacc[d0][2] * inv, oacc[d0][3] * inv); }
#pragma unroll
            for (int pr = 0; pr < 2; ++pr) { const pg8::u32x4_t o16 = pg8::widen_rows16(ow[2 * pr], ow[2 * pr + 1]); *(pg8::u32x4_t*)(opu + (olane + 64 * pr)) = o16; }
            if (g == 0) { char* lsu = LSEc + (((size_t)cur.p * T + cur.tok0) * 32 + 4 * cur.h + (size_t)(cur.n0 + i) * cur.dil * 4096);
                *(float*)(lsu + qrow * ((unsigned)cur.dil * 32)) = mx + __builtin_amdgcn_logf(lsum); }
            ATT_BAR;
        }
#pragma unroll
        for (int j = 0; j < 2; ++j) { const unsigned lo = drow[j] * 128 + (lane & 7) * 16;
            *(LAS v4u*)(ring + ATT_KREG + lo) = kr[j]; *(LAS v4u*)(ring + ATT_VREG + lo) = vr[j]; }
        asm volatile("s_waitcnt lgkmcnt(0)" ::: "memory"); ATT_BAR;
        cur = nxt;
    }
    ATT_WAITV(0x0F70); ATT_BAR;
}
#undef ATT_DMA
#undef ATT_QLD
#undef ATT_SCV
#undef ATT_BAR
#undef ATT_SEG
#undef ATT_WAITV
__device__ __forceinline__ void unpack8(const v4u w, float (&f)[8]) { f[0] = bflo(w.x); f[1] = bfhi(w.x); f[2] = bflo(w.y); f[3] = bfhi(w.y); f[4] = bflo(w.z); f[5] = bfhi(w.z); f[6] = bflo(w.w); f[7] = bfhi(w.w); }
__device__ __forceinline__ void p3_merge(Frame& F) {
    const int lane = F.lane, c0 = 8 * lane, head = lane >> 3;
    const int gw = F.vcu * 8 + F.wave, NGW = F.G * 8;
    const bf16* QKV = (const bf16*)(F.ws + WS_QKV);
    const bf16* Zb = QKV + 3 * QKV_STRIDE; const bf16* Bb = QKV + 4 * QKV_STRIDE;
    const bf16* OP = (const bf16*)(F.ws + WS_OP); const float* LSE = (const float*)(F.ws + WS_LSE);
    bf16* MX = (bf16*)(F.ws + WS_MIX);
    float ag[8], cg[8], w0[8], w1[8], w2[8];
#pragma unroll
    for (int j = 0; j < 8; ++j) { ag[j] = F.attn_g[c0 + j]; cg[j] = F.conv_g[c0 + j]; w0[j] = F.conv_w[c0 + j]; w1[j] = F.conv_w[512 + c0 + j]; w2[j] = F.conv_w[1024 + c0 + j]; }
    for (int run = gw; run < T / 16; run += NGW) {
        const int t0 = run * 16;
        float z1[8], z2[8];
        if ((t0 & (SEQ - 1)) != 0) { unpack8(*(const v4u*)(Zb + (size_t)(t0 - 1) * 512 + c0), z1); unpack8(*(const v4u*)(Zb + (size_t)(t0 - 2) * 512 + c0), z2); }
        else {
#pragma unroll
            for (int j = 0; j < 8; ++j) { z1[j] = 0.f; z2[j] = 0.f; }
        }
        float nl0, nl1, nl2; v4u no0, no1, no2, nz, nb;
#define P3_LOAD(t_) do { const size_t q_ = (size_t)(t_); nl0 = LSE[q_ * 8 + head]; nl1 = LSE[((size_t)T + q_) * 8 + head]; nl2 = LSE[((size_t)2 * T + q_) * 8 + head]; \
            no0 = *(const v4u*)(OP + q_ * 512 + c0); no1 = *(const v4u*)(OP + ((size_t)T + q_) * 512 + c0); no2 = *(const v4u*)(OP + ((size_t)2 * T + q_) * 512 + c0); \
            nz = *(const v4u*)(Zb + q_ * 512 + c0); nb = *(const v4u*)(Bb + q_ * 512 + c0); } while (0)
        P3_LOAD(t0);
#pragma unroll 2
        for (int tt = 0; tt < 16; ++tt) {
            const size_t t = (size_t)t0 + tt;
            const float l0 = nl0, l1 = nl1, l2 = nl2; const v4u vo0 = no0, vo1 = no1, vo2 = no2, vz = nz, vb = nb;
            if (tt + 1 < 16) P3_LOAD(t + 1);
            const float lm = fmaxf(l0, fmaxf(l1, l2));
            float e0 = __builtin_amdgcn_exp2f(l0 - lm), e1 = __builtin_amdgcn_exp2f(l1 - lm), e2 = __builtin_amdgcn_exp2f(l2 - lm);
            const float es = 1.0f / (e0 + e1 + e2); e0 *= es; e1 *= es; e2 *= es;
            float o0[8], o1[8], o2[8], at[8];
            unpack8(vo0, o0); unpack8(vo1, o1); unpack8(vo2, o2);
            float sa = 0.f;
#pragma unroll
            for (int j = 0; j < 8; ++j) { at[j] = e0 * o0[j] + e1 * o1[j] + e2 * o2[j]; sa += at[j] * at[j]; }
            float zz[8], bb[8], co[8];
            unpack8(vz, zz); unpack8(vb, bb);
            float sv = 0.f;
#pragma unroll
            for (int j = 0; j < 8; ++j) { const float z0 = zz[j]; const float cv = z2[j] * w0[j] + z1[j] * w1[j] + z0 * w2[j]; co[j] = bb[j] * cv; sv += co[j] * co[j]; z2[j] = z1[j]; z1[j] = z0; }
#pragma unroll
            for (int o = 1; o < 64; o <<= 1) { sa += __shfl_xor(sa, o); sv += __shfl_xor(sv, o); }
            const float ra = 1.0f / sqrtf(sa * (1.f / 512.f) + NORM_EPS), rc = 1.0f / sqrtf(sv * (1.f / 512.f) + NORM_EPS);
            v4u wa, wc;
            wa.x = pg8::cvt_pk_bf16(at[0] * ra * ag[0], at[1] * ra * ag[1]); wa.y = pg8::cvt_pk_bf16(at[2] * ra * ag[2], at[3] * ra * ag[3]); wa.z = pg8::cvt_pk_bf16(at[4] * ra * ag[4], at[5] * ra * ag[5]); wa.w = pg8::cvt_pk_bf16(at[6] * ra * ag[6], at[7] * ra * ag[7]);
            wc.x = pg8::cvt_pk_bf16(co[0] * rc * cg[0], co[1] * rc * cg[1]); wc.y = pg8::cvt_pk_bf16(co[2] * rc * cg[2], co[3] * rc * cg[3]); wc.z = pg8::cvt_pk_bf16(co[4] * rc * cg[4], co[5] * rc * cg[5]); wc.w = pg8::cvt_pk_bf16(co[6] * rc * cg[6], co[7] * rc * cg[7]);
            *(v4u*)(MX + t * 1024 + c0) = wa; *(v4u*)(MX + t * 1024 + 512 + c0) = wc;
        }
#undef P3_LOAD
    }
}

#define P5_LOAD(c) do { _Pragma("unroll") for (int i_ = 0; i_ < 4; ++i_) ra[i_] = *(const v4u*)(H + (size_t)(tok0 + prow + 32 * i_) * 1024 + (c) * 128 + pcc * 8); \
                        _Pragma("unroll") for (int i_ = 0; i_ < 2; ++i_) rb[i_] = *(const v4u*)(WRH + (size_t)(prow + 32 * i_) * 1024 + (c) * 128 + pcc * 8); } while (0)
#define P5_STORE(b_) do { _Pragma("unroll") for (int i_ = 0; i_ < 4; ++i_) { const int row_ = prow + 32 * i_; *(LAS v4u*)(lb + (b_) * 49152 + row_ * 256 + ((pcc ^ (row_ & 15)) << 4)) = ra[i_]; } \
                          _Pragma("unroll") for (int i_ = 0; i_ < 2; ++i_) { const int row_ = prow + 32 * i_; *(LAS v4u*)(lb + (b_) * 49152 + 32768 + row_ * 256 + ((pcc ^ (row_ & 15)) << 4)) = rb[i_]; } } while (0)
__device__ __forceinline__ void p5_router(Frame& F, int cwfill) {
    const int tid = F.tid, lane = F.lane, w = F.wave, li = lane & 15, g = lane >> 4;
    const bf16* H = (const bf16*)(F.ws + WS_H16); const bf16* WRH = (const bf16*)(F.ws + WS_WRH);
    int* TOPI = (int*)(F.ws + WS_TOPI); float* GATE = (float*)(F.ws + WS_GATE); int* OFF = (int*)(F.ws + WS_OFF);
    int* ROWTOK = (int*)(F.ws + WS_ROWTOK); float* RSCALE = (float*)(F.ws + WS_RSCALE);
    LAS unsigned* wsc = (LAS unsigned*)(F.lds + LDS_WSC);
    LAS unsigned char* lb = F.lds + RING_OFF;
    const int prow = tid >> 4, pcc = tid & 15;
    float br[8];
#pragma unroll
    for (int r = 0; r < 8; ++r) br[r] = F.b_r[16 * (r >> 2) + 4 * g + (r & 3)];
    for (int blk = blockIdx.x; blk < T / 128; blk += F.G) {
        const int tok0 = blk * 128, tok = tok0 + 16 * w + li;
        v4u ra[4], rb[2];
        P5_LOAD(0); P5_STORE(0);
        __syncthreads();
        f32x4 a0 = {0.f, 0.f, 0.f, 0.f}, a1 = {0.f, 0.f, 0.f, 0.f};
        float ssq = 0.f;
#pragma unroll 1
        for (int c = 0; c < 8; ++c) {
            if (c + 1 < 8) P5_LOAD(c + 1);
            const LAS unsigned char* ab = lb + (c & 1) * 49152 + (16 * w + li) * 256;
            const LAS unsigned char* bb = lb + (c & 1) * 49152 + 32768 + li * 256;
#pragma unroll
            for (int s4 = 0; s4 < 4; ++s4) {
                const int co = (((4 * s4 + g) ^ li) << 4);
                const bf16x8 hf = *(const LAS bf16x8*)(ab + co);
                const bf16x8 w0 = *(const LAS bf16x8*)(bb + co), w1 = *(const LAS bf16x8*)(bb + 16 * 256 + co), w2 = *(const LAS bf16x8*)(bb + 32 * 256 + co), w3 = *(const LAS bf16x8*)(bb + 48 * 256 + co);
                a0 = __builtin_amdgcn_mfma_f32_16x16x32_bf16(w0, hf, a0, 0, 0, 0); a0 = __builtin_amdgcn_mfma_f32_16x16x32_bf16(w2, hf, a0, 0, 0, 0);
                a1 = __builtin_amdgcn_mfma_f32_16x16x32_bf16(w1, hf, a1, 0, 0, 0); a1 = __builtin_amdgcn_mfma_f32_16x16x32_bf16(w3, hf, a1, 0, 0, 0);
#pragma unroll
                for (int j = 0; j < 8; ++j) { const float v = __builtin_bit_cast(float, (unsigned)(unsigned short)hf[j] << 16); ssq += v * v; }
            }
            if (c + 1 < 8) P5_STORE((c + 1) & 1);
            __syncthreads();
        }
        ssq += __shfl_xor(ssq, 16); ssq += __shfl_xor(ssq, 32);
        const float rstd = 1.0f / sqrtf(ssq * (1.f / 1024.f) + NORM_EPS);
        float lg[8];
#pragma unroll
        for (int i = 0; i < 4; ++i) { lg[i] = a0[i] * rstd + br[i]; lg[4 + i] = a1[i] * rstd + br[4 + i]; }
        float tv[4]; int te[4];
#pragma unroll
        for (int k = 0; k < 4; ++k) {
            float bv = lg[0]; int bi = 0;
#pragma unroll
            for (int r = 1; r < 8; ++r) if (lg[r] > bv) { bv = lg[r]; bi = r; }
            int be = 16 * (bi >> 2) + 4 * g + (bi & 3);
#pragma unroll
            for (int o = 16; o <= 32; o <<= 1) { const float ov = __shfl_xor(bv, o); const int oe = __shfl_xor(be, o); const bool take = (ov > bv) || (ov == bv && oe < be); bv = take ? ov : bv; be = take ? oe : be; }
            tv[k] = bv; te[k] = be;
            const int own_r = 4 * (be >> 4) + (be & 3); const bool own = (((be >> 2) & 3) == g);
#pragma unroll
            for (int r = 0; r < 8; ++r) if (own && r == own_r) lg[r] = -INFINITY;
        }
        const float e1 = __builtin_amdgcn_exp2f((tv[1] - tv[0]) * 1.4426950408889634f), e2 = __builtin_amdgcn_exp2f((tv[2] - tv[0]) * 1.4426950408889634f), e3 = __builtin_amdgcn_exp2f((tv[3] - tv[0]) * 1.4426950408889634f);
        const float gs = 1.0f / (1.0f + e1 + e2 + e3);
        if (tid < 32) wsc[tid] = 0u;
        __syncthreads();
        unsigned rk[4] = {0u, 0u, 0u, 0u};
        if (lane < 16) {
#pragma unroll
            for (int k = 0; k < 4; ++k) rk[k] = __hip_atomic_fetch_add(&wsc[te[k]], 1u, __ATOMIC_RELAXED, __HIP_MEMORY_SCOPE_WORKGROUP);
        }
        __syncthreads();
        if (tid < 32) { const unsigned c = wsc[tid]; unsigned base = 0u; if (c) base = __hip_atomic_fetch_add(F.ctl + cwfill + 64 * tid, c, __ATOMIC_RELAXED, __HIP_MEMORY_SCOPE_AGENT); wsc[32 + tid] = base; }
        __syncthreads();
        if (lane < 16) {
            typedef int i32x4 __attribute__((ext_vector_type(4)));
            i32x4 o; o.x = (int)(wsc[32 + te[0]] + rk[0]); o.y = (int)(wsc[32 + te[1]] + rk[1]); o.z = (int)(wsc[32 + te[2]] + rk[2]); o.w = (int)(wsc[32 + te[3]] + rk[3]);
            *(i32x4*)(OFF + (size_t)tok * 4) = o;
            *(i32x4*)(TOPI + (size_t)tok * 4) = (i32x4){te[0], te[1], te[2], te[3]};
            *(f32x4*)(GATE + (size_t)tok * 4) = (f32x4){gs, e1 * gs, e2 * gs, e3 * gs};
            ROWTOK[(size_t)te[0] * T + o.x] = tok; ROWTOK[(size_t)te[1] * T + o.y] = tok; ROWTOK[(size_t)te[2] * T + o.z] = tok; ROWTOK[(size_t)te[3] * T + o.w] = tok;
            RSCALE[(size_t)te[0] * T + o.x] = rstd; RSCALE[(size_t)te[1] * T + o.y] = rstd; RSCALE[(size_t)te[2] * T + o.z] = rstd; RSCALE[(size_t)te[3] * T + o.w] = rstd;
        }
        __syncthreads();
    }
}
#undef P5_LOAD
#undef P5_STORE

__device__ __forceinline__ int build_tiles(Frame& F) {
    LAS int* tstart = (LAS int*)(F.lds + LDS_TSTART); LAS int* texp = (LAS int*)(F.lds + LDS_TEXP); LAS int* tcnt = (LAS int*)(F.lds + LDS_TCNT);
    __syncthreads();
    if (F.tid < 64) {
        const int e = F.tid & 31;
        const unsigned c = __hip_atomic_load(F.ctl + CW_FILL + 64 * e, __ATOMIC_RELAXED, __HIP_MEMORY_SCOPE_AGENT);
        const int nt = (int)((c + 255u) >> 8);
        int inc = nt;
#pragma unroll
        for (int o = 1; o < 32; o <<= 1) { const int v = __shfl_up(inc, o, 32); if (e >= o) inc += v; }
        if (F.tid < 32) { tcnt[e] = (int)c; tstart[e] = inc - nt; if (e == 31) tstart[32] = inc; }
    }
    __syncthreads();
    if (F.tid < NE) { const int a = tstart[F.tid], b = tstart[F.tid + 1]; for (int t = a; t < b; ++t) texp[t] = F.tid; }
    __syncthreads();
    return tstart[NE];
}
__device__ __forceinline__ void build_idx(Frame& F, const pg8::MoeOrder& S, unsigned pitch) {
    LAS unsigned* idxtab = (LAS unsigned*)(F.lds + LDS_IDX);
    LAS int* udesc = (LAS int*)(F.lds + LDS_WSC);
    const LAS int* tstart = (const LAS int*)(F.lds + LDS_TSTART); const LAS int* tcnt = (const LAS int*)(F.lds + LDS_TCNT);
    const int* ROWTOK = (const int*)(F.ws + WS_ROWTOK);
    if (F.tid < 24) { pg8::Unit u; const bool ok = S.next(F.tid, u); const int e = ok ? (u.pn >> 3) : -1; udesc[2 * F.tid] = e; udesc[2 * F.tid + 1] = ok ? 256 * (u.pm - tstart[e]) : 0; }
    __syncthreads();
#pragma unroll
    for (int i = 0; i < 12; ++i) { const int idx = i * 512 + F.tid, ui = idx >> 8, row = idx & 255; const int e = udesc[2 * ui];
        if (e >= 0) { const int lr = udesc[2 * ui + 1] + row; const int tok = (lr < tcnt[e]) ? ROWTOK[(size_t)e * T + lr] : 0; idxtab[idx] = (unsigned)tok * pitch; } }
    __syncthreads();
}

__device__ __forceinline__ void unpack8_fp8(const pg8::u32x2_t w, float (&f)[8]) {
    typedef float f32x2_ __attribute__((ext_vector_type(2)));
    const f32x2_ a = __builtin_amdgcn_cvt_pk_f32_fp8((int)w.x, false), b = __builtin_amdgcn_cvt_pk_f32_fp8((int)w.x, true), c = __builtin_amdgcn_cvt_pk_f32_fp8((int)w.y, false), d = __builtin_amdgcn_cvt_pk_f32_fp8((int)w.y, true);
    f[0] = a.x; f[1] = a.y; f[2] = b.x; f[3] = b.y; f[4] = c.x; f[5] = c.y; f[6] = d.x; f[7] = d.y;
}
__device__ __forceinline__ void p9_combine(Frame& F, float* outp) {
    if (N_LAUNCHES != 1) build_tiles(F);
    const LAS int* tstart = (const LAS int*)(F.lds + LDS_TSTART);
    const int lane = F.lane, gw = F.vcu * 8 + F.wave, NGW = F.G * 8;
    const int* TOPI = (const int*)(F.ws + WS_TOPI); const int* OFF = (const int*)(F.ws + WS_OFF); const float* GATE = (const float*)(F.ws + WS_GATE); const unsigned char* YB = F.ws + WS_XB;
    const bf16* H = (const bf16*)(F.ws + WS_H16);
    f32x4 gg[2][2];
#pragma unroll
    for (int j = 0; j < 2; ++j) { gg[j][0] = *(const f32x4*)(F.gf + 512 * j + 8 * lane); gg[j][1] = *(const f32x4*)(F.gf + 512 * j + 8 * lane + 4); }
    typedef int i32x4 __attribute__((ext_vector_type(4)));
    for (int tok0 = gw; tok0 < T; tok0 += 2 * NGW) {
        int tk[2]; tk[0] = tok0; tk[1] = (tok0 + NGW < T) ? tok0 + NGW : tok0;
        i32x4 d[2]; f32x4 gt[2]; v4u hw[2][2]; pg8::u32x2_t yw[2][2][4];
#pragma unroll
        for (int q = 0; q < 2; ++q) { const int tok = tk[q];
            const i32x4 te = *(const i32x4*)(TOPI + (size_t)tok * 4), of = *(const i32x4*)(OFF + (size_t)tok * 4); gt[q] = *(const f32x4*)(GATE + (size_t)tok * 4) * 0.125f;
            d[q].x = 256 * tstart[te.x] + of.x; d[q].y = 256 * tstart[te.y] + of.y; d[q].z = 256 * tstart[te.z] + of.z; d[q].w = 256 * tstart[te.w] + of.w; }
#pragma unroll
        for (int q = 0; q < 2; ++q)
#pragma unroll
            for (int j = 0; j < 2; ++j) { const size_t co = 512 * j + 8 * lane;
                hw[q][j] = *(const v4u*)(H + (size_t)tk[q] * 1024 + co);
                yw[q][j][0] = *(const pg8::u32x2_t*)(YB + (size_t)d[q].x * 1024 + co); yw[q][j][1] = *(const pg8::u32x2_t*)(YB + (size_t)d[q].y * 1024 + co);
                yw[q][j][2] = *(const pg8::u32x2_t*)(YB + (size_t)d[q].z * 1024 + co); yw[q][j][3] = *(const pg8::u32x2_t*)(YB + (size_t)d[q].w * 1024 + co); }
#pragma unroll
        for (int q = 0; q < 2; ++q) {
            if (q == 1 && tk[1] == tk[0]) break;
            float hv[2][8]; float ssq = 0.f;
#pragma unroll
            for (int j = 0; j < 2; ++j) {
                float h8[8], y0[8], y1[8], y2[8], y3[8];
                unpack8(hw[q][j], h8); unpack8_fp8(yw[q][j][0], y0); unpack8_fp8(yw[q][j][1], y1); unpack8_fp8(yw[q][j][2], y2); unpack8_fp8(yw[q][j][3], y3);
#pragma unroll
                for (int i = 0; i < 8; ++i) { const float v = h8[i] + (gt[q].x * y0[i] + gt[q].y * y1[i]) + (gt[q].z * y2[i] + gt[q].w * y3[i]); hv[j][i] = v; ssq += v * v; } }
            const float rstd = 1.0f / sqrtf(wave_sum(ssq) * (1.f / 1024.f) + NORM_EPS);
#pragma unroll
            for (int j = 0; j < 2; ++j) { float* hp = outp + (size_t)tk[q] * 1024 + 512 * j + 8 * lane;
                f32x4 a, b; a.x = hv[j][0] * rstd * gg[j][0].x; a.y = hv[j][1] * rstd * gg[j][0].y; a.z = hv[j][2] * rstd * gg[j][0].z; a.w = hv[j][3] * rstd * gg[j][0].w;
                b.x = hv[j][4] * rstd * gg[j][1].x; b.y = hv[j][5] * rstd * gg[j][1].y; b.z = hv[j][6] * rstd * gg[j][1].z; b.w = hv[j][7] * rstd * gg[j][1].w;
                *(f32x4*)hp = a; *(f32x4*)(hp + 4) = b; }
        }
    }
}

constexpr int PER_PHASE = 10;
struct Args { const float* in[15]; float* out; unsigned char* ws; int ph_lo, ph_hi; };
__global__ void __launch_bounds__(512, 2) hyb_fwd(Args args) {
    extern __shared__ __attribute__((aligned(16))) unsigned char lds[];
    Frame F;
    F.lds = (LAS unsigned char*)lds;
    F.tid = threadIdx.x; F.lane = F.tid & 63; F.wave = __builtin_amdgcn_readfirstlane(F.tid >> 6);
    F.G = gridDim.x; { const int bx = blockIdx.x; F.vcu = (F.G % 8 == 0) ? (bx % 8) * (F.G / 8) + bx / 8 : bx; }
    F.x = args.in[0]; F.g1 = args.in[1]; F.w_in = args.in[2]; F.attn_g = args.in[3]; F.conv_w = args.in[4]; F.conv_g = args.in[5]; F.w_out = args.in[6]; F.g2 = args.in[7];
    F.w_r = args.in[8]; F.b_r = args.in[9]; F.w_gu = args.in[10]; F.b_gu = args.in[11]; F.w_dn = args.in[12]; F.b_dn = args.in[13]; F.gf = args.in[14];
    F.out = args.out; F.ws = args.ws; F.ctl = (gu32*)(args.ws + WS_CTL);
    for (int u = F.tid; u < (LDS_BYTES - MISC_OFF) / 4; u += 512) ((LAS unsigned*)(F.lds + MISC_OFF))[u] = 0u;
    __syncthreads();
    XcdBarrier bar; bar.bar = (unsigned*)(F.ctl + CW_BAR); bar.x = 0; bar.st = nullptr;
    if (N_LAUNCHES == 1) bar = xcd_barrier_post((unsigned*)(F.ctl + CW_BAR), (volatile LAS unsigned*)(F.lds + MISC_OFF + 32));
    const int lo = args.ph_lo, hi = args.ph_hi;
#define IN(k) (lo <= (k) && (k) < hi)
#define SEAM(k) do { if (IN(k) && IN((k) + 1)) { xcd_barrier(bar); } } while (0)

    if (IN(0)) { p0_prologue(F); SEAM(0); }
    if (IN(1)) {
        pg8::Gemm g{(const pg8::bf16_t*)(F.ws + WS_XN), (const pg8::bf16_t*)(F.ws + WS_WIN), T, NPROJ, DM}; pg8::StaticOrder S; S.init(T, NPROJ, F.G, (int)blockIdx.x);
        pg8::EpiQKV E{(pg8::bf16_t*)(F.ws + WS_QKV), (const float*)(F.ws + WS_ROPE), QKV_STRIDE};
        { const int nun = (S.nwg > (int)blockIdx.x) ? (S.nwg - (int)blockIdx.x + F.G - 1) / F.G : 0, kcut = (int)blockIdx.x % (nun + 1);
          pg8::RangeOrder R0{S, 0, kcut}, R1{S, kcut, nun};
          pg8::gemm_phase<pg8::EpiQKV, pg8::RangeOrder, true, true>(F.lds + RING_OFF, g, R0, E);
          __syncthreads();
          p0_moe_slice(F);
          __syncthreads();
          pg8::gemm_phase<pg8::EpiQKV, pg8::RangeOrder, true, true>(F.lds + RING_OFF, g, R1, E); }
        SEAM(1);
    }
    if (IN(2)) { p2_attention(F); SEAM(2); }
    if (IN(3)) { p3_merge(F); SEAM(3); }
    if (IN(4)) {
        pg8::Gemm g{(const pg8::bf16_t*)(F.ws + WS_MIX), (const pg8::bf16_t*)(F.ws + WS_WOUT), T, DM, DM}; pg8::StaticOrder S; S.init(T, DM, F.G, (int)blockIdx.x);
        pg8::EpiRes E{(const pg8::bf16_t*)(F.ws + WS_XN), (const float*)(F.ws + WS_RINV), (const float*)(F.ws + WS_GINV), (pg8::bf16_t*)(F.ws + WS_H16), F.ws + WS_H8};
        pg8::gemm_phase<pg8::EpiRes, pg8::StaticOrder, false, true>(F.lds + RING_OFF, g, S, E);
        SEAM(4);
    }
    if (IN(5)) { p5_router(F, CW_FILL); if (IN(7)) xcd_barrier(bar); }
    if (IN(7)) {
        const int ntiles = build_tiles(F);
        pg8::MoeOrder S; S.init(ntiles, 8, F.G, (int)blockIdx.x, (const LAS int*)(F.lds + LDS_TEXP));
        build_idx(F, S, 1024u);
        pg8::EpiSwiGLU E{F.ws + WS_ACT, F.b_gu, (const float*)(F.ws + WS_RSCALE), (const LAS int*)(F.lds + LDS_TSTART)};
        pg8::gemm_phase2<pg8::EpiSwiGLU, pg8::MoeOrder, true, true, 122>(F.lds + RING_OFF, F.ws + WS_H8, F.ws + WS_WGU, 1024, 1024, 8, S, E, (const LAS unsigned*)(F.lds + LDS_IDX), F.lds + LDS_IDX + 20480);
        SEAM(7);
    }
    if (IN(8)) {
        const int ntiles = (N_LAUNCHES != 1) ? build_tiles(F) : ((const LAS int*)(F.lds + LDS_TSTART))[NE];
        pg8::MoeOrder S; S.init(ntiles, 4, F.G, (int)blockIdx.x, (const LAS int*)(F.lds + LDS_TEXP));
        pg8::EpiOut8 E{F.ws + WS_XB, (const float*)(F.ws + WS_BDN32)};
        pg8::gemm_phase2<pg8::EpiOut8, pg8::MoeOrder, false, true, 122>(F.lds + RING_OFF, F.ws + WS_ACT, F.ws + WS_WDN, 1024, 1024, 8, S, E, nullptr, F.lds + LDS_IDX + 20480);
        SEAM(8);
    }
    if (IN(9)) { p9_combine(F, F.out); }
#undef IN
#undef SEAM
}

extern "C" void kernel_launch(void* const* d_in, const int* in_sizes, int n_in, void* d_out, int out_size, void* d_ws, size_t ws_size, hipStream_t stream) {
    static int grid = 0;
    if (grid == 0) {
        if (n_in != 15 || in_sizes[0] != T * DM || out_size != T * DM || ws_size < WS_END) { fprintf(stderr, "kernel_launch: unexpected shapes/workspace (n_in %d, ws %zu)\n", n_in, ws_size); grid = -1; return; }
        int dev = 0, cus = 0, per_cu = 0;
        if (hipGetDevice(&dev) != hipSuccess || hipDeviceGetAttribute(&cus, hipDeviceAttributeMultiprocessorCount, dev) != hipSuccess) { grid = -1; return; }
        if (hipFuncSetAttribute((const void*)hyb_fwd, hipFuncAttributeMaxDynamicSharedMemorySize, LDS_BYTES) != hipSuccess) { fprintf(stderr, "kernel_launch: hipFuncSetAttribute failed\n"); grid = -1; return; }
        if (hipOccupancyMaxActiveBlocksPerMultiprocessor(&per_cu, (const void*)hyb_fwd, 512, LDS_BYTES) != hipSuccess || per_cu < 1) { fprintf(stderr, "kernel_launch: occupancy query says %d\n", per_cu); per_cu = 1; }
        (void)hipGetLastError();
        grid = cus;
    }
    if (grid < 0) return;
    if (hipMemsetAsync((char*)d_ws + WS_CTL, 0, CTL_ZERO_BYTES, stream) != hipSuccess) { fprintf(stderr, "kernel_launch: memset failed\n"); return; }
    Args a{};
    for (int i = 0; i < 15; ++i) a.in[i] = (const float*)d_in[i];
    a.out = (float*)d_out; a.ws = (unsigned char*)d_ws;
    if (N_LAUNCHES == 1) {
        a.ph_lo = 0; a.ph_hi = PER_PHASE;
        void* kargs[] = {&a};
        const hipError_t le = hipLaunchCooperativeKernel((const void*)hyb_fwd, dim3(grid), dim3(512), kargs, LDS_BYTES, stream);
        if (le != hipSuccess) fprintf(stderr, "kernel_launch: cooperative launch failed: %s (grid %d)\n", hipGetErrorName(le), grid);
    } else {
        for (int li = 0; li < PER_PHASE; ++li) {
            a.ph_lo = li; a.ph_hi = li + 1;
            hipLaunchKernelGGL(hyb_fwd, dim3(grid), dim3(512), LDS_BYTES, stream, a);
        }
    }
}
```

```cpp
#include <hip/hip_runtime.h>
#include <hip/hip_bf16.h>
#include <cstdio>
#include <cstdint>
#include <cmath>

#ifndef MK_N_LAUNCHES
#define MK_N_LAUNCHES 1
#endif

constexpr int N_LAUNCHES = MK_N_LAUNCHES;
constexpr int BATCH = 4, SEQ = 8192, DM = 1024, T = BATCH * SEQ;
constexpr int NH = 8, HD = 64, AW = 512, NPROJ = 3072;
constexpr int NE = 32, TOPK = 4, FF = 1024;
constexpr int MASSIGN = T * TOPK;
constexpr int PMAX = MASSIGN + NE * 256;
constexpr int MAXTILES = PMAX / 256;
constexpr float NORM_EPS = 1e-5f;
constexpr float QSCALE = 0.125f * 1.4426950408889634f;

namespace pg8 {
#define PG8_LAS __attribute__((address_space(3)))
typedef unsigned short bf16_t;
typedef short bf16x8 __attribute__((ext_vector_type(8)));
typedef float f32x4 __attribute__((ext_vector_type(4)));
typedef unsigned u32x4 __attribute__((ext_vector_type(4)));
constexpr int BM = 256, BK = 64, HALF = 128, HTB = HALF * BK * 2  , STAGE_BYTES = 8 * HTB, NXCD = 8, WGM = 8;

__host__ __device__ __forceinline__ int lds_byte(int r, int c) { const int st = (r >> 4) * 2 + (c >> 5), rr = r & 15, cc = c & 31, ob = rr * 64 + cc * 2; return st * 1024 + (ob ^ (((ob >> 9) & 1) << 5)); }
__host__ __device__ __forceinline__ void stage_rc(int b, int& R, int& C) { const int st = b / 1024, sb = b % 1024, swz = sb ^ (((sb >> 9) & 1) << 5); R = (st >> 1) * 16 + swz / 64; C = (st & 1) * 32 + (swz % 64) / 2; }
__host__ __device__ __forceinline__ int perm32(int rho) { const int n = rho >> 4, i = rho & 15; return 8 * (i >> 2) + 4 * n + (i & 3); }

struct Unit { int pm, pn; };
struct Gemm { const bf16_t* A; const bf16_t* Bt; int M, N, K; };

struct StaticOrder {
    int nM, nN, nwg, G, c;
    __host__ __device__ void init(int M, int N, int G_, int c_) { nM = M / BM; nN = N / BM; nwg = nM * nN; G = G_; c = c_; }
    __host__ __device__ bool next(int i, Unit& u) const {
        const long L = (long)i * G + c; if (L >= nwg) return false;
        int wgid = (int)L; { const int q = nwg / NXCD, r = nwg % NXCD, xcd = wgid % NXCD, off = wgid / NXCD; wgid = (xcd < r ? xcd * (q + 1) : r * (q + 1) + (xcd - r) * q) + off; }
        const int nig = WGM * nN, gid = wgid / nig, fm = gid * WGM, gsz = (nM - fm) < WGM ? (nM - fm) : WGM;
        u.pm = fm + ((wgid % nig) % gsz); u.pn = (wgid % nig) / gsz; return true;
    }
    __device__ __forceinline__ void a_ready(const Unit&) const {}
    __device__ __forceinline__ void done(const Unit&) const {}
};

struct RangeOrder {
    StaticOrder base; int lo, hi;
    __host__ __device__ bool next(int i, Unit& u) const { return (lo + i < hi) && base.next(lo + i, u); }
    __device__ __forceinline__ void a_ready(const Unit&) const {}
    __device__ __forceinline__ void done(const Unit&) const {}
};
__device__ __forceinline__ unsigned cvt_pk_bf16(float lo, float hi) { unsigned r; asm volatile("v_cvt_pk_bf16_f32 %0, %1, %2" : "=v"(r) : "v"(lo), "v"(hi)); return r; }
typedef float f32x2 __attribute__((ext_vector_type(2)));
__device__ __forceinline__ f32x2 gelu_pk(f32x2 v) {
    const f32x2 av = __builtin_elementwise_abs(v), d = av * 0.2316418882f + 1.0f;
    f32x2 t; t.x = __builtin_amdgcn_rcpf(d.x); t.y = __builtin_amdgcn_rcpf(d.y);
    f32x2 q = t * 0.5307027145f + (-0.7265760135f); q = q * t + 0.7107068705f; q = q * t + (-0.142248368f); q = q * t + 0.127414796f; q = q * t;
    const f32x2 s = (v * v) * (-0.72134752044f);
    f32x2 e; e.x = __builtin_amdgcn_exp2f(s.x); e.y = __builtin_amdgcn_exp2f(s.y);
    const f32x2 m = v * (q * e), r = v - m;
    f32x2 o; o.x = v.x < 0.f ? m.x : r.x; o.y = v.y < 0.f ? m.y : r.y; return o;
}

template <int ACT  > struct EpiBf16 {
    static constexpr bool PERM = true, AFTER_DRAIN = false; static_assert(ACT == 0 || ACT == 1, "EpiBf16: ACT is 0 (none) or 1 (gelu_pk)");
    bf16_t* O; int ldc; const float* bias; int split_cols; size_t split_stride; float scale0;
    __device__ __forceinline__ void operator()(const f32x4 (&acc)[2][2][4][2], const Unit& u, int wr, int wc, int fr, int fq) const {
        const int row0 = u.pm * BM + wr * 64 + fr; int colt = u.pn * BM; bf16_t* base = O;
        float sc = 1.f; if (split_cols) { const int t = colt / split_cols; base += (size_t)t * split_stride; colt -= t * split_cols; if (t == 0) sc = scale0; }
        const int col0 = colt + wc * 32 + 8 * fq, bcol0 = u.pn * BM + wc * 32 + 8 * fq;
        f32x4 bv[2][2];
#pragma unroll
        for (int bj = 0; bj < 2; ++bj)
#pragma unroll
            for (int n = 0; n < 2; ++n) bv[bj][n] = bias ? *(const f32x4*)(bias + bcol0 + bj * HALF + 4 * n) : (f32x4){0.f, 0.f, 0.f, 0.f};
#pragma unroll
        for (int ai = 0; ai < 2; ++ai)
#pragma unroll
            for (int m = 0; m < 4; ++m) { bf16_t* rowp = base + (size_t)(row0 + ai * HALF + m * 16) * ldc + col0;
#pragma unroll
                for (int bj = 0; bj < 2; ++bj) { f32x4 v0 = acc[ai][bj][m][0] + bv[bj][0], v1 = acc[ai][bj][m][1] + bv[bj][1];
                    if (ACT == 1) { f32x2 a = gelu_pk((f32x2){v0[0], v0[1]}), b = gelu_pk((f32x2){v0[2], v0[3]}), c = gelu_pk((f32x2){v1[0], v1[1]}), d = gelu_pk((f32x2){v1[2], v1[3]});
                        v0 = (f32x4){a.x, a.y, b.x, b.y}; v1 = (f32x4){c.x, c.y, d.x, d.y}; }
                    v0 = v0 * sc; v1 = v1 * sc; u32x4 w; w.x = cvt_pk_bf16(v0[0], v0[1]); w.y = cvt_pk_bf16(v0[2], v0[3]); w.z = cvt_pk_bf16(v1[0], v1[1]); w.w = cvt_pk_bf16(v1[2], v1[3]);
                    *(u32x4*)(rowp + bj * HALF) = w; } }
    }
};

typedef unsigned u32x4_t __attribute__((ext_vector_type(4)));
typedef unsigned u32x2_t __attribute__((ext_vector_type(2)));
__device__ __forceinline__ unsigned pk4_fp8(float a, float b, float c, float d);
__device__ __forceinline__ u32x4_t widen_rows16(const u32x2_t wa, const u32x2_t wb) {
    const auto r0 = __builtin_amdgcn_permlane16_swap(wa.x, wb.x, false, false); const auto r1 = __builtin_amdgcn_permlane16_swap(wa.y, wb.y, false, false);
    u32x4_t o; o.x = r0[0]; o.y = r1[0]; o.z = r0[1]; o.w = r1[1]; return o;
}
__device__ __forceinline__ unsigned pk4_fp8(float a, float b, float c, float d) { int r = __builtin_amdgcn_cvt_pk_fp8_f32(a, b, 0, false); r = __builtin_amdgcn_cvt_pk_fp8_f32(c, d, r, true); return (unsigned)r; }
struct EpiQKV {
    static constexpr bool PERM = true, AFTER_DRAIN = false;
    bf16_t* __restrict__ out; const float* __restrict__ cs; size_t bufstride;
    __device__ __forceinline__ void operator()(const f32x4 (&acc)[2][2][4][2], const Unit& u, int wr, int wc, int fr, int fq) const {
        const int buf = u.pn >> 1; bf16_t* base = out + (size_t)buf * bufstride;
        const int row0 = u.pm * BM + wr * 64 + fr;
        if (u.pn < 4) {
            const float sc = (u.pn < 2) ? 0.125f * 1.4426950408889634f : 1.0f;
            const int head = (u.pn & 1) * 4 + wc;
#pragma unroll
            for (int ai = 0; ai < 2; ++ai) {
                f32x4 cv[4][4];
#pragma unroll
                for (int m = 0; m < 4; ++m) { const int pos = (row0 + ai * HALF + m * 16) & 8191; const f32x4* cp = (const f32x4*)(cs + (size_t)pos * 64 + fq * 16);
                    cv[m][0] = cp[0]; cv[m][1] = cp[1]; cv[m][2] = cp[2]; cv[m][3] = cp[3]; }
#pragma unroll
                for (int m = 0; m < 4; ++m) {
                    const int row = row0 + ai * HALF + m * 16;
                    const f32x4 c0 = cv[m][0], c1 = cv[m][1], c2 = cv[m][2], c3 = cv[m][3];
                    const f32x4 lo0 = acc[ai][0][m][0], lo1 = acc[ai][0][m][1], hi0 = acc[ai][1][m][0], hi1 = acc[ai][1][m][1];
                    float ol[8], oh[8];
                    ol[0] = lo0[0] * c0[0] - hi0[0] * c0[1]; oh[0] = hi0[0] * c0[0] + lo0[0] * c0[1];
                    ol[1] = lo0[1] * c0[2] - hi0[1] * c0[3]; oh[1] = hi0[1] * c0[2] + lo0[1] * c0[3];
                    ol[2] = lo0[2] * c1[0] - hi0[2] * c1[1]; oh[2] = hi0[2] * c1[0] + lo0[2] * c1[1];
                    ol[3] = lo0[3] * c1[2] - hi0[3] * c1[3]; oh[3] = hi0[3] * c1[2] + lo0[3] * c1[3];
                    ol[4] = lo1[0] * c2[0] - hi1[0] * c2[1]; oh[4] = hi1[0] * c2[0] + lo1[0] * c2[1];
                    ol[5] = lo1[1] * c2[2] - hi1[1] * c2[3]; oh[5] = hi1[1] * c2[2] + lo1[1] * c2[3];
                    ol[6] = lo1[2] * c3[0] - hi1[2] * c3[1]; oh[6] = hi1[2] * c3[0] + lo1[2] * c3[1];
                    ol[7] = lo1[3] * c3[2] - hi1[3] * c3[3]; oh[7] = hi1[3] * c3[2] + lo1[3] * c3[3];
                    u32x4_t wl, wh;
                    wl.x = cvt_pk_bf16(ol[0] * sc, ol[1] * sc); wl.y = cvt_pk_bf16(ol[2] * sc, ol[3] * sc); wl.z = cvt_pk_bf16(ol[4] * sc, ol[5] * sc); wl.w = cvt_pk_bf16(ol[6] * sc, ol[7] * sc);
                    wh.x = cvt_pk_bf16(oh[0] * sc, oh[1] * sc); wh.y = cvt_pk_bf16(oh[2] * sc, oh[3] * sc); wh.z = cvt_pk_bf16(oh[4] * sc, oh[5] * sc); wh.w = cvt_pk_bf16(oh[6] * sc, oh[7] * sc);
                    bf16_t* rowp = base + (size_t)row * 512 + head * 64 + 8 * fq;
                    *(u32x4_t*)(rowp) = wl; *(u32x4_t*)(rowp + 32) = wh;
                }
            }
        } else if (u.pn == 6 || u.pn == 7 || u.pn >= 10) {
            const int j = (u.pn >= 10) ? u.pn - 8 : u.pn - 6; bf16_t* zb = out + 3 * bufstride;
#pragma unroll
            for (int ai = 0; ai < 2; ++ai)
#pragma unroll
                for (int m = 0; m < 4; ++m) { const f32x4 z0 = acc[ai][0][m][0] * acc[ai][1][m][0], z1 = acc[ai][0][m][1] * acc[ai][1][m][1];
                    u32x4_t w; w.x = cvt_pk_bf16(z0[0], z0[1]); w.y = cvt_pk_bf16(z0[2], z0[3]); w.z = cvt_pk_bf16(z1[0], z1[1]); w.w = cvt_pk_bf16(z1[2], z1[3]);
                    *(u32x4_t*)(zb + (size_t)(row0 + ai * HALF + m * 16) * 512 + 128 * j + wc * 32 + 8 * fq) = w; }
        } else {
            const int col0 = (u.pn & 1) * 256 + wc * 32 + 8 * fq;
#pragma unroll
            for (int ai = 0; ai < 2; ++ai)
#pragma unroll
                for (int m = 0; m < 4; ++m) { bf16_t* rowp = base + (size_t)(row0 + ai * HALF + m * 16) * 512 + col0;
#pragma unroll
                    for (int bj = 0; bj < 2; ++bj) { const f32x4 v0 = acc[ai][bj][m][0], v1 = acc[ai][bj][m][1];
                        u32x4_t w; w.x = cvt_pk_bf16(v0[0], v0[1]); w.y = cvt_pk_bf16(v0[2], v0[3]); w.z = cvt_pk_bf16(v1[0], v1[1]); w.w = cvt_pk_bf16(v1[2], v1[3]);
                        *(u32x4_t*)(rowp + bj * HALF) = w; } }
        }
    }
};
struct EpiRes {
    static constexpr bool PERM = true, AFTER_DRAIN = false;
    const bf16_t* __restrict__ xn; const float* __restrict__ rinv; const float* __restrict__ ginv; bf16_t* __restrict__ out; unsigned char* __restrict__ out8;
    __device__ __forceinline__ void operator()(const f32x4 (&acc)[2][2][4][2], const Unit& u, int wr, int wc, int fr, int fq) const {
        const int row0 = u.pm * BM + wr * 64 + fr, col0 = u.pn * BM + wc * 32 + 8 * fq;
        f32x4 gi[2][2];
#pragma unroll
        for (int bj = 0; bj < 2; ++bj) { gi[bj][0] = *(const f32x4*)(ginv + col0 + bj * HALF); gi[bj][1] = *(const f32x4*)(ginv + col0 + bj * HALF + 4); }
#pragma unroll
        for (int ai = 0; ai < 2; ++ai) {
            u32x4_t xw[4][2]; float ri[4];
#pragma unroll
            for (int m = 0; m < 4; ++m) { const int row = row0 + ai * HALF + m * 16; ri[m] = rinv[row];
#pragma unroll
                for (int bj = 0; bj < 2; ++bj) xw[m][bj] = *(const u32x4_t*)(xn + (size_t)row * 1024 + col0 + bj * HALF); }
            u32x2_t w8[2][2];
#pragma unroll
            for (int m = 0; m < 4; ++m) { const int row = row0 + ai * HALF + m * 16; const size_t off = (size_t)row * 1024 + col0;
#pragma unroll
                for (int bj = 0; bj < 2; ++bj) { const u32x4_t q = xw[m][bj];
                    f32x4 xa, xb;
                    xa[0] = __builtin_bit_cast(float, q.x << 16); xa[1] = __builtin_bit_cast(float, q.x & 0xffff0000u); xa[2] = __builtin_bit_cast(float, q.y << 16); xa[3] = __builtin_bit_cast(float, q.y & 0xffff0000u);
                    xb[0] = __builtin_bit_cast(float, q.z << 16); xb[1] = __builtin_bit_cast(float, q.z & 0xffff0000u); xb[2] = __builtin_bit_cast(float, q.w << 16); xb[3] = __builtin_bit_cast(float, q.w & 0xffff0000u);
                    const f32x4 x0 = xa * gi[bj][0] * ri[m] + acc[ai][bj][m][0], x1 = xb * gi[bj][1] * ri[m] + acc[ai][bj][m][1];
                    u32x4_t w; w.x = cvt_pk_bf16(x0[0], x0[1]); w.y = cvt_pk_bf16(x0[2], x0[3]); w.z = cvt_pk_bf16(x1[0], x1[1]); w.w = cvt_pk_bf16(x1[2], x1[3]);
                    *(u32x4_t*)(out + off + bj * HALF) = w;
                    w8[m & 1][bj].x = pk4_fp8(x0[0], x0[1], x0[2], x0[3]); w8[m & 1][bj].y = pk4_fp8(x1[0], x1[1], x1[2], x1[3]); }
                if (m & 1) {
#pragma unroll
                    for (int bj = 0; bj < 2; ++bj) *(u32x4_t*)(out8 + (size_t)(row0 + ai * HALF + ((m & ~1) + (fq & 1)) * 16) * 1024 + u.pn * BM + wc * 32 + 8 * (fq & ~1) + bj * HALF) = widen_rows16(w8[0][bj], w8[1][bj]); } }
        }
    }
};
struct EpiRes8 {
    static constexpr bool PERM = true, AFTER_DRAIN = false;
    const bf16_t* __restrict__ xn; const float* __restrict__ rinv; const float* __restrict__ ginv; bf16_t* __restrict__ out; unsigned char* __restrict__ out8;
    __device__ __forceinline__ void prefetch(const Unit&, PG8_LAS unsigned char*, int, int) const {}
    __device__ __forceinline__ void operator()(const f32x4 (&acc)[2][2][4][2], const Unit& u, int wr, int wc, int fr, int fq, const PG8_LAS unsigned char*) const {
        const int row0 = u.pm * BM + wr * 64 + fr, col0 = u.pn * BM + wc * 32 + 8 * fq;
        f32x4 gi[2][2];
#pragma unroll
        for (int bj = 0; bj < 2; ++bj) { gi[bj][0] = *(const f32x4*)(ginv + col0 + bj * HALF); gi[bj][1] = *(const f32x4*)(ginv + col0 + bj * HALF + 4); }
#pragma unroll
        for (int ai = 0; ai < 2; ++ai) {
            u32x4_t xw[4][2]; float ri[4];
#pragma unroll
            for (int m = 0; m < 4; ++m) { const int row = row0 + ai * HALF + m * 16; ri[m] = rinv[row];
#pragma unroll
                for (int bj = 0; bj < 2; ++bj) xw[m][bj] = *(const u32x4_t*)(xn + (size_t)row * 1024 + col0 + bj * HALF); }
            u32x2_t w8[2][2];
#pragma unroll
            for (int m = 0; m < 4; ++m) { const int row = row0 + ai * HALF + m * 16; const size_t off = (size_t)row * 1024 + col0;
#pragma unroll
                for (int bj = 0; bj < 2; ++bj) { const u32x4_t q = xw[m][bj];
                    f32x4 xa, xb;
                    xa[0] = __builtin_bit_cast(float, q.x << 16); xa[1] = __builtin_bit_cast(float, q.x & 0xffff0000u); xa[2] = __builtin_bit_cast(float, q.y << 16); xa[3] = __builtin_bit_cast(float, q.y & 0xffff0000u);
                    xb[0] = __builtin_bit_cast(float, q.z << 16); xb[1] = __builtin_bit_cast(float, q.z & 0xffff0000u); xb[2] = __builtin_bit_cast(float, q.w << 16); xb[3] = __builtin_bit_cast(float, q.w & 0xffff0000u);
                    const f32x4 x0 = xa * gi[bj][0] * ri[m] + acc[ai][bj][m][0] * 0.03125f, x1 = xb * gi[bj][1] * ri[m] + acc[ai][bj][m][1] * 0.03125f;
                    u32x4_t w; w.x = cvt_pk_bf16(x0[0], x0[1]); w.y = cvt_pk_bf16(x0[2], x0[3]); w.z = cvt_pk_bf16(x1[0], x1[1]); w.w = cvt_pk_bf16(x1[2], x1[3]);
                    *(u32x4_t*)(out + off + bj * HALF) = w;
                    w8[m & 1][bj].x = pk4_fp8(x0[0], x0[1], x0[2], x0[3]); w8[m & 1][bj].y = pk4_fp8(x1[0], x1[1], x1[2], x1[3]); }
                if (m & 1) {
#pragma unroll
                    for (int bj = 0; bj < 2; ++bj) *(u32x4_t*)(out8 + (size_t)(row0 + ai * HALF + ((m & ~1) + (fq & 1)) * 16) * 1024 + u.pn * BM + wc * 32 + 8 * (fq & ~1) + bj * HALF) = widen_rows16(w8[0][bj], w8[1][bj]); } }
        }
    }
};
struct EpiSwiGLU {
    static constexpr bool PERM = true, AFTER_DRAIN = false;
    unsigned char* act; const float* bgu; const float* rscale; const __attribute__((address_space(3))) int* tstart;
    __device__ __forceinline__ void prefetch(const Unit& nu, PG8_LAS unsigned char* buf, int wid, int lane) const {
        const int e = nu.pn >> 3, pnl = nu.pn & 7;
        if (wid == 0) { const float* src = bgu + (size_t)e * 2048 + 128 * pnl + ((lane < 32) ? 4 * lane : 1024 + 4 * (lane - 32));
            __builtin_amdgcn_global_load_lds((const unsigned*)src, (PG8_LAS unsigned*)buf, 16, 0, 0); }
        if (wid == 1) { const float* src = rscale + (size_t)e * 32768 + (size_t)(nu.pm - tstart[e]) * BM + 4 * lane;
            __builtin_amdgcn_global_load_lds((const unsigned*)src, (PG8_LAS unsigned*)(buf + 1024), 16, 0, 0); }
    }
    __device__ __forceinline__ void operator()(const f32x4 (&acc)[2][2][4][2], const Unit& u, int wr, int wc, int fr, int fq, const PG8_LAS unsigned char* buf) const {
        const int pnl = u.pn & 7;
        const int row0 = u.pm * BM + wr * 64 + fr;
        f32x4 bg[2], bu[2];
#pragma unroll
        for (int n = 0; n < 2; ++n) { bg[n] = *(const PG8_LAS f32x4*)(buf + (32 * wc + 8 * fq + 4 * n) * 4); bu[n] = *(const PG8_LAS f32x4*)(buf + 512 + (32 * wc + 8 * fq + 4 * n) * 4); }
        float rsv[2][4]; u32x2_t wq[2];
#pragma unroll
        for (int ai = 0; ai < 2; ++ai)
#pragma unroll
            for (int m = 0; m < 4; ++m) rsv[ai][m] = *(const PG8_LAS float*)(buf + 1024 + (ai * HALF + wr * 64 + m * 16 + fr) * 4);
#pragma unroll
        for (int ai = 0; ai < 2; ++ai)
#pragma unroll
            for (int m = 0; m < 4; ++m) {
                const float rs = rsv[ai][m] * 0.03125f;
                f32x2 o[4];
#pragma unroll
                for (int n = 0; n < 2; ++n)
#pragma unroll
                    for (int h = 0; h < 2; ++h) {
                        const f32x2 a = {acc[ai][0][m][n][2 * h], acc[ai][0][m][n][2 * h + 1]}, b = {acc[ai][1][m][n][2 * h], acc[ai][1][m][n][2 * h + 1]};
                        const f32x2 bgp = {bg[n][2 * h], bg[n][2 * h + 1]}, bup = {bu[n][2 * h], bu[n][2 * h + 1]};
                        const f32x2 gv = a * rs + bgp, uv = b * rs + bup;
                        f32x2 g, up; g.x = fminf(gv.x, 7.0f); g.y = fminf(gv.y, 7.0f); up.x = __builtin_amdgcn_fmed3f(uv.x, -7.0f, 7.0f); up.y = __builtin_amdgcn_fmed3f(uv.y, -7.0f, 7.0f);
                        const f32x2 tt = g * (-1.702f * 1.4426950408889634f);
                        f32x2 ex; ex.x = __builtin_amdgcn_exp2f(tt.x); ex.y = __builtin_amdgcn_exp2f(tt.y);
                        const f32x2 dd = ex + 1.0f;
                        f32x2 rr; rr.x = __builtin_amdgcn_rcpf(dd.x); rr.y = __builtin_amdgcn_rcpf(dd.y);
                        o[2 * n + h] = (up + 1.0f) * (g * rr);
                    }
                wq[m & 1].x = pk4_fp8(o[0].x, o[0].y, o[1].x, o[1].y); wq[m & 1].y = pk4_fp8(o[2].x, o[2].y, o[3].x, o[3].y);
                if (m & 1) *(u32x4_t*)(act + (size_t)(row0 + ai * HALF + ((m & ~1) + (fq & 1)) * 16) * 1024 + 128 * pnl + 32 * wc + 8 * (fq & ~1)) = widen_rows16(wq[0], wq[1]);
            }
    }
};
struct EpiOut8 {
    static constexpr bool PERM = true, AFTER_DRAIN = false;
    unsigned char* out; const float* bias32;
    __device__ __forceinline__ void prefetch(const Unit& nu, PG8_LAS unsigned char* buf, int wid, int lane) const {
        if (wid == 0) { const float* src = bias32 + (size_t)(nu.pn >> 2) * 1024 + 256 * (nu.pn & 3) + 4 * lane;
            __builtin_amdgcn_global_load_lds((const unsigned*)src, (PG8_LAS unsigned*)buf, 16, 0, 0); }
    }
    __device__ __forceinline__ void operator()(const f32x4 (&acc)[2][2][4][2], const Unit& u, int wr, int wc, int fr, int fq, const PG8_LAS unsigned char* buf) const {
        const int pnl = u.pn & 3;
        const int row0 = u.pm * BM + wr * 64 + fr;
        f32x4 bv[2][2];
#pragma unroll
        for (int bj = 0; bj < 2; ++bj)
#pragma unroll
            for (int n = 0; n < 2; ++n) bv[bj][n] = *(const PG8_LAS f32x4*)(buf + (bj * HALF + 32 * wc + 8 * fq + 4 * n) * 4);
        const int odd = fq & 1, colw = 256 * pnl + 32 * wc + 8 * (fq & ~1);
#pragma unroll
        for (int ai = 0; ai < 2; ++ai)
#pragma unroll
            for (int mp = 0; mp < 2; ++mp) { unsigned char* rowp = out + (size_t)(row0 + ai * HALF + (2 * mp + odd) * 16) * 1024 + colw;
#pragma unroll
                for (int bj = 0; bj < 2; ++bj) { u32x2_t w[2];
#pragma unroll
                    for (int q = 0; q < 2; ++q) { const int m = 2 * mp + q; const f32x4 v0 = (acc[ai][bj][m][0] + bv[bj][0]) * 0.25f, v1 = (acc[ai][bj][m][1] + bv[bj][1]) * 0.25f;
                        w[q].x = pk4_fp8(v0[0], v0[1], v0[2], v0[3]); w[q].y = pk4_fp8(v1[0], v1[1], v1[2], v1[3]); }
                    *(u32x4_t*)(rowp + bj * HALF) = widen_rows16(w[0], w[1]); } }
    }
};
struct MoeOrder {
    int ntiles, npn, nwg, G, c; const __attribute__((address_space(3))) int* texp;
    __device__ void init(int ntiles_, int npn_, int G_, int c_, const __attribute__((address_space(3))) int* texp_) { ntiles = ntiles_; npn = npn_; nwg = ntiles_ * npn_; G = G_; c = c_; texp = texp_; }
    __device__ bool next(int i, Unit& u) const {
        const long L = (long)i * G + c; if (L >= nwg) return false;
        int wgid = (int)L; { const int q = nwg / NXCD, r = nwg % NXCD, xcd = wgid % NXCD, off = wgid / NXCD; wgid = (xcd < r ? xcd * (q + 1) : r * (q + 1) + (xcd - r) * q) + off; }
        constexpr int WG2 = 4; const int nig = WG2 * npn, gid = wgid / nig, fm = gid * WG2, gsz = (ntiles - fm) < WG2 ? (ntiles - fm) : WG2;
        const int t = fm + ((wgid % nig) % gsz), pnl = (wgid % nig) / gsz;
        const int e = texp[t];
        u.pm = t; u.pn = e * npn + pnl; return true;
    }
    __device__ __forceinline__ void a_ready(const Unit&) const {}
    __device__ __forceinline__ void done(const Unit&) const {}
};
template <class Epi, class Sched, bool ALIGN_EPI = false, bool SP2 = false>
__device__ __forceinline__ void gemm_phase(PG8_LAS unsigned char* lds, const Gemm g, const Sched& S, const Epi& E) {
    const int tid = threadIdx.x, wid = __builtin_amdgcn_readfirstlane(tid >> 6), lane = tid & 63, wr = wid >> 2, wc = wid & 3, fr = lane & 15, fq = lane >> 4;
    const int K = g.K, nt = K / BK;
    unsigned voffA[2], voffB[2];
#pragma unroll
    for (int i = 0; i < 2; ++i) { int R, C; stage_rc(tid * 16 + i * 8192, R, C); const int Rb = Epi::PERM ? ((R & ~31) + perm32(R & 31)) : R;
        voffA[i] = (unsigned)(R * K + C) * 2u; voffB[i] = (unsigned)(Rb * K + C) * 2u; }
    const size_t kstep = (size_t)(BK * 2);
    const size_t hstep = (size_t)HALF * K * 2;
    const size_t tstep = 2 * hstep;
    const unsigned ldsw = (unsigned)wid * 1024u;
    const int aoff = lds_byte(wr * 64 + fr, fq * 8), boff = lds_byte(wc * 32 + fr, fq * 8);
#define PG8_SA(b, h) (((b) * 2 + (h)) * HTB)
#define PG8_SB(b, h) ((4 + (b) * 2 + (h)) * HTB)
#define PG8_STAGE(bufoff, gbase, voff) do { _Pragma("unroll") for (int _i = 0; _i < 2; ++_i) \
        __builtin_amdgcn_global_load_lds((const unsigned*)((const char*)(gbase) + (voff)[_i]), (PG8_LAS unsigned*)(lds + (bufoff) + ldsw + _i * 8192), 16, 0, 0); } while (0)
#define PG8_LDA(dst, b, h) do { _Pragma("unroll") for (int m = 0; m < 4; ++m) _Pragma("unroll") for (int k = 0; k < 2; ++k) dst[m][k] = *(const PG8_LAS bf16x8*)(lds + PG8_SA(b, h) + aoff + m * 2048 + k * 1024); } while (0)
#define PG8_LDB(dst, b, h) do { _Pragma("unroll") for (int n = 0; n < 2; ++n) _Pragma("unroll") for (int k = 0; k < 2; ++k) dst[n][k] = *(const PG8_LAS bf16x8*)(lds + PG8_SB(b, h) + boff + n * 2048 + k * 1024); } while (0)
#define PG8_MMA(ai, bj, At, Bt) do { __builtin_amdgcn_s_setprio(1); _Pragma("unroll") for (int m = 0; m < 4; ++m) _Pragma("unroll") for (int n = 0; n < 2; ++n) _Pragma("unroll") for (int k = 0; k < 2; ++k) \
        acc[ai][bj][m][n] = __builtin_amdgcn_mfma_f32_16x16x32_bf16(Bt[n][k], At[m][k], acc[ai][bj][m][n], 0, 0, 0); __builtin_amdgcn_s_setprio(0); } while (0)
#define PG8_WAIT_V(n) asm volatile("s_waitcnt vmcnt(" #n ")" ::: "memory")
#define PG8_WAIT_L(n) asm volatile("s_waitcnt lgkmcnt(" #n ")" ::: "memory")
#define PG8_BAR __builtin_amdgcn_s_barrier()
#define PG8_SCHED __builtin_amdgcn_sched_barrier(0)
    Unit cur, nxt; int ui = 0;
    if (!S.next(0, cur)) return;
    f32x4 acc[2][2][4][2];
#pragma unroll
    for (int a = 0; a < 2; ++a)
#pragma unroll
        for (int b = 0; b < 2; ++b)
#pragma unroll
            for (int m = 0; m < 4; ++m)
#pragma unroll
                for (int n = 0; n < 2; ++n) acc[a][b][m][n] = (f32x4){0.f, 0.f, 0.f, 0.f};
    bf16x8 At[4][2], B0[2][2], B1[2][2];
    const char* cA = (const char*)g.A + (size_t)cur.pm * tstep; const char* cB = (const char*)g.Bt + (size_t)cur.pn * tstep;
    S.a_ready(cur);
    if constexpr (SP2) {
        PG8_STAGE(PG8_SB(0, 0), cB, voffB); PG8_STAGE(PG8_SB(0, 1), cB + hstep, voffB); PG8_STAGE(PG8_SA(0, 0), cA, voffA); PG8_STAGE(PG8_SA(0, 1), cA + hstep, voffA);
        if (wr == 1) PG8_BAR;
        PG8_WAIT_V(2); PG8_BAR;
        PG8_STAGE(PG8_SB(1, 0), cB + kstep, voffB); PG8_STAGE(PG8_SA(1, 0), cA + kstep, voffA); PG8_STAGE(PG8_SB(1, 1), cB + hstep + kstep, voffB);
        PG8_WAIT_V(6); PG8_BAR;
    } else {
        PG8_STAGE(PG8_SB(0, 0), cB, voffB); PG8_STAGE(PG8_SA(0, 0), cA, voffA); PG8_STAGE(PG8_SB(0, 1), cB + hstep, voffB); PG8_STAGE(PG8_SA(0, 1), cA + hstep, voffA);
        if (wr == 1) PG8_BAR;
        PG8_WAIT_V(4); PG8_BAR;
        PG8_STAGE(PG8_SB(1, 0), cB + kstep, voffB); PG8_STAGE(PG8_SA(1, 0), cA + kstep, voffA); PG8_STAGE(PG8_SB(1, 1), cB + hstep + kstep, voffB);
        PG8_WAIT_V(6); PG8_BAR;
    }
    for (;;) {
        const bool has_next = S.next(ui + 1, nxt);
        const char* nA = has_next ? (const char*)g.A + (size_t)nxt.pm * tstep : cA; const char* nB = has_next ? (const char*)g.Bt + (size_t)nxt.pn * tstep : cB;
        for (int t = 0; t < nt; t += 2) {
            const bool last = (t == nt - 2);
            const char* a1 = cA + (size_t)(t + 1) * kstep;
            const char* a2 = last ? nA : cA + (size_t)(t + 2) * kstep; const char* b2 = last ? nB : cB + (size_t)(t + 2) * kstep;
            const char* a3 = a2 + kstep; const char* b3 = b2 + kstep;
            if (last && has_next) S.a_ready(nxt);
            if constexpr (SP2) {
            PG8_LDB(B0, 0, 0); PG8_LDB(B1, 0, 1); PG8_SCHED; PG8_LDA(At, 0, 0); PG8_STAGE(PG8_SA(1, 1), a1 + hstep, voffA);
            PG8_WAIT_V(8); PG8_WAIT_L(0); PG8_BAR; PG8_MMA(0, 0, At, B0); PG8_MMA(0, 1, At, B1); PG8_BAR; PG8_SCHED;
            PG8_LDA(At, 0, 1); PG8_STAGE(PG8_SB(0, 0), b2, voffB); PG8_STAGE(PG8_SB(0, 1), b2 + hstep, voffB); PG8_STAGE(PG8_SA(0, 0), a2, voffA);
            PG8_WAIT_V(8); PG8_WAIT_L(0); PG8_BAR; PG8_MMA(1, 0, At, B0); PG8_MMA(1, 1, At, B1); PG8_BAR; PG8_SCHED;
            PG8_LDB(B0, 1, 0); PG8_LDB(B1, 1, 1); PG8_SCHED; PG8_LDA(At, 1, 0); PG8_STAGE(PG8_SA(0, 1), a2 + hstep, voffA);
            PG8_WAIT_V(8); PG8_WAIT_L(0); PG8_BAR; PG8_MMA(0, 0, At, B0); PG8_MMA(0, 1, At, B1); PG8_BAR; PG8_SCHED;
            PG8_LDA(At, 1, 1); PG8_STAGE(PG8_SB(1, 0), b3, voffB); PG8_STAGE(PG8_SB(1, 1), b3 + hstep, voffB); PG8_STAGE(PG8_SA(1, 0), a3, voffA);
            PG8_WAIT_V(8); PG8_WAIT_L(0); PG8_BAR; PG8_MMA(1, 0, At, B0); PG8_MMA(1, 1, At, B1); PG8_BAR; PG8_SCHED;
            } else {
            PG8_LDB(B0, 0, 0); PG8_SCHED; PG8_LDA(At, 0, 0); PG8_STAGE(PG8_SA(1, 1), a1 + hstep, voffA);
            PG8_WAIT_L(8); PG8_BAR; PG8_WAIT_L(0); PG8_MMA(0, 0, At, B0); PG8_BAR; PG8_SCHED;
            PG8_LDB(B1, 0, 1); PG8_STAGE(PG8_SB(0, 0), b2, voffB);
            PG8_BAR; PG8_WAIT_L(0); PG8_MMA(0, 1, At, B1); PG8_BAR;
            PG8_LDA(At, 0, 1); PG8_STAGE(PG8_SA(0, 0), a2, voffA);
            PG8_BAR; PG8_WAIT_L(0); PG8_MMA(1, 0, At, B0); PG8_BAR; PG8_SCHED;
            PG8_STAGE(PG8_SB(0, 1), b2 + hstep, voffB);
            PG8_WAIT_V(6); PG8_BAR; PG8_MMA(1, 1, At, B1); PG8_BAR;
            PG8_LDB(B0, 1, 0); PG8_SCHED; PG8_LDA(At, 1, 0); PG8_STAGE(PG8_SA(0, 1), a2 + hstep, voffA);
            PG8_WAIT_L(8); PG8_BAR; PG8_WAIT_L(0); PG8_MMA(0, 0, At, B0); PG8_BAR; PG8_SCHED;
            PG8_LDB(B1, 1, 1); PG8_STAGE(PG8_SB(1, 0), b3, voffB);
            PG8_BAR; PG8_WAIT_L(0); PG8_MMA(0, 1, At, B1); PG8_BAR;
            PG8_LDA(At, 1, 1); PG8_STAGE(PG8_SA(1, 0), a3, voffA);
            PG8_BAR; PG8_WAIT_L(0); PG8_MMA(1, 0, At, B0); PG8_BAR; PG8_SCHED;
            PG8_STAGE(PG8_SB(1, 1), b3 + hstep, voffB);
            PG8_WAIT_V(6); PG8_BAR; PG8_MMA(1, 1, At, B1); PG8_BAR;
            }
        }
        if constexpr (ALIGN_EPI) { if (wr == 0) PG8_BAR; }
        if constexpr (!Epi::AFTER_DRAIN) { E(acc, cur, wr, wc, fr, fq); S.done(cur); }
        if (!has_next) break;
#pragma unroll
        for (int a = 0; a < 2; ++a)
#pragma unroll
            for (int b = 0; b < 2; ++b)
#pragma unroll
                for (int m = 0; m < 4; ++m)
#pragma unroll
                    for (int n = 0; n < 2; ++n) acc[a][b][m][n] = (f32x4){0.f, 0.f, 0.f, 0.f};
        cur = nxt; cA = nA; cB = nB; ++ui;
        if constexpr (ALIGN_EPI) { if (wr == 1) PG8_BAR; }
    }
    PG8_WAIT_V(0);
    if constexpr (!ALIGN_EPI) { if (wr == 0) PG8_BAR; }
    PG8_BAR;
    if constexpr (Epi::AFTER_DRAIN) { E.fused(acc, cur, wr, wc, fr, fq, lds, wid, lane); S.done(cur); }
#undef PG8_SA
#undef PG8_SB
#undef PG8_STAGE
#undef PG8_LDA
#undef PG8_LDB
#undef PG8_CAT
#undef PG8_MMA
#undef PG8_WAIT_V
#undef PG8_WAIT_L
#undef PG8_BAR
#undef PG8_SCHED
}

typedef int i32x4_t __attribute__((ext_vector_type(4)));
typedef int i32x8_t __attribute__((ext_vector_type(8)));
template <class Epi, class Sched, bool GATHER, bool FP8, int SCALE_B = 127>
__device__ __forceinline__ void gemm_phase2(PG8_LAS unsigned char* lds, const void* Aptr, const void* Btptr, int pitchA, int pitchB, int nt, const Sched& S, const Epi& E, const PG8_LAS unsigned* idxtab, PG8_LAS unsigned char* ebuf) {
    const int tid = threadIdx.x, wid = __builtin_amdgcn_readfirstlane(tid >> 6), lane = tid & 63, wr = wid >> 2, wc = wid & 3, fr = lane & 15, fq = lane >> 4;
    unsigned voffB[2], cA2[2]; int RA[2];
#pragma unroll
    for (int i = 0; i < 2; ++i) { int R, C; stage_rc(tid * 16 + i * 8192, R, C); const int Rb = Epi::PERM ? ((R & ~31) + perm32(R & 31)) : R;
        voffB[i] = (unsigned)(Rb * pitchB + C * 2); RA[i] = R; cA2[i] = (unsigned)(C * 2); }
    const size_t kstep = 128;
    const size_t hstepB = (size_t)HALF * pitchB, tstepB = 2 * hstepB, tstepA = (size_t)BM * pitchA;
    const unsigned ldsw = (unsigned)wid * 1024u;
    const int aoff = lds_byte(wr * 64 + fr, fq * 8), boff = lds_byte(wc * 32 + fr, fq * 8);
#define PG8_SA(b, h) (((b) * 2 + (h)) * HTB)
#define PG8_SB(b, h) ((4 + (b) * 2 + (h)) * HTB)
#define PG8_STAGE(bufoff, gbase, voff) do { _Pragma("unroll") for (int _i = 0; _i < 2; ++_i) \
        __builtin_amdgcn_global_load_lds((const unsigned*)((const char*)(gbase) + (voff)[_i]), (PG8_LAS unsigned*)(lds + (bufoff) + ldsw + _i * 8192), 16, 0, 0); } while (0)
#define PG8_LDA(dst, b, h) do { _Pragma("unroll") for (int m = 0; m < 4; ++m) _Pragma("unroll") for (int k = 0; k < 2; ++k) dst[m][k] = *(const PG8_LAS bf16x8*)(lds + PG8_SA(b, h) + aoff + m * 2048 + k * 1024); } while (0)
#define PG8_LDB(dst, b, h) do { _Pragma("unroll") for (int n = 0; n < 2; ++n) _Pragma("unroll") for (int k = 0; k < 2; ++k) dst[n][k] = *(const PG8_LAS bf16x8*)(lds + PG8_SB(b, h) + boff + n * 2048 + k * 1024); } while (0)
#define PG8_CAT(x0, x1) __builtin_shufflevector(__builtin_bit_cast(i32x4_t, x0), __builtin_bit_cast(i32x4_t, x1), 0, 1, 2, 3, 4, 5, 6, 7)
#define PG8_MMA(ai, bj, At, Bt) do { __builtin_amdgcn_s_setprio(1); \
        if constexpr (FP8) { _Pragma("unroll") for (int m = 0; m < 4; ++m) _Pragma("unroll") for (int n = 0; n < 2; ++n) \
            asm volatile("s_nop 1\n\tv_mfma_f32_16x16x128_f8f6f4 %0, %1, %2, %0" : "+v"(acc[ai][bj][m][n]) : "v"(PG8_CAT(Bt[n][0], Bt[n][1])), "v"(PG8_CAT(At[m][0], At[m][1]))); } \
        else { _Pragma("unroll") for (int m = 0; m < 4; ++m) _Pragma("unroll") for (int n = 0; n < 2; ++n) _Pragma("unroll") for (int k = 0; k < 2; ++k) \
            acc[ai][bj][m][n] = __builtin_amdgcn_mfma_f32_16x16x32_bf16(Bt[n][k], At[m][k], acc[ai][bj][m][n], 0, 0, 0); } \
        __builtin_amdgcn_s_setprio(0); } while (0)
#define PG8_WAIT_V(n) asm volatile("s_waitcnt vmcnt(" #n ")" ::: "memory")
#define PG8_WAIT_L(n) asm volatile("s_waitcnt lgkmcnt(" #n ")" ::: "memory")
#define PG8_BAR __builtin_amdgcn_s_barrier()
#define PG8_SCHED __builtin_amdgcn_sched_barrier(0)
    Unit cur, nxt; int ui = 0;
    if (!S.next(0, cur)) return;
    f32x4 acc[2][2][4][2];
#pragma unroll
    for (int a = 0; a < 2; ++a)
#pragma unroll
        for (int b = 0; b < 2; ++b)
#pragma unroll
            for (int m = 0; m < 4; ++m)
#pragma unroll
                for (int n = 0; n < 2; ++n) acc[a][b][m][n] = (f32x4){0.f, 0.f, 0.f, 0.f};
    bf16x8 At[4][2], B0[2][2], B1[2][2];
    unsigned va[2][2], vn[2][2];
#pragma unroll
    for (int h = 0; h < 2; ++h)
#pragma unroll
        for (int i = 0; i < 2; ++i) { va[h][i] = GATHER ? idxtab[h * HALF + RA[i]] + cA2[i] : (unsigned)((RA[i] + h * HALF) * pitchA) + cA2[i]; vn[h][i] = va[h][i]; }
    const char* cA = (const char*)Aptr + (GATHER ? (size_t)0 : (size_t)cur.pm * tstepA); const char* cB = (const char*)Btptr + (size_t)cur.pn * tstepB;
    S.a_ready(cur);
    E.prefetch(cur, ebuf, wid, lane);
    PG8_STAGE(PG8_SB(0, 0), cB, voffB); PG8_STAGE(PG8_SB(0, 1), cB + hstepB, voffB); PG8_STAGE(PG8_SA(0, 0), cA, va[0]); PG8_STAGE(PG8_SA(0, 1), cA, va[1]);
    if (wr == 1) PG8_BAR;
    PG8_WAIT_V(2); PG8_BAR;
    PG8_STAGE(PG8_SB(1, 0), cB + kstep, voffB); PG8_STAGE(PG8_SA(1, 0), cA + kstep, va[0]); PG8_STAGE(PG8_SB(1, 1), cB + hstepB + kstep, voffB);
    PG8_WAIT_V(6); PG8_BAR;
    for (;;) {
        const bool has_next = S.next(ui + 1, nxt);
        const char* nA = (GATHER || !has_next) ? cA : (const char*)Aptr + (size_t)nxt.pm * tstepA; const char* nB = has_next ? (const char*)Btptr + (size_t)nxt.pn * tstepB : cB;
        if (GATHER && has_next) {
#pragma unroll
            for (int h = 0; h < 2; ++h)
#pragma unroll
                for (int i = 0; i < 2; ++i) vn[h][i] = idxtab[(ui + 1) * BM + h * HALF + RA[i]] + cA2[i];
        }
#pragma unroll 1
        for (int t = 0; t < nt; t += 2) {
            const bool last = (t == nt - 2);
            const char* a1 = cA + (size_t)(t + 1) * kstep;
            const char* a2 = last ? nA : cA + (size_t)(t + 2) * kstep; const char* b2 = last ? nB : cB + (size_t)(t + 2) * kstep;
            const char* a3 = a2 + kstep; const char* b3 = b2 + kstep;
            unsigned s2[2][2];
#pragma unroll
            for (int h = 0; h < 2; ++h)
#pragma unroll
                for (int i = 0; i < 2; ++i) s2[h][i] = (GATHER && last) ? vn[h][i] : va[h][i];
            if (last && has_next) S.a_ready(nxt);
            PG8_LDB(B0, 0, 0); PG8_LDB(B1, 0, 1); PG8_SCHED; PG8_LDA(At, 0, 0); PG8_STAGE(PG8_SA(1, 1), a1, va[1]);
            PG8_WAIT_V(8); PG8_WAIT_L(0); PG8_BAR; PG8_MMA(0, 0, At, B0); PG8_MMA(0, 1, At, B1); PG8_BAR; PG8_SCHED;
            PG8_LDA(At, 0, 1); PG8_STAGE(PG8_SB(0, 0), b2, voffB); PG8_STAGE(PG8_SB(0, 1), b2 + hstepB, voffB); PG8_STAGE(PG8_SA(0, 0), a2, s2[0]);
            PG8_WAIT_V(8); PG8_WAIT_L(0); PG8_BAR; PG8_MMA(1, 0, At, B0); PG8_MMA(1, 1, At, B1); PG8_BAR; PG8_SCHED;
            PG8_LDB(B0, 1, 0); PG8_LDB(B1, 1, 1); PG8_SCHED; PG8_LDA(At, 1, 0); PG8_STAGE(PG8_SA(0, 1), a2, s2[1]);
            PG8_WAIT_V(8); PG8_WAIT_L(0); PG8_BAR; PG8_MMA(0, 0, At, B0); PG8_MMA(0, 1, At, B1); PG8_BAR; PG8_SCHED;
            PG8_LDA(At, 1, 1); PG8_STAGE(PG8_SB(1, 0), b3, voffB); PG8_STAGE(PG8_SB(1, 1), b3 + hstepB, voffB); PG8_STAGE(PG8_SA(1, 0), a3, s2[0]);
            PG8_WAIT_V(8); PG8_WAIT_L(0); PG8_BAR; PG8_MMA(1, 0, At, B0); PG8_MMA(1, 1, At, B1); PG8_BAR; PG8_SCHED;
        }
        if (wr == 0) PG8_BAR;
        if constexpr (FP8) { asm volatile("s_nop 15\n\ts_nop 7" ::: "memory"); PG8_SCHED; }
        if (has_next) E.prefetch(nxt, ebuf + ((ui + 1) & 1) * 2048, wid, lane);
        E(acc, cur, wr, wc, fr, fq, ebuf + (ui & 1) * 2048); S.done(cur);
        if (!has_next) break;
#pragma unroll
        for (int a = 0; a < 2; ++a)
#pragma unroll
            for (int b = 0; b < 2; ++b)
#pragma unroll
                for (int m = 0; m < 4; ++m)
#pragma unroll
                    for (int n = 0; n < 2; ++n) acc[a][b][m][n] = (f32x4){0.f, 0.f, 0.f, 0.f};
        cur = nxt; cA = nA; cB = nB; ++ui;
#pragma unroll
        for (int h = 0; h < 2; ++h)
#pragma unroll
            for (int i = 0; i < 2; ++i) va[h][i] = vn[h][i];
        if (wr == 1) PG8_BAR;
    }
    PG8_WAIT_V(0);
    PG8_BAR;
#undef PG8_SA
#undef PG8_SB
#undef PG8_STAGE
#undef PG8_LDA
#undef PG8_LDB
#undef PG8_CAT
#undef PG8_MMA
#undef PG8_WAIT_V
#undef PG8_WAIT_L
#undef PG8_BAR
#undef PG8_SCHED
}
}
#define GAS __attribute__((address_space(1)))
#define LAS __attribute__((address_space(3)))
typedef unsigned short bf16;
typedef unsigned v4u __attribute__((ext_vector_type(4)));
typedef float f32x4 __attribute__((ext_vector_type(4)));
typedef short bf16x8 __attribute__((ext_vector_type(8)));
typedef GAS unsigned gu32;
typedef GAS unsigned long long gu64;
#define RLX_AGENT __ATOMIC_RELAXED, __HIP_MEMORY_SCOPE_AGENT
#define LDS_WAIT() asm volatile("s_waitcnt lgkmcnt(0)" ::: "memory")
#define VM_WAIT() asm volatile("s_waitcnt vmcnt(0)" ::: "memory")
__device__ __forceinline__ unsigned long long rt() { return __builtin_amdgcn_s_memrealtime(); }
__device__ __forceinline__ unsigned f2bf(float f) { unsigned u = __builtin_bit_cast(unsigned, f); return (u + 0x7fffu + ((u >> 16) & 1u)) >> 16; }
__device__ __forceinline__ unsigned pk2(float lo, float hi) { return f2bf(lo) | (f2bf(hi) << 16); }

#define XB_TMO      128
#define XB_XCNT(j)  (256  + 64 * (j))
#define XB_XSUB(j)  (1280 + 64 * (j))
#define XB_XGEN(j)  (2304 + 64 * (j))
#define XB_TOP      3328
#define XB_TOPGEN   3392
#define XCD_BAR_WORDS 3456
#define XB_SPIN_CAP (1u << 18)

__device__ __forceinline__ unsigned xb_ld(unsigned* p)              { return __hip_atomic_load(p, __ATOMIC_RELAXED, __HIP_MEMORY_SCOPE_AGENT); }
__device__ __forceinline__ unsigned xb_add(unsigned* p, unsigned v) { return __hip_atomic_fetch_add(p, v, __ATOMIC_RELAXED, __HIP_MEMORY_SCOPE_AGENT); }
__device__ __forceinline__ unsigned xb_xcc_id() { return (unsigned)__builtin_amdgcn_s_getreg((3 << 11) | 20) & 0xFu; }
#define XB_SPIN(cond, bar) do { unsigned _sp = 0; while (cond) { __builtin_amdgcn_s_sleep(1); \
    if ((++_sp & 255u) == 0u) { if (xb_ld(&(bar)[XB_TMO])) break; if (_sp > XB_SPIN_CAP) { atomicAdd(&(bar)[XB_TMO], 1u); break; } } } } while (0)

struct XcdBarrier {
    unsigned* bar; unsigned x;
    volatile LAS unsigned* st;
};

__device__ __forceinline__ XcdBarrier xcd_barrier_post(unsigned* bar, volatile LAS unsigned* st) {
    XcdBarrier b; b.bar = bar; b.x = xb_xcc_id(); b.st = st;
    if (threadIdx.x == 0) (void)xb_add(&bar[XB_XCNT(b.x)], 1u);
    return b;
}
__device__ __forceinline__ void xcd_barrier_complete(unsigned* bar, unsigned x, unsigned& nloc, unsigned& nx) {
    const unsigned G = gridDim.x * gridDim.y * gridDim.z;
    unsigned sum, cnt, mine, sp = 0u;
    for (;;) {
        sum = 0u; cnt = 0u; mine = 0u;
#pragma unroll
        for (unsigned j = 0; j < 16; ++j) { const unsigned c = xb_ld(&bar[XB_XCNT(j)]); sum += c; cnt += (c > 0u) ? 1u : 0u; mine = (j == x) ? c : mine; }
        if (sum == G) break;
        __builtin_amdgcn_s_sleep(1);
        if ((++sp & 255u) == 0u) { if (xb_ld(&bar[XB_TMO])) break; if (sp > XB_SPIN_CAP) { atomicAdd(&bar[XB_TMO], 1u); break; } }
    }
    nloc = mine > 0u ? mine : 1u; nx = cnt > 0u ? cnt : 1u;
}

__device__ __forceinline__ void xcd_barrier(const XcdBarrier& b) {
    asm volatile("s_waitcnt vmcnt(0)" ::: "memory");
    __syncthreads();
    if (threadIdx.x == 0) {
        unsigned* bar = b.bar;
        __builtin_amdgcn_s_waitcnt(0);
        unsigned nloc = b.st[0], nx = b.st[1];
        if (nloc == 0u) { xcd_barrier_complete(bar, b.x, nloc, nx); b.st[0] = nloc; b.st[1] = nx; }
        const unsigned old = xb_add(&bar[XB_XSUB(b.x)], 1u);
        const unsigned gen = old / nloc;
        if (old + 1u == (gen + 1u) * nloc) {
            __builtin_amdgcn_fence(__ATOMIC_RELEASE, "agent");
            asm volatile("s_waitcnt vmcnt(0)" ::: "memory");
            const unsigned og = xb_add(&bar[XB_TOP], 1u);
            const unsigned tg = og / nx;
            if (og + 1u == (tg + 1u) * nx) xb_add(&bar[XB_TOPGEN], 1u);
            else XB_SPIN(xb_ld(&bar[XB_TOPGEN]) == tg, bar);
            __builtin_amdgcn_fence(__ATOMIC_ACQUIRE, "agent");
            xb_add(&bar[XB_XGEN(b.x)], 1u);
            asm volatile("s_waitcnt vmcnt(0)" ::: "memory");
        } else {
            XB_SPIN(xb_ld(&bar[XB_XGEN(b.x)]) == gen, bar);
            __builtin_amdgcn_fence(__ATOMIC_ACQUIRE, "agent");
            asm volatile("s_waitcnt vmcnt(0)" ::: "memory");
        }
    }
    __syncthreads();
}

constexpr size_t MiB = 1u << 20;
constexpr size_t WS_CTL = 0, CTL_ZERO_BYTES = 1 * MiB;
constexpr size_t WS_ROPE = 1 * MiB;
constexpr size_t WS_WRH = 3 * MiB;
constexpr size_t WS_BDN32 = 3 * MiB + 256 * 1024;
constexpr size_t WS_ONES = 3 * MiB + 512 * 1024;
constexpr size_t WS_GINV = 3 * MiB + 640 * 1024;
constexpr size_t WS_RINV = 3 * MiB + 768 * 1024;
constexpr size_t WS_TOPI = 4 * MiB;
constexpr size_t WS_GATE = WS_TOPI + 512 * 1024;
constexpr size_t WS_OFF = WS_GATE + 512 * 1024;
constexpr size_t WS_WIN = 8 * MiB;
constexpr size_t WS_WOUT = 14 * MiB;
constexpr size_t WS_WGU = 16 * MiB;
constexpr size_t WS_WDN = 144 * MiB;
constexpr size_t WS_XN = 208 * MiB;
constexpr size_t WS_QKV = 272 * MiB;
constexpr size_t WS_OP = 464 * MiB;
constexpr size_t WS_LSE = 560 * MiB;
constexpr size_t WS_XB = 272 * MiB;
constexpr size_t WS_ACT = 564 * MiB;
constexpr size_t WS_H16 = 836 * MiB;
constexpr size_t WS_H8 = 908 * MiB;
constexpr size_t WS_ROWTOK = 900 * MiB;
constexpr size_t WS_RSCALE = 904 * MiB;
constexpr size_t WS_MIX = 940 * MiB;
constexpr size_t WS_END = 1004 * MiB;
static_assert(WS_OFF + 512 * 1024 <= WS_WIN && WS_XB + (size_t)PMAX * 2048 <= WS_LSE + 3 * MiB && WS_LSE + 3 * MiB <= WS_ACT && WS_ACT + (size_t)PMAX * 2048 <= WS_H16, "ws map");
constexpr size_t QKV_STRIDE = (size_t)T * 512;
constexpr int CW_FILL = 64;
constexpr int CW_BAR = 4096;

constexpr int RING_OFF = 0, RING_BYTES = 131072;
constexpr int MISC_OFF = RING_BYTES;
constexpr int LDS_TSTART = MISC_OFF + 256;
constexpr int LDS_TEXP = MISC_OFF + 512;
constexpr int LDS_TCNT = MISC_OFF + 128;
constexpr int LDS_WSC = MISC_OFF + 4096;
constexpr int LDS_IDX = MISC_OFF + 8192;
constexpr int LDS_BYTES = 163840;

typedef float f32x16 __attribute__((ext_vector_type(16)));
typedef short s16x4 __attribute__((ext_vector_type(4)));
typedef unsigned u32x2 __attribute__((ext_vector_type(2)));
__device__ __forceinline__ float bflo(unsigned w) { return __builtin_bit_cast(float, w << 16); }
__device__ __forceinline__ float bfhi(unsigned w) { return __builtin_bit_cast(float, w & 0xffff0000u); }
__device__ __forceinline__ float wave_sum(float v) {
#pragma unroll
    for (int o = 1; o < 64; o <<= 1) v += __shfl_xor(v, o);
    return v;
}

struct Frame {
    LAS unsigned char* lds;
    int tid, lane, wave, vcu, G;
    const float *x, *g1, *w_in, *attn_g, *conv_w, *conv_g, *w_out, *g2, *w_r, *b_r, *w_gu, *b_gu, *w_dn, *b_dn, *gf;
    float* out; unsigned char* ws; gu32* ctl;
};

__device__ __forceinline__ void p0_transpose_item(const float* W, int K, int N, bf16* WT, int k0, int n0, int drow0, LAS float* scr, int lane, const float* kscale) {
#pragma unroll 8
    for (int i = 0; i < 32; ++i) { const int kk = 2 * i + (lane >> 5); scr[kk * 33 + (lane & 31)] = W[(size_t)(k0 + kk) * N + n0 + (lane & 31)]; }
    const int c = lane & 7;
    f32x4 s0 = {1.f, 1.f, 1.f, 1.f}, s1 = {1.f, 1.f, 1.f, 1.f};
    if (kscale) { s0 = *(const f32x4*)(kscale + k0 + 8 * c); s1 = *(const f32x4*)(kscale + k0 + 8 * c + 4); }
    LDS_WAIT(); asm volatile("" ::: "memory");
#pragma unroll
    for (int j = 0; j < 4; ++j) { const int n = (lane >> 3) + 8 * j; const LAS float* s = scr + (8 * c) * 33 + n;
        v4u o; o.x = pk2(s[0 * 33] * s0.x, s[1 * 33] * s0.y); o.y = pk2(s[2 * 33] * s0.z, s[3 * 33] * s0.w); o.z = pk2(s[4 * 33] * s1.x, s[5 * 33] * s1.y); o.w = pk2(s[6 * 33] * s1.z, s[7 * 33] * s1.w);
        *(v4u*)(WT + (size_t)(drow0 + n) * K + k0 + 8 * c) = o; }
    LDS_WAIT(); asm volatile("" ::: "memory");
}
struct Item8 { const float* W; unsigned char* WT; const float* ks; int N, k0, n0, drow; };
__device__ __forceinline__ void item8_load(const Item8& d, int lane, f32x4 (&v)[8], f32x4 (&s)[2]) {
    const int kq = lane >> 3, n4 = lane & 7;
#pragma unroll
    for (int ci = 0; ci < 2; ++ci) {
#pragma unroll
        for (int r = 0; r < 4; ++r) v[4 * ci + r] = __builtin_nontemporal_load((const f32x4*)(d.W + (size_t)(d.k0 + 4 * (kq + 8 * ci) + r) * d.N + d.n0 + 4 * n4));
        s[ci] = *(const f32x4*)(d.ks + d.k0 + 4 * (kq + 8 * ci));
    }
}
__device__ __forceinline__ void item8_store(const Item8& d, LAS float* scr, int lane, const f32x4 (&v)[8], const f32x4 (&s)[2], float wscale) {
    const int kq = lane >> 3, n4 = lane & 7;
    LAS unsigned char* tile = (LAS unsigned char*)scr;
#pragma unroll
    for (int ci = 0; ci < 2; ++ci) { const f32x4 sc = s[ci] * wscale;
#pragma unroll
        for (int e = 0; e < 4; ++e)
            *(LAS unsigned*)(tile + (4 * n4 + e) * 72 + 4 * (kq + 8 * ci)) = pg8::pk4_fp8(v[4 * ci + 0][e] * sc.x, v[4 * ci + 1][e] * sc.y, v[4 * ci + 2][e] * sc.z, v[4 * ci + 3][e] * sc.w); }
    LDS_WAIT(); asm volatile("" ::: "memory");
    const int c = lane & 3;
#pragma unroll
    for (int j = 0; j < 2; ++j) { const int n = (lane >> 2) + 16 * j; const LAS unsigned char* p = tile + n * 72 + 16 * c;
        const pg8::u32x2_t lo = *(const LAS pg8::u32x2_t*)p, hi = *(const LAS pg8::u32x2_t*)(p + 8);
        v4u o; o.x = lo.x; o.y = lo.y; o.z = hi.x; o.w = hi.y;
        *(v4u*)(d.WT + (size_t)(d.drow + n) * 1024 + d.k0 + 16 * c) = o; }
    LDS_WAIT(); asm volatile("" ::: "memory");
}
__device__ const double INV_FREQ_REV[32] = {
    1.0 / 6.283185307179586, 0.7498942093324559 / 6.283185307179586, 0.5623413251903491 / 6.283185307179586, 0.4216965034285822 / 6.283185307179586,
    0.31622776601683794 / 6.283185307179586, 0.23713737056616552 / 6.283185307179586, 0.1778279410038923 / 6.283185307179586, 0.1333521432163324 / 6.283185307179586,
    0.1 / 6.283185307179586, 0.07498942093324558 / 6.283185307179586, 0.05623413251903491 / 6.283185307179586, 0.042169650342858224 / 6.283185307179586,
    0.03162277660168379 / 6.283185307179586, 0.023713737056616554 / 6.283185307179586, 0.01778279410038923 / 6.283185307179586, 0.01333521432163324 / 6.283185307179586,
    0.01 / 6.283185307179586, 0.007498942093324558 / 6.283185307179586, 0.005623413251903491 / 6.283185307179586, 0.004216965034285823 / 6.283185307179586,
    0.0031622776601683794 / 6.283185307179586, 0.0023713737056616554 / 6.283185307179586, 0.0017782794100389228 / 6.283185307179586, 0.001333521432163324 / 6.283185307179586,
    0.001 / 6.283185307179586, 0.0007498942093324559 / 6.283185307179586, 0.0005623413251903491 / 6.283185307179586, 0.00042169650342858224 / 6.283185307179586,
    0.00031622776601683794 / 6.283185307179586, 0.00023713737056616554 / 6.283185307179586, 0.00017782794100389227 / 6.283185307179586, 0.0001333521432163324 / 6.283185307179586};

__device__ __forceinline__ void p0_prologue(Frame& F) {
    LAS float* scr = (LAS float*)(F.lds + RING_OFF + F.wave * 16384);
    const int gw = F.vcu * 8 + F.wave, NGW = F.G * 8;
    bf16* win_t = (bf16*)(F.ws + WS_WIN); bf16* wout_t = (bf16*)(F.ws + WS_WOUT);
    constexpr int I_IN = 16 * 96, I_OUT = 16 * 32, I_GU = 16 * 64, I_DN = 16 * 32;
    constexpr int NITEMS = I_IN;
    for (int it = gw; it < NITEMS; it += NGW) {
        int r = it;
        if (r < I_IN) { const int kb = r / 96, nb = r % 96, n0 = 32 * nb; int drow = n0;
            if (n0 < 1024) { const int pn = n0 >> 8, w = n0 & 255, hh = w >> 6, bj = (w >> 5) & 1; drow = 256 * pn + 128 * bj + 32 * hh; }
            else if (n0 >= 1536 && n0 < 2048) { const int c = n0 - 1536, j = c >> 7; drow = 256 * (j < 2 ? 6 + j : 8 + j) + (c & 127); }
            else if (n0 >= 2560) { const int c = n0 - 2560, j = c >> 7; drow = 256 * (j < 2 ? 6 + j : 8 + j) + 128 + (c & 127); }
            p0_transpose_item(F.w_in, 1024, NPROJ, win_t, 64 * kb, n0, drow, scr, F.lane, nullptr); continue; }
        r -= I_IN;
        { const int kb = r / 32, nb = r % 32; p0_transpose_item(F.w_out, 1024, 1024, wout_t, 64 * kb, 32 * nb, 32 * nb, scr, F.lane, nullptr); }
    }
    { const int gt = F.vcu * 512 + F.tid, NGT = F.G * 512;
      float* rope = (float*)(F.ws + WS_ROPE);
      for (int i = gt; i < SEQ * 32; i += NGT) { const int pos = i >> 5, fi = i & 31; const double rev = (double)pos * INV_FREQ_REV[fi]; const float fr = (float)(rev - __builtin_rint(rev));
          rope[2 * i] = __builtin_amdgcn_cosf(fr); rope[2 * i + 1] = __builtin_amdgcn_sinf(fr); }
      float* ginv = (float*)(F.ws + WS_GINV);
      for (int i = gt; i < 1024; i += NGT) ginv[i] = 1.0f / F.g1[i];
      float* ones = (float*)(F.ws + WS_ONES);
      for (int i = gt; i < 1024; i += NGT) ones[i] = 1.0f;
      float* bdn32 = (float*)(F.ws + WS_BDN32);
      for (int i = gt; i < NE * 1024; i += NGT) bdn32[i] = 32.0f * F.b_dn[i];
      bf16* wrh = (bf16*)(F.ws + WS_WRH);
      for (int i = gt; i < NE * 1024; i += NGT) { const int e = i >> 10, k = i & 1023; const float v = F.g2[k] * F.w_r[k * NE + e]; const unsigned hi = f2bf(v); const float rem = v - __builtin_bit_cast(float, hi << 16);
          wrh[i] = (bf16)hi; wrh[NE * 1024 + i] = (bf16)f2bf(rem); }
    }
    bf16* XN = (bf16*)(F.ws + WS_XN);
    f32x4 gv[4];
#pragma unroll
    for (int j = 0; j < 4; ++j) gv[j] = ((const f32x4*)F.g1)[F.lane + 64 * j];
    for (int m = gw; m < T; m += 2 * NGW) {
        const int m2 = m + NGW; const bool two = m2 < T;
        const f32x4* xr = (const f32x4*)(F.x + (size_t)m * DM) + F.lane; const f32x4* xr2 = (const f32x4*)(F.x + (size_t)(two ? m2 : m) * DM) + F.lane;
        f32x4 v[4], v2[4]; float s2 = 0.f, t2 = 0.f;
#pragma unroll
        for (int j = 0; j < 4; ++j) { v[j] = __builtin_nontemporal_load(xr + 64 * j); v2[j] = __builtin_nontemporal_load(xr2 + 64 * j); }
#pragma unroll
        for (int j = 0; j < 4; ++j) { s2 += (v[j].x * v[j].x + v[j].y * v[j].y) + (v[j].z * v[j].z + v[j].w * v[j].w); t2 += (v2[j].x * v2[j].x + v2[j].y * v2[j].y) + (v2[j].z * v2[j].z + v2[j].w * v2[j].w); }
#pragma unroll
        for (int o = 1; o < 64; o <<= 1) { s2 += __shfl_xor(s2, o); t2 += __shfl_xor(t2, o); }
        const float rstd = 1.0f / sqrtf(s2 * (1.f / DM) + NORM_EPS), rstd2 = 1.0f / sqrtf(t2 * (1.f / DM) + NORM_EPS);
        if (F.lane == 0) { float* rinv = (float*)(F.ws + WS_RINV); rinv[m] = sqrtf(s2 * (1.f / DM) + NORM_EPS); if (two) rinv[m2] = sqrtf(t2 * (1.f / DM) + NORM_EPS); }
        if (two) {
            const int odd = F.lane & 1; bf16* rowp = XN + (size_t)(odd ? m2 : m) * DM + 4 * (F.lane & ~1);
#pragma unroll
            for (int j = 0; j < 4; ++j) {
                const unsigned a0 = pg8::cvt_pk_bf16(v[j].x * rstd * gv[j].x, v[j].y * rstd * gv[j].y), a1 = pg8::cvt_pk_bf16(v[j].z * rstd * gv[j].z, v[j].w * rstd * gv[j].w);
                const unsigned b0 = pg8::cvt_pk_bf16(v2[j].x * rstd2 * gv[j].x, v2[j].y * rstd2 * gv[j].y), b1 = pg8::cvt_pk_bf16(v2[j].z * rstd2 * gv[j].z, v2[j].w * rstd2 * gv[j].w);
                const unsigned s0 = odd ? a0 : b0, s1 = odd ? a1 : b1;
                const unsigned n0 = (unsigned)__builtin_amdgcn_mov_dpp((int)s0, 0xB1, 0xF, 0xF, true), n1 = (unsigned)__builtin_amdgcn_mov_dpp((int)s1, 0xB1, 0xF, 0xF, true);
                v4u w; if (odd) { w.x = n0; w.y = n1; w.z = b0; w.w = b1; } else { w.x = a0; w.y = a1; w.z = n0; w.w = n1; }
                *(v4u*)(rowp + 256 * j) = w; }
        } else {
            u32x2* o8 = (u32x2*)(XN + (size_t)m * DM) + F.lane;
#pragma unroll
            for (int j = 0; j < 4; ++j) { u32x2 w; w.x = pg8::cvt_pk_bf16(v[j].x * rstd * gv[j].x, v[j].y * rstd * gv[j].y); w.y = pg8::cvt_pk_bf16(v[j].z * rstd * gv[j].z, v[j].w * rstd * gv[j].w); o8[64 * j] = w; }
        }
    }
}

__device__ __forceinline__ Item8 moe_item(const Frame& F, int r) {
    constexpr int I_GU = 16 * 64, I_DN = 16 * 32;
    Item8 d;
    if (r < NE * I_GU) { const int e = r / I_GU, q = r % I_GU, kb = q / 64, nb = q % 64, n0 = 32 * nb; const int up = n0 >> 10, f = n0 & 1023;
        d.W = F.w_gu + (size_t)e * 1024 * 2048; d.WT = F.ws + WS_WGU + (size_t)e * 2048 * 1024; d.ks = F.g2; d.N = 2048; d.k0 = 64 * kb; d.n0 = n0; d.drow = 256 * (f >> 7) + 128 * up + (f & 127); }
    else if (r >= NE * (I_GU + I_DN)) { const int q = r - NE * (I_GU + I_DN), kb = q / 32, nb = q % 32;
        d.W = F.w_out; d.WT = F.ws + WS_WOUT; d.ks = (const float*)(F.ws + WS_ONES); d.N = 1024; d.k0 = 64 * kb; d.n0 = 32 * nb; d.drow = 32 * nb; }
    else { const int r2 = r - NE * I_GU, e = r2 / I_DN, q = r2 % I_DN, kb = q / 32, nb = q % 32;
        d.W = F.w_dn + (size_t)e * 1024 * 1024; d.WT = F.ws + WS_WDN + (size_t)e * 1024 * 1024; d.ks = (const float*)(F.ws + WS_ONES); d.N = 1024; d.k0 = 64 * kb; d.n0 = 32 * nb; d.drow = 32 * nb; }
    return d;
}
__device__ __forceinline__ void p0_moe_slice(Frame& F) {
    const float wsc = 32.0f;
    LAS float* scr = (LAS float*)(F.lds + RING_OFF + F.wave * 16384);
    constexpr int NMOE = NE * (16 * 64 + 16 * 32) + 16 * 32;
    const int per = (NMOE + F.G - 1) / F.G, lo = F.vcu * per, hi = (lo + per < NMOE) ? lo + per : NMOE;
    const int r0 = lo + F.wave;
    if (r0 >= hi) return;
    const int cnt = (hi - r0 + 7) / 8, last = r0 + 8 * (cnt - 1), pairs = (cnt + 1) / 2;
    Item8 d0 = moe_item(F, r0), d1 = d0; f32x4 va[8], vb[8], sa[2], sb[2];
    item8_load(d0, F.lane, va, sa);
    for (int p = 0; p < pairs; ++p) {
        const int r1 = r0 + 16 * p + 8, r2 = r0 + 16 * p + 16;
        d1 = moe_item(F, r1 < last ? r1 : last); item8_load(d1, F.lane, vb, sb);
        item8_store(d0, scr, F.lane, va, sa, wsc);
        d0 = moe_item(F, r2 < last ? r2 : last); item8_load(d0, F.lane, va, sa);
        item8_store(d1, scr, F.lane, vb, sb, wsc);
    }
}

constexpr int ATT_NSEG = BATCH * NH * 48, ATT_VREG = 0, ATT_KREG = 65536;
__device__ __forceinline__ s16x4 tr_read(const LAS unsigned char* p) { typedef short v4i16_t __attribute__((ext_vector_type(4))); return __builtin_bit_cast(s16x4, __builtin_amdgcn_ds_read_tr16_b64_v4i16((LAS v4i16_t*)p)); }
__device__ __forceinline__ float max3f(float a, float b, float c) { float r; asm("v_max3_f32 %0, %1, %2, %3" : "=v"(r) : "v"(a), "v"(b), "v"(c)); return r; }
struct AttSeg { int p, dil, n0, key; unsigned base, tok0, h; };
__device__ __forceinline__ void att_decode(int s, AttSeg& d) {
    const int bh = s / 48, ws = s % 48, j = ws & 15, b = bh >> 3, h = bh & 7; int r;
    d.p = ws >> 4;
    if (d.p == 0) { d.dil = 1; r = 0; d.n0 = 4 * j; } else if (d.p == 1) { d.dil = 4; r = j >> 2; d.n0 = 4 * (j & 3); } else { d.dil = 16; r = j; d.n0 = 0; }
    d.key = s - (d.n0 >> 2); d.tok0 = (unsigned)(b * SEQ + r); d.h = (unsigned)h; d.base = (d.tok0 * 512u + (unsigned)h * 64u) * 2u;
}

__device__ __forceinline__ void p2_attention(Frame& F) {
    const int lane = F.lane, w = __builtin_amdgcn_readfirstlane(F.wave), li = lane & 15, g = lane >> 4;
    LAS unsigned char* ring = F.lds + RING_OFF;
    const char* Qc = (const char*)(F.ws + WS_QKV); const char* Kc = Qc + QKV_STRIDE * 2; const char* Vc = Kc + QKV_STRIDE * 2;
    char* OPc = (char*)(F.ws + WS_OP); char* LSEc = (char*)(F.ws + WS_LSE);
    const int per = (ATT_NSEG + F.G - 1) / F.G;
    const int s_lo = F.vcu * per, s_hi = (s_lo + per < ATT_NSEG) ? s_lo + per : ATT_NSEG;
    if (s_lo >= s_hi) return;
    const bool xl = (F.G % 8 == 0) && (ATT_NSEG % F.G == 0);
    const int cpx = F.G / 8, xq = xl ? F.vcu / cpx : 0, xr = xl ? F.vcu % cpx : 0;
#define ATT_SEG(i_) (xl ? (xq * per * cpx + ((i_) - s_lo) * cpx + xr) : (i_))
    const int fk = li >> 1;
    const unsigned ringa = (unsigned)(unsigned long)ring;
    const unsigned ka0 = ringa + ATT_KREG + w * 2048 + li * 128 + ((g ^ fk) << 4), ka1 = ringa + ATT_KREG + w * 2048 + li * 128 + (((g + 4) ^ fk) << 4);
    const int vq = li >> 2, vp = li & 3;
    const int fv = (((2 * g + (li >> 3)) & 3) << 1);
    unsigned va[4];
#pragma unroll
    for (int d0 = 0; d0 < 4; ++d0) va[d0] = (unsigned)(unsigned long)ring + ATT_VREG + w * 2048 + (4 * g + vq) * 128 + 8 * (vp & 1) + (((2 * d0 + (vp >> 1)) ^ fv) << 4);
    unsigned drow[2], dck[2], dcv[2];
#pragma unroll
    for (int j = 0; j < 2; ++j) { const int row = 16 * w + 8 * j + (lane >> 3), ps = lane & 7; drow[j] = (unsigned)row; dck[j] = (unsigned)((ps ^ ((row >> 1) & 7)) << 4); dcv[j] = (unsigned)((ps ^ (((row >> 1) & 3) << 1)) << 4); }
    const unsigned qrow = (unsigned)(16 * w + li);
#define ATT_DMA(sd_, blk_, slot_) do { const unsigned bo_ = (sd_).base + (unsigned)(blk_) * ((unsigned)(sd_).dil << 17); const char* kg_ = Kc + bo_; const char* vg_ = Vc + bo_; \
        _Pragma("unroll") for (int j_ = 0; j_ < 2; ++j_) { const unsigned ro_ = drow[j_] * ((unsigned)(sd_).dil << 10); \
            __builtin_amdgcn_global_load_lds((const unsigned*)(kg_ + (ro_ + dck[j_])), (LAS unsigned*)(ring + ATT_KREG + (slot_) * 16384 + w * 2048 + j_ * 1024), 16, 0, 0); \
            __builtin_amdgcn_global_load_lds((const unsigned*)(vg_ + (ro_ + dcv[j_])), (LAS unsigned*)(ring + ATT_VREG + (slot_) * 16384 + w * 2048 + j_ * 1024), 16, 0, 0); } } while (0)
#define ATT_QLD(sd_, blk_, dst_) do { const char* qg_ = Qc + ((sd_).base + (unsigned)(blk_) * ((unsigned)(sd_).dil << 17)); const unsigned qo_ = qrow * ((unsigned)(sd_).dil << 10) + 16 * g; \
        dst_[0] = *(const bf16x8*)(qg_ + qo_); dst_[1] = *(const bf16x8*)(qg_ + qo_ + 64); } while (0)
#define ATT_SCV(k_) sc[(k_) >> 2][(k_) & 3]
#define ATT_WAITV(imm_) do { asm volatile("" ::: "memory"); __builtin_amdgcn_s_waitcnt(imm_); asm volatile("" ::: "memory"); } while (0)
#define ATT_BAR asm volatile("s_barrier" ::: "memory")
    AttSeg cur, nxt; att_decode(ATT_SEG(s_lo), cur);
    bf16x8 q[4][2]; v4u kr[2], vr[2];
    { const int nb0 = cur.n0 > 0 ? cur.n0 - 1 : 0; ATT_DMA(cur, nb0, 0); ATT_DMA(cur, cur.n0, 1); ATT_DMA(cur, cur.n0 + 1, 2); ATT_QLD(cur, cur.n0, q[0]); ATT_QLD(cur, cur.n0 + 1, q[1]); }
    ATT_WAITV(0x0F70); ATT_BAR;
    for (int s = s_lo; s < s_hi; ++s) {
        const int sn = (s + 1 < s_hi) ? s + 1 : s; att_decode(ATT_SEG(sn), nxt);
#pragma unroll
        for (int i = 0; i < 4; ++i) {
            if (i == 0) { ATT_DMA(cur, cur.n0 + 2, 3); ATT_QLD(cur, cur.n0 + 2, q[2]); }
            else if (i == 1) { ATT_DMA(cur, cur.n0 + 3, 0); ATT_QLD(cur, cur.n0 + 3, q[3]); }
            else if (i == 2) { ATT_DMA(nxt, nxt.n0, 1); ATT_QLD(nxt, nxt.n0, q[0]);
                const unsigned bo = nxt.base + (unsigned)(nxt.n0 > 0 ? nxt.n0 - 1 : 0) * ((unsigned)nxt.dil << 17);
#pragma unroll
                for (int j = 0; j < 2; ++j) { const unsigned ro = drow[j] * ((unsigned)nxt.dil << 10); kr[j] = *(const v4u*)(Kc + bo + (ro + dck[j])); vr[j] = *(const v4u*)(Vc + bo + (ro + dcv[j])); } }
            else { ATT_DMA(nxt, nxt.n0 + 1, 2); ATT_QLD(nxt, nxt.n0 + 1, q[1]); }
#define ATT_TOFF(kt_) ((i < 3) ? (8 * i + (kt_)) * 2048 : (((kt_) == 8 || w + (kt_) >= 8) ? ((kt_) - 8) * 2048 : (24 + (kt_)) * 2048))
            const bf16x8 qf0 = q[i][0], qf1 = q[i][1];
            f32x4 sc[9];
            v4u kf[6][2];
#define ATT_KRD(kt_) do { if (i < 3) { asm volatile("ds_read_b128 %0, %1 offset:%2" : "=v"(kf[(kt_) % 6][0]) : "v"(ka0), "i"((8 * i + (kt_)) * 2048) : "memory"); \
            asm volatile("ds_read_b128 %0, %1 offset:%2" : "=v"(kf[(kt_) % 6][1]) : "v"(ka1), "i"((8 * i + (kt_)) * 2048) : "memory"); } \
        else { const unsigned a0_ = ka0 + ATT_TOFF(kt_), a1_ = ka1 + ATT_TOFF(kt_); asm volatile("ds_read_b128 %0, %1" : "=v"(kf[(kt_) % 6][0]) : "v"(a0_) : "memory"); asm volatile("ds_read_b128 %0, %1" : "=v"(kf[(kt_) % 6][1]) : "v"(a1_) : "memory"); } } while (0)
#define ATT_KWAIT(n_, s_) asm volatile("s_waitcnt lgkmcnt(" #n_ ")" : "+v"(kf[s_][0]), "+v"(kf[s_][1]) :: "memory")
            ATT_KRD(0); ATT_KRD(1); ATT_KRD(2); ATT_KRD(3); ATT_KRD(4);
#pragma unroll
            for (int kt = 0; kt < 9; ++kt) {
                if (kt + 5 < 9) ATT_KRD(kt + 5);
                if (kt < 4) { if (kt % 6 == 0) ATT_KWAIT(10, 0); else if (kt % 6 == 1) ATT_KWAIT(10, 1); else if (kt % 6 == 2) ATT_KWAIT(10, 2); else ATT_KWAIT(10, 3); }
                else if (kt == 4) ATT_KWAIT(8, 4); else if (kt == 5) ATT_KWAIT(6, 5); else if (kt == 6) ATT_KWAIT(4, 0); else if (kt == 7) ATT_KWAIT(2, 1); else ATT_KWAIT(0, 2);
                f32x4 z = {0.f, 0.f, 0.f, 0.f};
                z = __builtin_amdgcn_mfma_f32_16x16x32_bf16(__builtin_bit_cast(bf16x8, kf[kt % 6][0]), qf0, z, 0, 0, 0);
                sc[kt] = __builtin_amdgcn_mfma_f32_16x16x32_bf16(__builtin_bit_cast(bf16x8, kf[kt % 6][1]), qf1, z, 0, 0, 0);
            }
#undef ATT_KRD
#undef ATT_KWAIT
            u32x2 xr[3][8];
#define ATT_TR(dst_, kt_, d0_) do { if (i < 3) asm volatile("ds_read_b64_tr_b16 %0, %1 offset:%2" : "=v"(dst_) : "v"(va[d0_]), "i"((8 * i + (kt_)) * 2048) : "memory"); \
        else { const unsigned ad_ = va[d0_] + ATT_TOFF(kt_); asm volatile("ds_read_b64_tr_b16 %0, %1" : "=v"(dst_) : "v"(ad_) : "memory"); } } while (0)
#define ATT_ISSUE(ks_) do { _Pragma("unroll") for (int d0 = 0; d0 < 4; ++d0) { ATT_TR(xr[(ks_) % 3][2 * d0], 2 * (ks_), d0); if ((ks_) < 4) ATT_TR(xr[(ks_) % 3][2 * d0 + 1], 2 * (ks_) + 1, d0); } } while (0)
#define ATT_WAITL(n_, s_) asm volatile("s_waitcnt lgkmcnt(" #n_ ")" : "+v"(xr[s_][0]), "+v"(xr[s_][1]), "+v"(xr[s_][2]), "+v"(xr[s_][3]), "+v"(xr[s_][4]), "+v"(xr[s_][5]), "+v"(xr[s_][6]), "+v"(xr[s_][7]) :: "memory")
            ATT_ISSUE(0); ATT_ISSUE(1);
            const float NEG = -INFINITY;
#pragma unroll
            for (int e = 0; e < 4; ++e) { const int ik = 4 * g + e; if (ik < li) sc[0][e] = NEG; if (ik > li) sc[8][e] = NEG; }
            if (i == 0 && cur.n0 == 0) {
#pragma unroll
                for (int kt = 0; kt < 8; ++kt) if (w + kt < 8) sc[kt] = (f32x4){NEG, NEG, NEG, NEG};
            }
            float mx = max3f(ATT_SCV(0), ATT_SCV(1), ATT_SCV(2));
#pragma unroll
            for (int k = 3; k < 35; k += 2) mx = max3f(mx, ATT_SCV(k), ATT_SCV(k + 1));
            mx = max3f(mx, ATT_SCV(35), ATT_SCV(35));
            { auto r16 = __builtin_amdgcn_permlane16_swap(__float_as_uint(mx), __float_as_uint(mx), false, false); mx = max3f(__uint_as_float(r16[0]), __uint_as_float(r16[1]), __uint_as_float(r16[1]));
              auto r32 = __builtin_amdgcn_permlane32_swap(__float_as_uint(mx), __float_as_uint(mx), false, false); mx = max3f(__uint_as_float(r32[0]), __uint_as_float(r32[1]), __uint_as_float(r32[1])); }
            pg8::f32x2 ls2 = {0.f, 0.f}; const pg8::f32x2 mx2 = {mx, mx};
#pragma unroll
            for (int kt = 0; kt < 9; ++kt)
#pragma unroll
                for (int hh = 0; hh < 2; ++hh) { const pg8::f32x2 d = (pg8::f32x2){sc[kt][2 * hh], sc[kt][2 * hh + 1]} - mx2; pg8::f32x2 e; e.x = __builtin_amdgcn_exp2f(d.x); e.y = __builtin_amdgcn_exp2f(d.y);
                    ls2 += e; sc[kt][2 * hh] = e.x; sc[kt][2 * hh + 1] = e.y; }
            float lsum = ls2.x + ls2.y;
            { auto r16 = __builtin_amdgcn_permlane16_swap(__float_as_uint(lsum), __float_as_uint(lsum), false, false); lsum = __uint_as_float(r16[0]) + __uint_as_float(r16[1]);
              auto r32 = __builtin_amdgcn_permlane32_swap(__float_as_uint(lsum), __float_as_uint(lsum), false, false); lsum = __uint_as_float(r32[0]) + __uint_as_float(r32[1]); }
            f32x4 oacc[4];
#pragma unroll
            for (int d0 = 0; d0 < 4; ++d0) oacc[d0] = (f32x4){0.f, 0.f, 0.f, 0.f};
#pragma unroll
            for (int ks = 0; ks < 5; ++ks) {
                v4u pw; pw.x = pg8::cvt_pk_bf16(sc[2 * ks][0], sc[2 * ks][1]); pw.y = pg8::cvt_pk_bf16(sc[2 * ks][2], sc[2 * ks][3]);
                if (ks < 4) { pw.z = pg8::cvt_pk_bf16(sc[2 * ks + 1][0], sc[2 * ks + 1][1]); pw.w = pg8::cvt_pk_bf16(sc[2 * ks + 1][2], sc[2 * ks + 1][3]); } else { pw.z = 0u; pw.w = 0u; }
                const bf16x8 pf = __builtin_bit_cast(bf16x8, pw);
                if (ks == 0) ATT_WAITL(8, 0); else if (ks == 1) ATT_WAITL(8, 1); else if (ks == 2) ATT_WAITL(8, 2); else if (ks == 3) ATT_WAITL(4, 0); else { ATT_WAITL(0, 1); xr[1][1] = xr[1][0]; xr[1][3] = xr[1][2]; xr[1][5] = xr[1][4]; xr[1][7] = xr[1][6]; }
#pragma unroll
                for (int d0 = 0; d0 < 4; ++d0) {
                    const u32x2 xa = xr[ks % 3][2 * d0], xb = xr[ks % 3][2 * d0 + 1];
                    const v4u vw = {xa.x, xa.y, xb.x, xb.y};
                    oacc[d0] = __builtin_amdgcn_mfma_f32_16x16x32_bf16(__builtin_bit_cast(bf16x8, vw), pf, oacc[d0], 0, 0, 0); }
                if (ks == 0) ATT_ISSUE(2); else if (ks == 1) ATT_ISSUE(3); else if (ks == 2) ATT_ISSUE(4);
            }
#undef ATT_TR
#undef ATT_ISSUE
#undef ATT_WAITL
#undef ATT_TOFF
            if (i == 2) ATT_WAITV(0x0F7A); else ATT_WAITV(0x0F76);
            const float inv = __builtin_amdgcn_rcpf(lsum);
            const unsigned nb = (unsigned)(cur.n0 + i) * ((unsigned)cur.dil << 17);
            char* opu = OPc + ((size_t)cur.p * T * 1024 + cur.base + nb);
            const unsigned olane = qrow * ((unsigned)cur.dil << 10) + 8 * (g & ~1) + 32 * (g & 1);
            pg8::u32x2_t ow[4];
#pragma unroll
            for (int d0 = 0; d0 < 4; ++d0) { ow[d0].x = pg8::cvt_pk_bf16(oacc[d0][0] * inv, oacc[d0][1] * inv); ow[d0].y = pg8::cvt_pk_bf16(oacc[d0][2] * inv, oacc[d0][3] * inv); }
#pragma unroll
            for (int pr = 0; pr < 2; ++pr) { const pg8::u32x4_t o16 = pg8::widen_rows16(ow[2 * pr], ow[2 * pr + 1]); *(pg8::u32x4_t*)(opu + (olane + 64 * pr)) = o16; }
            if (g == 0) { char* lsu = LSEc + (((size_t)cur.p * T + cur.tok0) * 32 + 4 * cur.h + (size_t)(cur.n0 + i) * cur.dil * 4096);
                *(float*)(lsu + qrow * ((unsigned)cur.dil * 32)) = mx + __builtin_amdgcn_logf(lsum); }
            ATT_BAR;
        }
#pragma unroll
        for (int j = 0; j < 2; ++j) { const unsigned lo = drow[j] * 128 + (lane & 7) * 16;
            *(LAS v4u*)(ring + ATT_KREG + lo) = kr[j]; *(LAS v4u*)(ring + ATT_VREG + lo) = vr[j]; }
        asm volatile("s_waitcnt lgkmcnt(0)" ::: "memory"); ATT_BAR;
        cur = nxt;
    }
    ATT_WAITV(0x0F70); ATT_BAR;
}
#undef ATT_DMA
#undef ATT_QLD
#undef ATT_SCV
#undef ATT_BAR
#undef ATT_SEG
#undef ATT_WAITV
__device__ __forceinline__ void unpack8(const v4u w, float (&f)[8]) { f[0] = bflo(w.x); f[1] = bfhi(w.x); f[2] = bflo(w.y); f[3] = bfhi(w.y); f[4] = bflo(w.z); f[5] = bfhi(w.z); f[6] = bflo(w.w); f[7] = bfhi(w.w); }
__device__ __forceinline__ void p3_merge(Frame& F) {
    const int lane = F.lane, c0 = 8 * lane, head = lane >> 3;
    const int gw = F.vcu * 8 + F.wave, NGW = F.G * 8;
    const bf16* QKV = (const bf16*)(F.ws + WS_QKV);
    const bf16* Zb = QKV + 3 * QKV_STRIDE; const bf16* Bb = QKV + 4 * QKV_STRIDE;
    const bf16* OP = (const bf16*)(F.ws + WS_OP); const float* LSE = (const float*)(F.ws + WS_LSE);
    unsigned char* MX = F.ws + WS_MIX;
    float ag[8], cg[8], w0[8], w1[8], w2[8];
#pragma unroll
    for (int j = 0; j < 8; ++j) { ag[j] = F.attn_g[c0 + j]; cg[j] = F.conv_g[c0 + j]; w0[j] = F.conv_w[c0 + j]; w1[j] = F.conv_w[512 + c0 + j]; w2[j] = F.conv_w[1024 + c0 + j]; }
    for (int run = gw; run < T / 16; run += NGW) {
        const int t0 = run * 16;
        float z1[8], z2[8];
        if ((t0 & (SEQ - 1)) != 0) { unpack8(*(const v4u*)(Zb + (size_t)(t0 - 1) * 512 + c0), z1); unpack8(*(const v4u*)(Zb + (size_t)(t0 - 2) * 512 + c0), z2); }
        else {
#pragma unroll
            for (int j = 0; j < 8; ++j) { z1[j] = 0.f; z2[j] = 0.f; }
        }
        float nl0, nl1, nl2; v4u no0, no1, no2, nz, nb;
#define P3_LOAD(t_) do { const size_t q_ = (size_t)(t_); nl0 = LSE[q_ * 8 + head]; nl1 = LSE[((size_t)T + q_) * 8 + head]; nl2 = LSE[((size_t)2 * T + q_) * 8 + head]; \
            no0 = *(const v4u*)(OP + q_ * 512 + c0); no1 = *(const v4u*)(OP + ((size_t)T + q_) * 512 + c0); no2 = *(const v4u*)(OP + ((size_t)2 * T + q_) * 512 + c0); \
            nz = *(const v4u*)(Zb + q_ * 512 + c0); nb = *(const v4u*)(Bb + q_ * 512 + c0); } while (0)
        P3_LOAD(t0);
#pragma unroll 2
        for (int tt = 0; tt < 16; ++tt) {
            const size_t t = (size_t)t0 + tt;
            const float l0 = nl0, l1 = nl1, l2 = nl2; const v4u vo0 = no0, vo1 = no1, vo2 = no2, vz = nz, vb = nb;
            if (tt + 1 < 16) P3_LOAD(t + 1);
            const float lm = fmaxf(l0, fmaxf(l1, l2));
            float e0 = __builtin_amdgcn_exp2f(l0 - lm), e1 = __builtin_amdgcn_exp2f(l1 - lm), e2 = __builtin_amdgcn_exp2f(l2 - lm);
            const float es = 1.0f / (e0 + e1 + e2); e0 *= es; e1 *= es; e2 *= es;
            float o0[8], o1[8], o2[8], at[8];
            unpack8(vo0, o0); unpack8(vo1, o1); unpack8(vo2, o2);
            float sa = 0.f;
#pragma unroll
            for (int j = 0; j < 8; ++j) { at[j] = e0 * o0[j] + e1 * o1[j] + e2 * o2[j]; sa += at[j] * at[j]; }
            float zz[8], bb[8], co[8];
            unpack8(vz, zz); unpack8(vb, bb);
            float sv = 0.f;
#pragma unroll
            for (int j = 0; j < 8; ++j) { const float z0 = zz[j]; const float cv = z2[j] * w0[j] + z1[j] * w1[j] + z0 * w2[j]; co[j] = bb[j] * cv; sv += co[j] * co[j]; z2[j] = z1[j]; z1[j] = z0; }
#pragma unroll
            for (int o = 1; o < 64; o <<= 1) { sa += __shfl_xor(sa, o); sv += __shfl_xor(sv, o); }
            const float ra = 1.0f / sqrtf(sa * (1.f / 512.f) + NORM_EPS), rc = 1.0f / sqrtf(sv * (1.f / 512.f) + NORM_EPS);
            u32x2 wa, wc;
            wa.x = pg8::pk4_fp8(at[0] * ra * ag[0], at[1] * ra * ag[1], at[2] * ra * ag[2], at[3] * ra * ag[3]); wa.y = pg8::pk4_fp8(at[4] * ra * ag[4], at[5] * ra * ag[5], at[6] * ra * ag[6], at[7] * ra * ag[7]);
            wc.x = pg8::pk4_fp8(co[0] * rc * cg[0], co[1] * rc * cg[1], co[2] * rc * cg[2], co[3] * rc * cg[3]); wc.y = pg8::pk4_fp8(co[4] * rc * cg[4], co[5] * rc * cg[5], co[6] * rc * cg[6], co[7] * rc * cg[7]);
            *(u32x2*)(MX + t * 1024 + c0) = wa; *(u32x2*)(MX + t * 1024 + 512 + c0) = wc;
        }
#undef P3_LOAD
    }
}

#define P5_LOAD(c) do { _Pragma("unroll") for (int i_ = 0; i_ < 4; ++i_) ra[i_] = *(const v4u*)(H + (size_t)(tok0 + prow + 32 * i_) * 1024 + (c) * 128 + pcc * 8); \
                        _Pragma("unroll") for (int i_ = 0; i_ < 2; ++i_) rb[i_] = *(const v4u*)(WRH + (size_t)(prow + 32 * i_) * 1024 + (c) * 128 + pcc * 8); } while (0)
#define P5_STORE(b_) do { _Pragma("unroll") for (int i_ = 0; i_ < 4; ++i_) { const int row_ = prow + 32 * i_; *(LAS v4u*)(lb + (b_) * 49152 + row_ * 256 + ((pcc ^ (row_ & 15)) << 4)) = ra[i_]; } \
                          _Pragma("unroll") for (int i_ = 0; i_ < 2; ++i_) { const int row_ = prow + 32 * i_; *(LAS v4u*)(lb + (b_) * 49152 + 32768 + row_ * 256 + ((pcc ^ (row_ & 15)) << 4)) = rb[i_]; } } while (0)
__device__ __forceinline__ void p5_router(Frame& F, int cwfill) {
    const int tid = F.tid, lane = F.lane, w = F.wave, li = lane & 15, g = lane >> 4;
    const bf16* H = (const bf16*)(F.ws + WS_H16); const bf16* WRH = (const bf16*)(F.ws + WS_WRH);
    int* TOPI = (int*)(F.ws + WS_TOPI); float* GATE = (float*)(F.ws + WS_GATE); int* OFF = (int*)(F.ws + WS_OFF);
    int* ROWTOK = (int*)(F.ws + WS_ROWTOK); float* RSCALE = (float*)(F.ws + WS_RSCALE);
    LAS unsigned* wsc = (LAS unsigned*)(F.lds + LDS_WSC);
    LAS unsigned char* lb = F.lds + RING_OFF;
    const int prow = tid >> 4, pcc = tid & 15;
    float br[8];
#pragma unroll
    for (int r = 0; r < 8; ++r) br[r] = F.b_r[16 * (r >> 2) + 4 * g + (r & 3)];
    for (int blk = blockIdx.x; blk < T / 128; blk += F.G) {
        const int tok0 = blk * 128, tok = tok0 + 16 * w + li;
        v4u ra[4], rb[2];
        P5_LOAD(0); P5_STORE(0);
        __syncthreads();
        f32x4 a0 = {0.f, 0.f, 0.f, 0.f}, a1 = {0.f, 0.f, 0.f, 0.f};
        float ssq = 0.f;
#pragma unroll 1
        for (int c = 0; c < 8; ++c) {
            if (c + 1 < 8) P5_LOAD(c + 1);
            const LAS unsigned char* ab = lb + (c & 1) * 49152 + (16 * w + li) * 256;
            const LAS unsigned char* bb = lb + (c & 1) * 49152 + 32768 + li * 256;
#pragma unroll
            for (int s4 = 0; s4 < 4; ++s4) {
                const int co = (((4 * s4 + g) ^ li) << 4);
                const bf16x8 hf = *(const LAS bf16x8*)(ab + co);
                const bf16x8 w0 = *(const LAS bf16x8*)(bb + co), w1 = *(const LAS bf16x8*)(bb + 16 * 256 + co), w2 = *(const LAS bf16x8*)(bb + 32 * 256 + co), w3 = *(const LAS bf16x8*)(bb + 48 * 256 + co);
                a0 = __builtin_amdgcn_mfma_f32_16x16x32_bf16(w0, hf, a0, 0, 0, 0); a0 = __builtin_amdgcn_mfma_f32_16x16x32_bf16(w2, hf, a0, 0, 0, 0);
                a1 = __builtin_amdgcn_mfma_f32_16x16x32_bf16(w1, hf, a1, 0, 0, 0); a1 = __builtin_amdgcn_mfma_f32_16x16x32_bf16(w3, hf, a1, 0, 0, 0);
#pragma unroll
                for (int j = 0; j < 8; ++j) { const float v = __builtin_bit_cast(float, (unsigned)(unsigned short)hf[j] << 16); ssq += v * v; }
            }
            if (c + 1 < 8) P5_STORE((c + 1) & 1);
            __syncthreads();
        }
        ssq += __shfl_xor(ssq, 16); ssq += __shfl_xor(ssq, 32);
        const float rstd = 1.0f / sqrtf(ssq * (1.f / 1024.f) + NORM_EPS);
        float lg[8];
#pragma unroll
        for (int i = 0; i < 4; ++i) { lg[i] = a0[i] * rstd + br[i]; lg[4 + i] = a1[i] * rstd + br[4 + i]; }
        float tv[4]; int te[4];
#pragma unroll
        for (int k = 0; k < 4; ++k) {
            float bv = lg[0]; int bi = 0;
#pragma unroll
            for (int r = 1; r < 8; ++r) if (lg[r] > bv) { bv = lg[r]; bi = r; }
            int be = 16 * (bi >> 2) + 4 * g + (bi & 3);
#pragma unroll
            for (int o = 16; o <= 32; o <<= 1) { const float ov = __shfl_xor(bv, o); const int oe = __shfl_xor(be, o); const bool take = (ov > bv) || (ov == bv && oe < be); bv = take ? ov : bv; be = take ? oe : be; }
            tv[k] = bv; te[k] = be;
            const int own_r = 4 * (be >> 4) + (be & 3); const bool own = (((be >> 2) & 3) == g);
#pragma unroll
            for (int r = 0; r < 8; ++r) if (own && r == own_r) lg[r] = -INFINITY;
        }
        const float e1 = __builtin_amdgcn_exp2f((tv[1] - tv[0]) * 1.4426950408889634f), e2 = __builtin_amdgcn_exp2f((tv[2] - tv[0]) * 1.4426950408889634f), e3 = __builtin_amdgcn_exp2f((tv[3] - tv[0]) * 1.4426950408889634f);
        const float gs = 1.0f / (1.0f + e1 + e2 + e3);
        if (tid < 32) wsc[tid] = 0u;
        __syncthreads();
        unsigned rk[4] = {0u, 0u, 0u, 0u};
        if (lane < 16) {
#pragma unroll
            for (int k = 0; k < 4; ++k) rk[k] = __hip_atomic_fetch_add(&wsc[te[k]], 1u, __ATOMIC_RELAXED, __HIP_MEMORY_SCOPE_WORKGROUP);
        }
        __syncthreads();
        if (tid < 32) { const unsigned c = wsc[tid]; unsigned base = 0u; if (c) base = __hip_atomic_fetch_add(F.ctl + cwfill + 64 * tid, c, __ATOMIC_RELAXED, __HIP_MEMORY_SCOPE_AGENT); wsc[32 + tid] = base; }
        __syncthreads();
        if (lane < 16) {
            typedef int i32x4 __attribute__((ext_vector_type(4)));
            i32x4 o; o.x = (int)(wsc[32 + te[0]] + rk[0]); o.y = (int)(wsc[32 + te[1]] + rk[1]); o.z = (int)(wsc[32 + te[2]] + rk[2]); o.w = (int)(wsc[32 + te[3]] + rk[3]);
            *(i32x4*)(OFF + (size_t)tok * 4) = o;
            *(i32x4*)(TOPI + (size_t)tok * 4) = (i32x4){te[0], te[1], te[2], te[3]};
            *(f32x4*)(GATE + (size_t)tok * 4) = (f32x4){gs, e1 * gs, e2 * gs, e3 * gs};
            ROWTOK[(size_t)te[0] * T + o.x] = tok; ROWTOK[(size_t)te[1] * T + o.y] = tok; ROWTOK[(size_t)te[2] * T + o.z] = tok; ROWTOK[(size_t)te[3] * T + o.w] = tok;
            RSCALE[(size_t)te[0] * T + o.x] = rstd; RSCALE[(size_t)te[1] * T + o.y] = rstd; RSCALE[(size_t)te[2] * T + o.z] = rstd; RSCALE[(size_t)te[3] * T + o.w] = rstd;
        }
        __syncthreads();
    }
}
#undef P5_LOAD
#undef P5_STORE

__device__ __forceinline__ int build_tiles(Frame& F) {
    LAS int* tstart = (LAS int*)(F.lds + LDS_TSTART); LAS int* texp = (LAS int*)(F.lds + LDS_TEXP); LAS int* tcnt = (LAS int*)(F.lds + LDS_TCNT);
    __syncthreads();
    if (F.tid < 64) {
        const int e = F.tid & 31;
        const unsigned c = __hip_atomic_load(F.ctl + CW_FILL + 64 * e, __ATOMIC_RELAXED, __HIP_MEMORY_SCOPE_AGENT);
        const int nt = (int)((c + 255u) >> 8);
        int inc = nt;
#pragma unroll
        for (int o = 1; o < 32; o <<= 1) { const int v = __shfl_up(inc, o, 32); if (e >= o) inc += v; }
        if (F.tid < 32) { tcnt[e] = (int)c; tstart[e] = inc - nt; if (e == 31) tstart[32] = inc; }
    }
    __syncthreads();
    if (F.tid < NE) { const int a = tstart[F.tid], b = tstart[F.tid + 1]; for (int t = a; t < b; ++t) texp[t] = F.tid; }
    __syncthreads();
    return tstart[NE];
}
__device__ __forceinline__ void build_idx(Frame& F, const pg8::MoeOrder& S, unsigned pitch) {
    LAS unsigned* idxtab = (LAS unsigned*)(F.lds + LDS_IDX);
    LAS int* udesc = (LAS int*)(F.lds + LDS_WSC);
    const LAS int* tstart = (const LAS int*)(F.lds + LDS_TSTART); const LAS int* tcnt = (const LAS int*)(F.lds + LDS_TCNT);
    const int* ROWTOK = (const int*)(F.ws + WS_ROWTOK);
    if (F.tid < 24) { pg8::Unit u; const bool ok = S.next(F.tid, u); const int e = ok ? (u.pn >> 3) : -1; udesc[2 * F.tid] = e; udesc[2 * F.tid + 1] = ok ? 256 * (u.pm - tstart[e]) : 0; }
    __syncthreads();
#pragma unroll
    for (int i = 0; i < 12; ++i) { const int idx = i * 512 + F.tid, ui = idx >> 8, row = idx & 255; const int e = udesc[2 * ui];
        if (e >= 0) { const int lr = udesc[2 * ui + 1] + row; const int tok = (lr < tcnt[e]) ? ROWTOK[(size_t)e * T + lr] : 0; idxtab[idx] = (unsigned)tok * pitch; } }
    __syncthreads();
}

__device__ __forceinline__ void unpack8_fp8(const pg8::u32x2_t w, float (&f)[8]) {
    typedef float f32x2_ __attribute__((ext_vector_type(2)));
    const f32x2_ a = __builtin_amdgcn_cvt_pk_f32_fp8((int)w.x, false), b = __builtin_amdgcn_cvt_pk_f32_fp8((int)w.x, true), c = __builtin_amdgcn_cvt_pk_f32_fp8((int)w.y, false), d = __builtin_amdgcn_cvt_pk_f32_fp8((int)w.y, true);
    f[0] = a.x; f[1] = a.y; f[2] = b.x; f[3] = b.y; f[4] = c.x; f[5] = c.y; f[6] = d.x; f[7] = d.y;
}
__device__ __forceinline__ void p9_combine(Frame& F, float* outp) {
    if (N_LAUNCHES != 1) build_tiles(F);
    const LAS int* tstart = (const LAS int*)(F.lds + LDS_TSTART);
    const int lane = F.lane, gw = F.vcu * 8 + F.wave, NGW = F.G * 8;
    const int* TOPI = (const int*)(F.ws + WS_TOPI); const int* OFF = (const int*)(F.ws + WS_OFF); const float* GATE = (const float*)(F.ws + WS_GATE); const unsigned char* YB = F.ws + WS_XB;
    const bf16* H = (const bf16*)(F.ws + WS_H16);
    f32x4 gg[2][2];
#pragma unroll
    for (int j = 0; j < 2; ++j) { gg[j][0] = *(const f32x4*)(F.gf + 512 * j + 8 * lane); gg[j][1] = *(const f32x4*)(F.gf + 512 * j + 8 * lane + 4); }
    typedef int i32x4 __attribute__((ext_vector_type(4)));
    for (int tok0 = gw; tok0 < T; tok0 += 2 * NGW) {
        int tk[2]; tk[0] = tok0; tk[1] = (tok0 + NGW < T) ? tok0 + NGW : tok0;
        i32x4 d[2]; f32x4 gt[2]; v4u hw[2][2]; pg8::u32x2_t yw[2][2][4];
#pragma unroll
        for (int q = 0; q < 2; ++q) { const int tok = tk[q];
            const i32x4 te = *(const i32x4*)(TOPI + (size_t)tok * 4), of = *(const i32x4*)(OFF + (size_t)tok * 4); gt[q] = *(const f32x4*)(GATE + (size_t)tok * 4) * 0.125f;
            d[q].x = 256 * tstart[te.x] + of.x; d[q].y = 256 * tstart[te.y] + of.y; d[q].z = 256 * tstart[te.z] + of.z; d[q].w = 256 * tstart[te.w] + of.w; }
#pragma unroll
        for (int q = 0; q < 2; ++q)
#pragma unroll
            for (int j = 0; j < 2; ++j) { const size_t co = 512 * j + 8 * lane;
                hw[q][j] = *(const v4u*)(H + (size_t)tk[q] * 1024 + co);
                yw[q][j][0] = *(const pg8::u32x2_t*)(YB + (size_t)d[q].x * 1024 + co); yw[q][j][1] = *(const pg8::u32x2_t*)(YB + (size_t)d[q].y * 1024 + co);
                yw[q][j][2] = *(const pg8::u32x2_t*)(YB + (size_t)d[q].z * 1024 + co); yw[q][j][3] = *(const pg8::u32x2_t*)(YB + (size_t)d[q].w * 1024 + co); }
#pragma unroll
        for (int q = 0; q < 2; ++q) {
            if (q == 1 && tk[1] == tk[0]) break;
            float hv[2][8]; float ssq = 0.f;
#pragma unroll
            for (int j = 0; j < 2; ++j) {
                float h8[8], y0[8], y1[8], y2[8], y3[8];
                unpack8(hw[q][j], h8); unpack8_fp8(yw[q][j][0], y0); unpack8_fp8(yw[q][j][1], y1); unpack8_fp8(yw[q][j][2], y2); unpack8_fp8(yw[q][j][3], y3);
#pragma unroll
                for (int i = 0; i < 8; ++i) { const float v = h8[i] + (gt[q].x * y0[i] + gt[q].y * y1[i]) + (gt[q].z * y2[i] + gt[q].w * y3[i]); hv[j][i] = v; ssq += v * v; } }
            const float rstd = 1.0f / sqrtf(wave_sum(ssq) * (1.f / 1024.f) + NORM_EPS);
#pragma unroll
            for (int j = 0; j < 2; ++j) { float* hp = outp + (size_t)tk[q] * 1024 + 512 * j + 8 * lane;
                f32x4 a, b; a.x = hv[j][0] * rstd * gg[j][0].x; a.y = hv[j][1] * rstd * gg[j][0].y; a.z = hv[j][2] * rstd * gg[j][0].z; a.w = hv[j][3] * rstd * gg[j][0].w;
                b.x = hv[j][4] * rstd * gg[j][1].x; b.y = hv[j][5] * rstd * gg[j][1].y; b.z = hv[j][6] * rstd * gg[j][1].z; b.w = hv[j][7] * rstd * gg[j][1].w;
                *(f32x4*)hp = a; *(f32x4*)(hp + 4) = b; }
        }
    }
}

constexpr int PER_PHASE = 10;
struct Args { const float* in[15]; float* out; unsigned char* ws; int ph_lo, ph_hi; };
__global__ void __launch_bounds__(512, 2) hyb_fwd(Args args) {
    extern __shared__ __attribute__((aligned(16))) unsigned char lds[];
    Frame F;
    F.lds = (LAS unsigned char*)lds;
    F.tid = threadIdx.x; F.lane = F.tid & 63; F.wave = __builtin_amdgcn_readfirstlane(F.tid >> 6);
    F.G = gridDim.x; { const int bx = blockIdx.x; F.vcu = (F.G % 8 == 0) ? (bx % 8) * (F.G / 8) + bx / 8 : bx; }
    F.x = args.in[0]; F.g1 = args.in[1]; F.w_in = args.in[2]; F.attn_g = args.in[3]; F.conv_w = args.in[4]; F.conv_g = args.in[5]; F.w_out = args.in[6]; F.g2 = args.in[7];
    F.w_r = args.in[8]; F.b_r = args.in[9]; F.w_gu = args.in[10]; F.b_gu = args.in[11]; F.w_dn = args.in[12]; F.b_dn = args.in[13]; F.gf = args.in[14];
    F.out = args.out; F.ws = args.ws; F.ctl = (gu32*)(args.ws + WS_CTL);
    for (int u = F.tid; u < (LDS_BYTES - MISC_OFF) / 4; u += 512) ((LAS unsigned*)(F.lds + MISC_OFF))[u] = 0u;
    __syncthreads();
    XcdBarrier bar; bar.bar = (unsigned*)(F.ctl + CW_BAR); bar.x = 0; bar.st = nullptr;
    if (N_LAUNCHES == 1) bar = xcd_barrier_post((unsigned*)(F.ctl + CW_BAR), (volatile LAS unsigned*)(F.lds + MISC_OFF + 32));
    const int lo = args.ph_lo, hi = args.ph_hi;
#define IN(k) (lo <= (k) && (k) < hi)
#define SEAM(k) do { if (IN(k) && IN((k) + 1)) { xcd_barrier(bar); } } while (0)

    if (IN(0)) { p0_prologue(F); SEAM(0); }
    if (IN(1)) {
        pg8::Gemm g{(const pg8::bf16_t*)(F.ws + WS_XN), (const pg8::bf16_t*)(F.ws + WS_WIN), T, NPROJ, DM}; pg8::StaticOrder S; S.init(T, NPROJ, F.G, (int)blockIdx.x);
        pg8::EpiQKV E{(pg8::bf16_t*)(F.ws + WS_QKV), (const float*)(F.ws + WS_ROPE), QKV_STRIDE};
        { const int nun = (S.nwg > (int)blockIdx.x) ? (S.nwg - (int)blockIdx.x + F.G - 1) / F.G : 0, kcut = (int)blockIdx.x % (nun + 1);
          pg8::RangeOrder R0{S, 0, kcut}, R1{S, kcut, nun};
          pg8::gemm_phase<pg8::EpiQKV, pg8::RangeOrder, true, true>(F.lds + RING_OFF, g, R0, E);
          __syncthreads();
          p0_moe_slice(F);
          __syncthreads();
          pg8::gemm_phase<pg8::EpiQKV, pg8::RangeOrder, true, true>(F.lds + RING_OFF, g, R1, E); }
        SEAM(1);
    }
    if (IN(2)) { p2_attention(F); SEAM(2); }
    if (IN(3)) { p3_merge(F); SEAM(3); }
    if (IN(4)) {
        pg8::StaticOrder S; S.init(T, DM, F.G, (int)blockIdx.x);
        pg8::EpiRes8 E{(const pg8::bf16_t*)(F.ws + WS_XN), (const float*)(F.ws + WS_RINV), (const float*)(F.ws + WS_GINV), (pg8::bf16_t*)(F.ws + WS_H16), F.ws + WS_H8};
        pg8::gemm_phase2<pg8::EpiRes8, pg8::StaticOrder, false, true, 122>(F.lds + RING_OFF, F.ws + WS_MIX, F.ws + WS_WOUT, 1024, 1024, 8, S, E, nullptr, F.lds + LDS_IDX + 20480);
        SEAM(4);
    }
    if (IN(5)) { p5_router(F, CW_FILL); if (IN(7)) xcd_barrier(bar); }
    if (IN(7)) {
        const int ntiles = build_tiles(F);
        pg8::MoeOrder S; S.init(ntiles, 8, F.G, (int)blockIdx.x, (const LAS int*)(F.lds + LDS_TEXP));
        build_idx(F, S, 1024u);
        pg8::EpiSwiGLU E{F.ws + WS_ACT, F.b_gu, (const float*)(F.ws + WS_RSCALE), (const LAS int*)(F.lds + LDS_TSTART)};
        pg8::gemm_phase2<pg8::EpiSwiGLU, pg8::MoeOrder, true, true, 122>(F.lds + RING_OFF, F.ws + WS_H8, F.ws + WS_WGU, 1024, 1024, 8, S, E, (const LAS unsigned*)(F.lds + LDS_IDX), F.lds + LDS_IDX + 20480);
        SEAM(7);
    }
    if (IN(8)) {
        const int ntiles = (N_LAUNCHES != 1) ? build_tiles(F) : ((const LAS int*)(F.lds + LDS_TSTART))[NE];
        pg8::MoeOrder S; S.init(ntiles, 4, F.G, (int)blockIdx.x, (const LAS int*)(F.lds + LDS_TEXP));
        pg8::EpiOut8 E{F.ws + WS_XB, (const float*)(F.ws + WS_BDN32)};
        pg8::gemm_phase2<pg8::EpiOut8, pg8::MoeOrder, false, true, 122>(F.lds + RING_OFF, F.ws + WS_ACT, F.ws + WS_WDN, 1024, 1024, 8, S, E, nullptr, F.lds + LDS_IDX + 20480);
        SEAM(8);
    }
    if (IN(9)) { p9_combine(F, F.out); }
#undef IN
#undef SEAM
}

extern "C" void kernel_launch(void* const* d_in, const int* in_sizes, int n_in, void* d_out, int out_size, void* d_ws, size_t ws_size, hipStream_t stream) {
    static int grid = 0;
    if (grid == 0) {
        if (n_in != 15 || in_sizes[0] != T * DM || out_size != T * DM || ws_size < WS_END) { fprintf(stderr, "kernel_launch: unexpected shapes/workspace (n_in %d, ws %zu)\n", n_in, ws_size); grid = -1; return; }
        int dev = 0, cus = 0, per_cu = 0;
        if (hipGetDevice(&dev) != hipSuccess || hipDeviceGetAttribute(&cus, hipDeviceAttributeMultiprocessorCount, dev) != hipSuccess) { grid = -1; return; }
        if (hipFuncSetAttribute((const void*)hyb_fwd, hipFuncAttributeMaxDynamicSharedMemorySize, LDS_BYTES) != hipSuccess) { fprintf(stderr, "kernel_launch: hipFuncSetAttribute failed\n"); grid = -1; return; }
        if (hipOccupancyMaxActiveBlocksPerMultiprocessor(&per_cu, (const void*)hyb_fwd, 512, LDS_BYTES) != hipSuccess || per_cu < 1) { fprintf(stderr, "kernel_launch: occupancy query says %d\n", per_cu); per_cu = 1; }
        (void)hipGetLastError();
        grid = cus;
    }
    if (grid < 0) return;
    if (hipMemsetAsync((char*)d_ws + WS_CTL, 0, CTL_ZERO_BYTES, stream) != hipSuccess) { fprintf(stderr, "kernel_launch: memset failed\n"); return; }
    Args a{};
    for (int i = 0; i < 15; ++i) a.in[i] = (const float*)d_in[i];
    a.out = (float*)d_out; a.ws = (unsigned char*)d_ws;
    if (N_LAUNCHES == 1) {
        a.ph_lo = 0; a.ph_hi = PER_PHASE;
        void* kargs[] = {&a};
        const hipError_t le = hipLaunchCooperativeKernel((const void*)hyb_fwd, dim3(grid), dim3(512), kargs, LDS_BYTES, stream);
        if (le != hipSuccess) fprintf(stderr, "kernel_launch: cooperative launch failed: %s (grid %d)\n", hipGetErrorName(le), grid);
    } else {
        for (int li = 0; li < PER_PHASE; ++li) {
            a.ph_lo = li; a.ph_hi = li + 1;
            hipLaunchKernelGGL(hyb_fwd, dim3(grid), dim3(512), LDS_BYTES, stream, a);
        }
    }
}
```

```cpp
#include <hip/hip_runtime.h>
#include <hip/hip_bf16.h>
#include <cstdio>
#include <cstdint>
#include <cmath>

#ifndef MK_N_LAUNCHES
#define MK_N_LAUNCHES 1
#endif

constexpr int N_LAUNCHES = MK_N_LAUNCHES;
constexpr int BATCH = 4, SEQ = 8192, DM = 1024, T = BATCH * SEQ;
constexpr int NH = 8, HD = 64, AW = 512, NPROJ = 3072;
constexpr int NE = 32, TOPK = 4, FF = 1024;
constexpr int MASSIGN = T * TOPK;
constexpr int PMAX = MASSIGN + NE * 256;
constexpr int MAXTILES = PMAX / 256;
constexpr float NORM_EPS = 1e-5f;
constexpr float QSCALE = 0.125f * 1.4426950408889634f;

namespace pg8 {
#define PG8_LAS __attribute__((address_space(3)))
typedef unsigned short bf16_t;
typedef short bf16x8 __attribute__((ext_vector_type(8)));
typedef float f32x4 __attribute__((ext_vector_type(4)));
typedef unsigned u32x4 __attribute__((ext_vector_type(4)));
constexpr int BM = 256, BK = 64, HALF = 128, HTB = HALF * BK * 2  , STAGE_BYTES = 8 * HTB, NXCD = 8, WGM = 8;

__host__ __device__ __forceinline__ int lds_byte(int r, int c) { const int st = (r >> 4) * 2 + (c >> 5), rr = r & 15, cc = c & 31, ob = rr * 64 + cc * 2; return st * 1024 + (ob ^ (((ob >> 9) & 1) << 5)); }
__host__ __device__ __forceinline__ void stage_rc(int b, int& R, int& C) { const int st = b / 1024, sb = b % 1024, swz = sb ^ (((sb >> 9) & 1) << 5); R = (st >> 1) * 16 + swz / 64; C = (st & 1) * 32 + (swz % 64) / 2; }
__host__ __device__ __forceinline__ int perm32(int rho) { const int n = rho >> 4, i = rho & 15; return 8 * (i >> 2) + 4 * n + (i & 3); }

struct Unit { int pm, pn; };
struct Gemm { const bf16_t* A; const bf16_t* Bt; int M, N, K; };

struct StaticOrder {
    int nM, nN, nwg, G, c;
    __host__ __device__ void init(int M, int N, int G_, int c_) { nM = M / BM; nN = N / BM; nwg = nM * nN; G = G_; c = c_; }
    __host__ __device__ bool next(int i, Unit& u) const {
        const long L = (long)i * G + c; if (L >= nwg) return false;
        int wgid = (int)L; { const int q = nwg / NXCD, r = nwg % NXCD, xcd = wgid % NXCD, off = wgid / NXCD; wgid = (xcd < r ? xcd * (q + 1) : r * (q + 1) + (xcd - r) * q) + off; }
        const int nig = WGM * nN, gid = wgid / nig, fm = gid * WGM, gsz = (nM - fm) < WGM ? (nM - fm) : WGM;
        u.pm = fm + ((wgid % nig) % gsz); u.pn = (wgid % nig) / gsz; return true;
    }
    __device__ __forceinline__ void a_ready(const Unit&) const {}
    __device__ __forceinline__ void done(const Unit&) const {}
};

struct RangeOrder {
    StaticOrder base; int lo, hi;
    __host__ __device__ bool next(int i, Unit& u) const { return (lo + i < hi) && base.next(lo + i, u); }
    __device__ __forceinline__ void a_ready(const Unit&) const {}
    __device__ __forceinline__ void done(const Unit&) const {}
};
__device__ __forceinline__ unsigned cvt_pk_bf16(float lo, float hi) { unsigned r; asm volatile("v_cvt_pk_bf16_f32 %0, %1, %2" : "=v"(r) : "v"(lo), "v"(hi)); return r; }
typedef float f32x2 __attribute__((ext_vector_type(2)));
__device__ __forceinline__ f32x2 gelu_pk(f32x2 v) {
    const f32x2 av = __builtin_elementwise_abs(v), d = av * 0.2316418882f + 1.0f;
    f32x2 t; t.x = __builtin_amdgcn_rcpf(d.x); t.y = __builtin_amdgcn_rcpf(d.y);
    f32x2 q = t * 0.5307027145f + (-0.7265760135f); q = q * t + 0.7107068705f; q = q * t + (-0.142248368f); q = q * t + 0.127414796f; q = q * t;
    const f32x2 s = (v * v) * (-0.72134752044f);
    f32x2 e; e.x = __builtin_amdgcn_exp2f(s.x); e.y = __builtin_amdgcn_exp2f(s.y);
    const f32x2 m = v * (q * e), r = v - m;
    f32x2 o; o.x = v.x < 0.f ? m.x : r.x; o.y = v.y < 0.f ? m.y : r.y; return o;
}

template <int ACT  > struct EpiBf16 {
    static constexpr bool PERM = true, AFTER_DRAIN = false; static_assert(ACT == 0 || ACT == 1, "EpiBf16: ACT is 0 (none) or 1 (gelu_pk)");
    bf16_t* O; int ldc; const float* bias; int split_cols; size_t split_stride; float scale0;
    __device__ __forceinline__ void operator()(const f32x4 (&acc)[2][2][4][2], const Unit& u, int wr, int wc, int fr, int fq) const {
        const int row0 = u.pm * BM + wr * 64 + fr; int colt = u.pn * BM; bf16_t* base = O;
        float sc = 1.f; if (split_cols) { const int t = colt / split_cols; base += (size_t)t * split_stride; colt -= t * split_cols; if (t == 0) sc = scale0; }
        const int col0 = colt + wc * 32 + 8 * fq, bcol0 = u.pn * BM + wc * 32 + 8 * fq;
        f32x4 bv[2][2];
#pragma unroll
        for (int bj = 0; bj < 2; ++bj)
#pragma unroll
            for (int n = 0; n < 2; ++n) bv[bj][n] = bias ? *(const f32x4*)(bias + bcol0 + bj * HALF + 4 * n) : (f32x4){0.f, 0.f, 0.f, 0.f};
#pragma unroll
        for (int ai = 0; ai < 2; ++ai)
#pragma unroll
            for (int m = 0; m < 4; ++m) { bf16_t* rowp = base + (size_t)(row0 + ai * HALF + m * 16) * ldc + col0;
#pragma unroll
                for (int bj = 0; bj < 2; ++bj) { f32x4 v0 = acc[ai][bj][m][0] + bv[bj][0], v1 = acc[ai][bj][m][1] + bv[bj][1];
                    if (ACT == 1) { f32x2 a = gelu_pk((f32x2){v0[0], v0[1]}), b = gelu_pk((f32x2){v0[2], v0[3]}), c = gelu_pk((f32x2){v1[0], v1[1]}), d = gelu_pk((f32x2){v1[2], v1[3]});
                        v0 = (f32x4){a.x, a.y, b.x, b.y}; v1 = (f32x4){c.x, c.y, d.x, d.y}; }
                    v0 = v0 * sc; v1 = v1 * sc; u32x4 w; w.x = cvt_pk_bf16(v0[0], v0[1]); w.y = cvt_pk_bf16(v0[2], v0[3]); w.z = cvt_pk_bf16(v1[0], v1[1]); w.w = cvt_pk_bf16(v1[2], v1[3]);
                    *(u32x4*)(rowp + bj * HALF) = w; } }
    }
};

typedef unsigned u32x4_t __attribute__((ext_vector_type(4)));
typedef unsigned u32x2_t __attribute__((ext_vector_type(2)));
__device__ __forceinline__ unsigned pk4_fp8(float a, float b, float c, float d);
__device__ __forceinline__ u32x4_t widen_rows16(const u32x2_t wa, const u32x2_t wb) {
    const auto r0 = __builtin_amdgcn_permlane16_swap(wa.x, wb.x, false, false); const auto r1 = __builtin_amdgcn_permlane16_swap(wa.y, wb.y, false, false);
    u32x4_t o; o.x = r0[0]; o.y = r1[0]; o.z = r0[1]; o.w = r1[1]; return o;
}
__device__ __forceinline__ unsigned pk4_fp8(float a, float b, float c, float d) { int r = __builtin_amdgcn_cvt_pk_fp8_f32(a, b, 0, false); r = __builtin_amdgcn_cvt_pk_fp8_f32(c, d, r, true); return (unsigned)r; }
struct EpiQKV {
    static constexpr bool PERM = true, AFTER_DRAIN = false;
    bf16_t* __restrict__ out; const float* __restrict__ cs; size_t bufstride;
    __device__ __forceinline__ void operator()(const f32x4 (&acc)[2][2][4][2], const Unit& u, int wr, int wc, int fr, int fq) const {
        const int buf = u.pn >> 1; bf16_t* base = out + (size_t)buf * bufstride;
        const int row0 = u.pm * BM + wr * 64 + fr;
        if (u.pn < 4) {
            const float sc = (u.pn < 2) ? 0.125f * 1.4426950408889634f : 1.0f;
            const int head = (u.pn & 1) * 4 + wc;
#pragma unroll
            for (int ai = 0; ai < 2; ++ai) {
                f32x4 cv[4][4];
#pragma unroll
                for (int m = 0; m < 4; ++m) { const int pos = (row0 + ai * HALF + m * 16) & 8191; const f32x4* cp = (const f32x4*)(cs + (size_t)pos * 64 + fq * 16);
                    cv[m][0] = cp[0]; cv[m][1] = cp[1]; cv[m][2] = cp[2]; cv[m][3] = cp[3]; }
#pragma unroll
                for (int m = 0; m < 4; ++m) {
                    const int row = row0 + ai * HALF + m * 16;
                    const f32x4 c0 = cv[m][0], c1 = cv[m][1], c2 = cv[m][2], c3 = cv[m][3];
                    const f32x4 lo0 = acc[ai][0][m][0], lo1 = acc[ai][0][m][1], hi0 = acc[ai][1][m][0], hi1 = acc[ai][1][m][1];
                    float ol[8], oh[8];
                    ol[0] = lo0[0] * c0[0] - hi0[0] * c0[1]; oh[0] = hi0[0] * c0[0] + lo0[0] * c0[1];
                    ol[1] = lo0[1] * c0[2] - hi0[1] * c0[3]; oh[1] = hi0[1] * c0[2] + lo0[1] * c0[3];
                    ol[2] = lo0[2] * c1[0] - hi0[2] * c1[1]; oh[2] = hi0[2] * c1[0] + lo0[2] * c1[1];
                    ol[3] = lo0[3] * c1[2] - hi0[3] * c1[3]; oh[3] = hi0[3] * c1[2] + lo0[3] * c1[3];
                    ol[4] = lo1[0] * c2[0] - hi1[0] * c2[1]; oh[4] = hi1[0] * c2[0] + lo1[0] * c2[1];
                    ol[5] = lo1[1] * c2[2] - hi1[1] * c2[3]; oh[5] = hi1[1] * c2[2] + lo1[1] * c2[3];
                    ol[6] = lo1[2] * c3[0] - hi1[2] * c3[1]; oh[6] = hi1[2] * c3[0] + lo1[2] * c3[1];
                    ol[7] = lo1[3] * c3[2] - hi1[3] * c3[3]; oh[7] = hi1[3] * c3[2] + lo1[3] * c3[3];
                    u32x4_t wl, wh;
                    wl.x = cvt_pk_bf16(ol[0] * sc, ol[1] * sc); wl.y = cvt_pk_bf16(ol[2] * sc, ol[3] * sc); wl.z = cvt_pk_bf16(ol[4] * sc, ol[5] * sc); wl.w = cvt_pk_bf16(ol[6] * sc, ol[7] * sc);
                    wh.x = cvt_pk_bf16(oh[0] * sc, oh[1] * sc); wh.y = cvt_pk_bf16(oh[2] * sc, oh[3] * sc); wh.z = cvt_pk_bf16(oh[4] * sc, oh[5] * sc); wh.w = cvt_pk_bf16(oh[6] * sc, oh[7] * sc);
                    const bool lo8 = fr < 8; const u32x4_t snd = lo8 ? wh : wl; u32x4_t rcv;
                    rcv.x = (unsigned)__builtin_amdgcn_mov_dpp((int)snd.x, 0x128, 0xF, 0xF, true); rcv.y = (unsigned)__builtin_amdgcn_mov_dpp((int)snd.y, 0x128, 0xF, 0xF, true);
                    rcv.z = (unsigned)__builtin_amdgcn_mov_dpp((int)snd.z, 0x128, 0xF, 0xF, true); rcv.w = (unsigned)__builtin_amdgcn_mov_dpp((int)snd.w, 0x128, 0xF, 0xF, true);
                    bf16_t* rowp = base + (size_t)(row - fr + (fr & 7)) * 512 + head * 64 + 8 * fq + (lo8 ? 0 : 32);
                    __builtin_nontemporal_store(lo8 ? wl : rcv, (u32x4_t*)(rowp)); __builtin_nontemporal_store(lo8 ? rcv : wh, (u32x4_t*)(rowp + 8 * 512));
                }
            }
        } else if (u.pn == 6 || u.pn == 7 || u.pn >= 10) {
            const int j = (u.pn >= 10) ? u.pn - 8 : u.pn - 6; bf16_t* zb = out + 3 * bufstride;
#pragma unroll
            for (int ai = 0; ai < 2; ++ai)
#pragma unroll
                for (int m = 0; m < 4; ++m) { const f32x4 z0 = acc[ai][0][m][0] * acc[ai][1][m][0], z1 = acc[ai][0][m][1] * acc[ai][1][m][1];
                    u32x4_t w; w.x = cvt_pk_bf16(z0[0], z0[1]); w.y = cvt_pk_bf16(z0[2], z0[3]); w.z = cvt_pk_bf16(z1[0], z1[1]); w.w = cvt_pk_bf16(z1[2], z1[3]);
                    *(u32x4_t*)(zb + (size_t)(row0 + ai * HALF + m * 16) * 512 + 128 * j + wc * 32 + 8 * fq) = w; }
        } else {
            const int col0 = (u.pn & 1) * 256 + wc * 32 + 8 * fq;
#pragma unroll
            for (int ai = 0; ai < 2; ++ai)
#pragma unroll
                for (int m = 0; m < 4; ++m) { bf16_t* rowp = base + (size_t)(row0 + ai * HALF + m * 16) * 512 + col0;
#pragma unroll
                    for (int bj = 0; bj < 2; ++bj) { const f32x4 v0 = acc[ai][bj][m][0], v1 = acc[ai][bj][m][1];
                        u32x4_t w; w.x = cvt_pk_bf16(v0[0], v0[1]); w.y = cvt_pk_bf16(v0[2], v0[3]); w.z = cvt_pk_bf16(v1[0], v1[1]); w.w = cvt_pk_bf16(v1[2], v1[3]);
                        *(u32x4_t*)(rowp + bj * HALF) = w; } }
        }
    }
};
struct EpiRes {
    static constexpr bool PERM = true, AFTER_DRAIN = false;
    const bf16_t* __restrict__ xn; const float* __restrict__ rinv; const float* __restrict__ ginv; bf16_t* __restrict__ out; unsigned char* __restrict__ out8;
    __device__ __forceinline__ void operator()(const f32x4 (&acc)[2][2][4][2], const Unit& u, int wr, int wc, int fr, int fq) const {
        const int row0 = u.pm * BM + wr * 64 + fr, col0 = u.pn * BM + wc * 32 + 8 * fq;
        f32x4 gi[2][2];
#pragma unroll
        for (int bj = 0; bj < 2; ++bj) { gi[bj][0] = *(const f32x4*)(ginv + col0 + bj * HALF); gi[bj][1] = *(const f32x4*)(ginv + col0 + bj * HALF + 4); }
#pragma unroll
        for (int ai = 0; ai < 2; ++ai) {
            u32x4_t xw[4][2]; float ri[4];
#pragma unroll
            for (int m = 0; m < 4; ++m) { const int row = row0 + ai * HALF + m * 16; ri[m] = rinv[row];
#pragma unroll
                for (int bj = 0; bj < 2; ++bj) xw[m][bj] = *(const u32x4_t*)(xn + (size_t)row * 1024 + col0 + bj * HALF); }
            u32x2_t w8[2][2];
#pragma unroll
            for (int m = 0; m < 4; ++m) { const int row = row0 + ai * HALF + m * 16; const size_t off = (size_t)row * 1024 + col0;
#pragma unroll
                for (int bj = 0; bj < 2; ++bj) { const u32x4_t q = xw[m][bj];
                    f32x4 xa, xb;
                    xa[0] = __builtin_bit_cast(float, q.x << 16); xa[1] = __builtin_bit_cast(float, q.x & 0xffff0000u); xa[2] = __builtin_bit_cast(float, q.y << 16); xa[3] = __builtin_bit_cast(float, q.y & 0xffff0000u);
                    xb[0] = __builtin_bit_cast(float, q.z << 16); xb[1] = __builtin_bit_cast(float, q.z & 0xffff0000u); xb[2] = __builtin_bit_cast(float, q.w << 16); xb[3] = __builtin_bit_cast(float, q.w & 0xffff0000u);
                    const f32x4 x0 = xa * gi[bj][0] * ri[m] + acc[ai][bj][m][0], x1 = xb * gi[bj][1] * ri[m] + acc[ai][bj][m][1];
                    u32x4_t w; w.x = cvt_pk_bf16(x0[0], x0[1]); w.y = cvt_pk_bf16(x0[2], x0[3]); w.z = cvt_pk_bf16(x1[0], x1[1]); w.w = cvt_pk_bf16(x1[2], x1[3]);
                    *(u32x4_t*)(out + off + bj * HALF) = w;
                    w8[m & 1][bj].x = pk4_fp8(x0[0], x0[1], x0[2], x0[3]); w8[m & 1][bj].y = pk4_fp8(x1[0], x1[1], x1[2], x1[3]); }
                if (m & 1) {
#pragma unroll
                    for (int bj = 0; bj < 2; ++bj) *(u32x4_t*)(out8 + (size_t)(row0 + ai * HALF + ((m & ~1) + (fq & 1)) * 16) * 1024 + u.pn * BM + wc * 32 + 8 * (fq & ~1) + bj * HALF) = widen_rows16(w8[0][bj], w8[1][bj]); } }
        }
    }
};
struct EpiRes8 {
    static constexpr bool PERM = true, AFTER_DRAIN = false;
    const bf16_t* __restrict__ xn; const float* __restrict__ rinv; const float* __restrict__ ginv; bf16_t* __restrict__ out; unsigned char* __restrict__ out8;
    __device__ __forceinline__ void prefetch(const Unit&, PG8_LAS unsigned char*, int, int) const {}
    __device__ __forceinline__ void operator()(const f32x4 (&acc)[2][2][4][2], const Unit& u, int wr, int wc, int fr, int fq, const PG8_LAS unsigned char*) const {
        const int row0 = u.pm * BM + wr * 64 + fr, col0 = u.pn * BM + wc * 64 + 8 * fq;
        f32x4 gi[2][2];
#pragma unroll
        for (int bj = 0; bj < 2; ++bj) { gi[bj][0] = *(const f32x4*)(ginv + col0 + bj * 32); gi[bj][1] = *(const f32x4*)(ginv + col0 + bj * 32 + 4); }
        const bool lo8 = fr < 8;
#pragma unroll
        for (int ai = 0; ai < 2; ++ai) {
            u32x4_t xw[4][2]; float ri[4];
#pragma unroll
            for (int m = 0; m < 4; ++m) { const int row = row0 + ai * HALF + m * 16; ri[m] = rinv[row];
#pragma unroll
                for (int bj = 0; bj < 2; ++bj) xw[m][bj] = *(const u32x4_t*)(xn + (size_t)row * 1024 + col0 + bj * 32); }
#pragma unroll
            for (int m = 0; m < 4; ++m) { const int row = row0 + ai * HALF + m * 16;
                u32x4_t wv[2];
#pragma unroll
                for (int bj = 0; bj < 2; ++bj) { const u32x4_t q = xw[m][bj];
                    f32x4 xa, xb;
                    xa[0] = __builtin_bit_cast(float, q.x << 16); xa[1] = __builtin_bit_cast(float, q.x & 0xffff0000u); xa[2] = __builtin_bit_cast(float, q.y << 16); xa[3] = __builtin_bit_cast(float, q.y & 0xffff0000u);
                    xb[0] = __builtin_bit_cast(float, q.z << 16); xb[1] = __builtin_bit_cast(float, q.z & 0xffff0000u); xb[2] = __builtin_bit_cast(float, q.w << 16); xb[3] = __builtin_bit_cast(float, q.w & 0xffff0000u);
                    const f32x4 x0 = xa * gi[bj][0] * ri[m] + acc[ai][bj][m][0] * 0.03125f, x1 = xb * gi[bj][1] * ri[m] + acc[ai][bj][m][1] * 0.03125f;
                    wv[bj].x = cvt_pk_bf16(x0[0], x0[1]); wv[bj].y = cvt_pk_bf16(x0[2], x0[3]); wv[bj].z = cvt_pk_bf16(x1[0], x1[1]); wv[bj].w = cvt_pk_bf16(x1[2], x1[3]);
}
                { const u32x4_t snd = lo8 ? wv[1] : wv[0]; u32x4_t rcv;
                  rcv.x = (unsigned)__builtin_amdgcn_mov_dpp((int)snd.x, 0x128, 0xF, 0xF, true); rcv.y = (unsigned)__builtin_amdgcn_mov_dpp((int)snd.y, 0x128, 0xF, 0xF, true);
                  rcv.z = (unsigned)__builtin_amdgcn_mov_dpp((int)snd.z, 0x128, 0xF, 0xF, true); rcv.w = (unsigned)__builtin_amdgcn_mov_dpp((int)snd.w, 0x128, 0xF, 0xF, true);
                  bf16_t* rowp = out + (size_t)(row - fr + (fr & 7)) * 1024 + col0 + (lo8 ? 0 : 32);
                  __builtin_nontemporal_store(lo8 ? wv[0] : rcv, (u32x4_t*)rowp); __builtin_nontemporal_store(lo8 ? rcv : wv[1], (u32x4_t*)(rowp + 8 * 1024)); }
            }
        }
    }
};
struct EpiSwiGLU {
    static constexpr bool PERM = true, AFTER_DRAIN = false;
    unsigned char* act; const float* bgu; const float* rscale; const __attribute__((address_space(3))) int* tstart;
    __device__ __forceinline__ void prefetch(const Unit& nu, PG8_LAS unsigned char* buf, int wid, int lane) const {
        const int e = nu.pn >> 3, pnl = nu.pn & 7;
        if (wid == 0) { const float* src = bgu + (size_t)e * 2048 + 128 * pnl + ((lane < 32) ? 4 * lane : 1024 + 4 * (lane - 32));
            __builtin_amdgcn_global_load_lds((const unsigned*)src, (PG8_LAS unsigned*)buf, 16, 0, 0); }
        if (wid == 1) { const float* src = rscale + (size_t)e * 32768 + (size_t)(nu.pm - tstart[e]) * BM + 4 * lane;
            __builtin_amdgcn_global_load_lds((const unsigned*)src, (PG8_LAS unsigned*)(buf + 1024), 16, 0, 0); }
    }
    __device__ __forceinline__ void operator()(const f32x4 (&acc)[2][2][4][2], const Unit& u, int wr, int wc, int fr, int fq, const PG8_LAS unsigned char* buf) const {
        const int pnl = u.pn & 7;
        const int row0 = u.pm * BM + wr * 64 + fr;
        constexpr float SWC = 1.702f * 1.4426950408889634f;
        f32x4 bg[2], bu[2];
#pragma unroll
        for (int n = 0; n < 2; ++n) { bg[n] = *(const PG8_LAS f32x4*)(buf + (32 * wc + 8 * fq + 4 * n) * 4) * SWC; bu[n] = *(const PG8_LAS f32x4*)(buf + 512 + (32 * wc + 8 * fq + 4 * n) * 4); }
        float rsv[2][4]; u32x2_t wq[2];
#pragma unroll
        for (int ai = 0; ai < 2; ++ai)
#pragma unroll
            for (int m = 0; m < 4; ++m) rsv[ai][m] = *(const PG8_LAS float*)(buf + 1024 + (ai * HALF + wr * 64 + m * 16 + fr) * 4);
#pragma unroll
        for (int ai = 0; ai < 2; ++ai)
#pragma unroll
            for (int m = 0; m < 4; ++m) {
                const float rs = rsv[ai][m] * 0.03125f, rsc = rs * SWC;
                f32x2 o[4];
#pragma unroll
                for (int n = 0; n < 2; ++n)
#pragma unroll
                    for (int h = 0; h < 2; ++h) {
                        const f32x2 a = {acc[ai][0][m][n][2 * h], acc[ai][0][m][n][2 * h + 1]}, b = {acc[ai][1][m][n][2 * h], acc[ai][1][m][n][2 * h + 1]};
                        const f32x2 bgp = {bg[n][2 * h], bg[n][2 * h + 1]}, bup = {bu[n][2 * h], bu[n][2 * h + 1]};
                        const f32x2 gv = a * rsc + bgp, uv = b * rs + bup;
                        f32x2 g, up; g.x = fminf(gv.x, 7.0f * SWC); g.y = fminf(gv.y, 7.0f * SWC); up.x = __builtin_amdgcn_fmed3f(uv.x, -7.0f, 7.0f); up.y = __builtin_amdgcn_fmed3f(uv.y, -7.0f, 7.0f);
                        f32x2 ex; ex.x = __builtin_amdgcn_exp2f(-g.x); ex.y = __builtin_amdgcn_exp2f(-g.y);
                        const f32x2 dd = ex + 1.0f;
                        f32x2 rr; rr.x = __builtin_amdgcn_rcpf(dd.x); rr.y = __builtin_amdgcn_rcpf(dd.y);
                        o[2 * n + h] = (up * (1.0f / SWC) + (1.0f / SWC)) * (g * rr);
                    }
                wq[m & 1].x = pk4_fp8(o[0].x, o[0].y, o[1].x, o[1].y); wq[m & 1].y = pk4_fp8(o[2].x, o[2].y, o[3].x, o[3].y);
                if (m & 1) *(u32x4_t*)(act + (size_t)(row0 + ai * HALF + ((m & ~1) + (fq & 1)) * 16) * 1024 + 128 * pnl + 32 * wc + 8 * (fq & ~1)) = widen_rows16(wq[0], wq[1]);
            }
    }
};
struct EpiOut8 {
    static constexpr bool PERM = true, AFTER_DRAIN = false;
    unsigned char* out; const float* bias32;
    __device__ __forceinline__ void prefetch(const Unit& nu, PG8_LAS unsigned char* buf, int wid, int lane) const {
        if (wid == 0) { const float* src = bias32 + (size_t)(nu.pn >> 2) * 1024 + 256 * (nu.pn & 3) + 4 * lane;
            __builtin_amdgcn_global_load_lds((const unsigned*)src, (PG8_LAS unsigned*)buf, 16, 0, 0); }
    }
    __device__ __forceinline__ void operator()(const f32x4 (&acc)[2][2][4][2], const Unit& u, int wr, int wc, int fr, int fq, const PG8_LAS unsigned char* buf) const {
        const int pnl = u.pn & 3;
        const int row0 = u.pm * BM + wr * 64 + fr;
        f32x4 bv[2][2];
#pragma unroll
        for (int bj = 0; bj < 2; ++bj)
#pragma unroll
            for (int n = 0; n < 2; ++n) bv[bj][n] = *(const PG8_LAS f32x4*)(buf + (bj * HALF + 32 * wc + 8 * fq + 4 * n) * 4);
        const int odd = fq & 1, colw = 256 * pnl + 32 * wc + 8 * (fq & ~1);
#pragma unroll
        for (int ai = 0; ai < 2; ++ai)
#pragma unroll
            for (int mp = 0; mp < 2; ++mp) { unsigned char* rowp = out + (size_t)(row0 + ai * HALF + (2 * mp + odd) * 16) * 1024 + colw;
#pragma unroll
                for (int bj = 0; bj < 2; ++bj) { u32x2_t w[2];
#pragma unroll
                    for (int q = 0; q < 2; ++q) { const int m = 2 * mp + q; const f32x4 v0 = (acc[ai][bj][m][0] + bv[bj][0]) * 0.25f, v1 = (acc[ai][bj][m][1] + bv[bj][1]) * 0.25f;
                        w[q].x = pk4_fp8(v0[0], v0[1], v0[2], v0[3]); w[q].y = pk4_fp8(v1[0], v1[1], v1[2], v1[3]); }
                    *(u32x4_t*)(rowp + bj * HALF) = widen_rows16(w[0], w[1]); } }
    }
};
struct MoeOrder {
    int ntiles, npn, nwg, G, c; const __attribute__((address_space(3))) int* texp;
    __device__ void init(int ntiles_, int npn_, int G_, int c_, const __attribute__((address_space(3))) int* texp_) { ntiles = ntiles_; npn = npn_; nwg = ntiles_ * npn_; G = G_; c = c_; texp = texp_; }
    __device__ bool next(int i, Unit& u) const {
        const long L = (long)i * G + c; if (L >= nwg) return false;
        int wgid = (int)L; { const int q = nwg / NXCD, r = nwg % NXCD, xcd = wgid % NXCD, off = wgid / NXCD; wgid = (xcd < r ? xcd * (q + 1) : r * (q + 1) + (xcd - r) * q) + off; }
        constexpr int WG2 = 4; const int nig = WG2 * npn, gid = wgid / nig, fm = gid * WG2, gsz = (ntiles - fm) < WG2 ? (ntiles - fm) : WG2;
        const int t = fm + ((wgid % nig) % gsz), pnl = (wgid % nig) / gsz;
        const int e = texp[t];
        u.pm = t; u.pn = e * npn + pnl; return true;
    }
    __device__ __forceinline__ void a_ready(const Unit&) const {}
    __device__ __forceinline__ void done(const Unit&) const {}
};
template <class Epi, class Sched, bool ALIGN_EPI = false, bool SP2 = false>
__device__ __forceinline__ void gemm_phase(PG8_LAS unsigned char* lds, const Gemm g, const Sched& S, const Epi& E) {
    const int tid = threadIdx.x, wid = __builtin_amdgcn_readfirstlane(tid >> 6), lane = tid & 63, wr = wid >> 2, wc = wid & 3, fr = lane & 15, fq = lane >> 4;
    const int K = g.K, nt = K / BK;
    unsigned voffA[2], voffB[2];
#pragma unroll
    for (int i = 0; i < 2; ++i) { int R, C; stage_rc(tid * 16 + i * 8192, R, C); const int Rb = Epi::PERM ? ((R & ~31) + perm32(R & 31)) : R;
        voffA[i] = (unsigned)(R * K + C) * 2u; voffB[i] = (unsigned)(Rb * K + C) * 2u; }
    const size_t kstep = (size_t)(BK * 2);
    const size_t hstep = (size_t)HALF * K * 2;
    const size_t tstep = 2 * hstep;
    const unsigned ldsw = (unsigned)wid * 1024u;
    const int aoff = lds_byte(wr * 64 + fr, fq * 8), boff = lds_byte(wc * 32 + fr, fq * 8);
#define PG8_SA(b, h) (((b) * 2 + (h)) * HTB)
#define PG8_SB(b, h) ((4 + (b) * 2 + (h)) * HTB)
#define PG8_STAGE(bufoff, gbase, voff) do { _Pragma("unroll") for (int _i = 0; _i < 2; ++_i) \
        __builtin_amdgcn_global_load_lds((const unsigned*)((const char*)(gbase) + (voff)[_i]), (PG8_LAS unsigned*)(lds + (bufoff) + ldsw + _i * 8192), 16, 0, 0); } while (0)
#define PG8_LDA(dst, b, h) do { _Pragma("unroll") for (int m = 0; m < 4; ++m) _Pragma("unroll") for (int k = 0; k < 2; ++k) dst[m][k] = *(const PG8_LAS bf16x8*)(lds + PG8_SA(b, h) + aoff + m * 2048 + k * 1024); } while (0)
#define PG8_LDB(dst, b, h) do { _Pragma("unroll") for (int n = 0; n < 2; ++n) _Pragma("unroll") for (int k = 0; k < 2; ++k) dst[n][k] = *(const PG8_LAS bf16x8*)(lds + PG8_SB(b, h) + boff + n * 2048 + k * 1024); } while (0)
#define PG8_MMA(ai, bj, At, Bt) do { __builtin_amdgcn_s_setprio(1); _Pragma("unroll") for (int m = 0; m < 4; ++m) _Pragma("unroll") for (int n = 0; n < 2; ++n) _Pragma("unroll") for (int k = 0; k < 2; ++k) \
        acc[ai][bj][m][n] = __builtin_amdgcn_mfma_f32_16x16x32_bf16(Bt[n][k], At[m][k], acc[ai][bj][m][n], 0, 0, 0); __builtin_amdgcn_s_setprio(0); } while (0)
#define PG8_WAIT_V(n) asm volatile("s_waitcnt vmcnt(" #n ")" ::: "memory")
#define PG8_WAIT_L(n) asm volatile("s_waitcnt lgkmcnt(" #n ")" ::: "memory")
#define PG8_BAR __builtin_amdgcn_s_barrier()
#define PG8_SCHED __builtin_amdgcn_sched_barrier(0)
    Unit cur, nxt; int ui = 0;
    if (!S.next(0, cur)) return;
    f32x4 acc[2][2][4][2];
#pragma unroll
    for (int a = 0; a < 2; ++a)
#pragma unroll
        for (int b = 0; b < 2; ++b)
#pragma unroll
            for (int m = 0; m < 4; ++m)
#pragma unroll
                for (int n = 0; n < 2; ++n) acc[a][b][m][n] = (f32x4){0.f, 0.f, 0.f, 0.f};
    bf16x8 At[4][2], B0[2][2], B1[2][2];
    const char* cA = (const char*)g.A + (size_t)cur.pm * tstep; const char* cB = (const char*)g.Bt + (size_t)cur.pn * tstep;
    S.a_ready(cur);
    if constexpr (SP2) {
        PG8_STAGE(PG8_SB(0, 0), cB, voffB); PG8_STAGE(PG8_SB(0, 1), cB + hstep, voffB); PG8_STAGE(PG8_SA(0, 0), cA, voffA); PG8_STAGE(PG8_SA(0, 1), cA + hstep, voffA);
        if (wr == 1) PG8_BAR;
        PG8_WAIT_V(2); PG8_BAR;
        PG8_STAGE(PG8_SB(1, 0), cB + kstep, voffB); PG8_STAGE(PG8_SA(1, 0), cA + kstep, voffA); PG8_STAGE(PG8_SB(1, 1), cB + hstep + kstep, voffB);
        PG8_WAIT_V(6); PG8_BAR;
    } else {
        PG8_STAGE(PG8_SB(0, 0), cB, voffB); PG8_STAGE(PG8_SA(0, 0), cA, voffA); PG8_STAGE(PG8_SB(0, 1), cB + hstep, voffB); PG8_STAGE(PG8_SA(0, 1), cA + hstep, voffA);
        if (wr == 1) PG8_BAR;
        PG8_WAIT_V(4); PG8_BAR;
        PG8_STAGE(PG8_SB(1, 0), cB + kstep, voffB); PG8_STAGE(PG8_SA(1, 0), cA + kstep, voffA); PG8_STAGE(PG8_SB(1, 1), cB + hstep + kstep, voffB);
        PG8_WAIT_V(6); PG8_BAR;
    }
    for (;;) {
        const bool has_next = S.next(ui + 1, nxt);
        const char* nA = has_next ? (const char*)g.A + (size_t)nxt.pm * tstep : cA; const char* nB = has_next ? (const char*)g.Bt + (size_t)nxt.pn * tstep : cB;
        for (int t = 0; t < nt; t += 2) {
            const bool last = (t == nt - 2);
            const char* a1 = cA + (size_t)(t + 1) * kstep;
            const char* a2 = last ? nA : cA + (size_t)(t + 2) * kstep; const char* b2 = last ? nB : cB + (size_t)(t + 2) * kstep;
            const char* a3 = a2 + kstep; const char* b3 = b2 + kstep;
            if (last && has_next) S.a_ready(nxt);
            if constexpr (SP2) {
            PG8_LDB(B0, 0, 0); PG8_LDB(B1, 0, 1); PG8_SCHED; PG8_LDA(At, 0, 0); PG8_STAGE(PG8_SA(1, 1), a1 + hstep, voffA);
            PG8_WAIT_V(8); PG8_WAIT_L(0); PG8_BAR; PG8_MMA(0, 0, At, B0); PG8_MMA(0, 1, At, B1); PG8_BAR; PG8_SCHED;
            PG8_LDA(At, 0, 1); PG8_STAGE(PG8_SB(0, 0), b2, voffB); PG8_STAGE(PG8_SB(0, 1), b2 + hstep, voffB); PG8_STAGE(PG8_SA(0, 0), a2, voffA);
            PG8_WAIT_V(8); PG8_WAIT_L(0); PG8_BAR; PG8_MMA(1, 0, At, B0); PG8_MMA(1, 1, At, B1); PG8_BAR; PG8_SCHED;
            PG8_LDB(B0, 1, 0); PG8_LDB(B1, 1, 1); PG8_SCHED; PG8_LDA(At, 1, 0); PG8_STAGE(PG8_SA(0, 1), a2 + hstep, voffA);
            PG8_WAIT_V(8); PG8_WAIT_L(0); PG8_BAR; PG8_MMA(0, 0, At, B0); PG8_MMA(0, 1, At, B1); PG8_BAR; PG8_SCHED;
            PG8_LDA(At, 1, 1); PG8_STAGE(PG8_SB(1, 0), b3, voffB); PG8_STAGE(PG8_SB(1, 1), b3 + hstep, voffB); PG8_STAGE(PG8_SA(1, 0), a3, voffA);
            PG8_WAIT_V(8); PG8_WAIT_L(0); PG8_BAR; PG8_MMA(1, 0, At, B0); PG8_MMA(1, 1, At, B1); PG8_BAR; PG8_SCHED;
            } else {
            PG8_LDB(B0, 0, 0); PG8_SCHED; PG8_LDA(At, 0, 0); PG8_STAGE(PG8_SA(1, 1), a1 + hstep, voffA);
            PG8_WAIT_L(8); PG8_BAR; PG8_WAIT_L(0); PG8_MMA(0, 0, At, B0); PG8_BAR; PG8_SCHED;
            PG8_LDB(B1, 0, 1); PG8_STAGE(PG8_SB(0, 0), b2, voffB);
            PG8_BAR; PG8_WAIT_L(0); PG8_MMA(0, 1, At, B1); PG8_BAR;
            PG8_LDA(At, 0, 1); PG8_STAGE(PG8_SA(0, 0), a2, voffA);
            PG8_BAR; PG8_WAIT_L(0); PG8_MMA(1, 0, At, B0); PG8_BAR; PG8_SCHED;
            PG8_STAGE(PG8_SB(0, 1), b2 + hstep, voffB);
            PG8_WAIT_V(6); PG8_BAR; PG8_MMA(1, 1, At, B1); PG8_BAR;
            PG8_LDB(B0, 1, 0); PG8_SCHED; PG8_LDA(At, 1, 0); PG8_STAGE(PG8_SA(0, 1), a2 + hstep, voffA);
            PG8_WAIT_L(8); PG8_BAR; PG8_WAIT_L(0); PG8_MMA(0, 0, At, B0); PG8_BAR; PG8_SCHED;
            PG8_LDB(B1, 1, 1); PG8_STAGE(PG8_SB(1, 0), b3, voffB);
            PG8_BAR; PG8_WAIT_L(0); PG8_MMA(0, 1, At, B1); PG8_BAR;
            PG8_LDA(At, 1, 1); PG8_STAGE(PG8_SA(1, 0), a3, voffA);
            PG8_BAR; PG8_WAIT_L(0); PG8_MMA(1, 0, At, B0); PG8_BAR; PG8_SCHED;
            PG8_STAGE(PG8_SB(1, 1), b3 + hstep, voffB);
            PG8_WAIT_V(6); PG8_BAR; PG8_MMA(1, 1, At, B1); PG8_BAR;
            }
        }
        if constexpr (ALIGN_EPI) { if (wr == 0) PG8_BAR; }
        if constexpr (!Epi::AFTER_DRAIN) { E(acc, cur, wr, wc, fr, fq); S.done(cur); }
        if (!has_next) break;
#pragma unroll
        for (int a = 0; a < 2; ++a)
#pragma unroll
            for (int b = 0; b < 2; ++b)
#pragma unroll
                for (int m = 0; m < 4; ++m)
#pragma unroll
                    for (int n = 0; n < 2; ++n) acc[a][b][m][n] = (f32x4){0.f, 0.f, 0.f, 0.f};
        cur = nxt; cA = nA; cB = nB; ++ui;
        if constexpr (ALIGN_EPI) { if (wr == 1) PG8_BAR; }
    }
    PG8_WAIT_V(0);
    if constexpr (!ALIGN_EPI) { if (wr == 0) PG8_BAR; }
    PG8_BAR;
    if constexpr (Epi::AFTER_DRAIN) { E.fused(acc, cur, wr, wc, fr, fq, lds, wid, lane); S.done(cur); }
#undef PG8_SA
#undef PG8_SB
#undef PG8_STAGE
#undef PG8_LDA
#undef PG8_LDB
#undef PG8_CAT
#undef PG8_MMA
#undef PG8_WAIT_V
#undef PG8_WAIT_L
#undef PG8_BAR
#undef PG8_SCHED
}

typedef int i32x4_t __attribute__((ext_vector_type(4)));
typedef int i32x8_t __attribute__((ext_vector_type(8)));
template <class Epi, class Sched, bool GATHER, bool FP8, int SCALE_B = 127>
__device__ __forceinline__ void gemm_phase2(PG8_LAS unsigned char* lds, const void* Aptr, const void* Btptr, int pitchA, int pitchB, int nt, const Sched& S, const Epi& E, const PG8_LAS unsigned* idxtab, PG8_LAS unsigned char* ebuf) {
    const int tid = threadIdx.x, wid = __builtin_amdgcn_readfirstlane(tid >> 6), lane = tid & 63, wr = wid >> 2, wc = wid & 3, fr = lane & 15, fq = lane >> 4;
    unsigned voffB[2], cA2[2]; int RA[2];
#pragma unroll
    for (int i = 0; i < 2; ++i) { int R, C; stage_rc(tid * 16 + i * 8192, R, C); const int Rb = Epi::PERM ? ((R & ~31) + perm32(R & 31)) : R;
        voffB[i] = (unsigned)(Rb * pitchB + C * 2); RA[i] = R; cA2[i] = (unsigned)(C * 2); }
    const size_t kstep = 128;
    const size_t hstepB = (size_t)HALF * pitchB, tstepB = 2 * hstepB, tstepA = (size_t)BM * pitchA;
    const unsigned ldsw = (unsigned)wid * 1024u;
    const int aoff = lds_byte(wr * 64 + fr, fq * 8), boff = lds_byte(wc * 32 + fr, fq * 8);
#define PG8_SA(b, h) (((b) * 2 + (h)) * HTB)
#define PG8_SB(b, h) ((4 + (b) * 2 + (h)) * HTB)
#define PG8_STAGE(bufoff, gbase, voff) do { _Pragma("unroll") for (int _i = 0; _i < 2; ++_i) \
        __builtin_amdgcn_global_load_lds((const unsigned*)((const char*)(gbase) + (voff)[_i]), (PG8_LAS unsigned*)(lds + (bufoff) + ldsw + _i * 8192), 16, 0, 0); } while (0)
#define PG8_LDA(dst, b, h) do { _Pragma("unroll") for (int m = 0; m < 4; ++m) _Pragma("unroll") for (int k = 0; k < 2; ++k) dst[m][k] = *(const PG8_LAS bf16x8*)(lds + PG8_SA(b, h) + aoff + m * 2048 + k * 1024); } while (0)
#define PG8_LDB(dst, b, h) do { _Pragma("unroll") for (int n = 0; n < 2; ++n) _Pragma("unroll") for (int k = 0; k < 2; ++k) dst[n][k] = *(const PG8_LAS bf16x8*)(lds + PG8_SB(b, h) + boff + n * 2048 + k * 1024); } while (0)
#define PG8_CAT(x0, x1) __builtin_shufflevector(__builtin_bit_cast(i32x4_t, x0), __builtin_bit_cast(i32x4_t, x1), 0, 1, 2, 3, 4, 5, 6, 7)
#define PG8_MMA(ai, bj, At, Bt) do { __builtin_amdgcn_s_setprio(1); \
        if constexpr (FP8) { _Pragma("unroll") for (int m = 0; m < 4; ++m) _Pragma("unroll") for (int n = 0; n < 2; ++n) \
            asm volatile("s_nop 1\n\tv_mfma_f32_16x16x128_f8f6f4 %0, %1, %2, %0" : "+v"(acc[ai][bj][m][n]) : "v"(PG8_CAT(Bt[n][0], Bt[n][1])), "v"(PG8_CAT(At[m][0], At[m][1]))); } \
        else { _Pragma("unroll") for (int m = 0; m < 4; ++m) _Pragma("unroll") for (int n = 0; n < 2; ++n) _Pragma("unroll") for (int k = 0; k < 2; ++k) \
            acc[ai][bj][m][n] = __builtin_amdgcn_mfma_f32_16x16x32_bf16(Bt[n][k], At[m][k], acc[ai][bj][m][n], 0, 0, 0); } \
        __builtin_amdgcn_s_setprio(0); } while (0)
#define PG8_WAIT_V(n) asm volatile("s_waitcnt vmcnt(" #n ")" ::: "memory")
#define PG8_WAIT_L(n) asm volatile("s_waitcnt lgkmcnt(" #n ")" ::: "memory")
#define PG8_BAR __builtin_amdgcn_s_barrier()
#define PG8_SCHED __builtin_amdgcn_sched_barrier(0)
    Unit cur, nxt; int ui = 0;
    if (!S.next(0, cur)) return;
    f32x4 acc[2][2][4][2];
#pragma unroll
    for (int a = 0; a < 2; ++a)
#pragma unroll
        for (int b = 0; b < 2; ++b)
#pragma unroll
            for (int m = 0; m < 4; ++m)
#pragma unroll
                for (int n = 0; n < 2; ++n) acc[a][b][m][n] = (f32x4){0.f, 0.f, 0.f, 0.f};
    bf16x8 At[4][2], B0[2][2], B1[2][2];
    unsigned va[2][2], vn[2][2];
#pragma unroll
    for (int h = 0; h < 2; ++h)
#pragma unroll
        for (int i = 0; i < 2; ++i) { va[h][i] = GATHER ? idxtab[h * HALF + RA[i]] + cA2[i] : (unsigned)((RA[i] + h * HALF) * pitchA) + cA2[i]; vn[h][i] = va[h][i]; }
    const char* cA = (const char*)Aptr + (GATHER ? (size_t)0 : (size_t)cur.pm * tstepA); const char* cB = (const char*)Btptr + (size_t)cur.pn * tstepB;
    S.a_ready(cur);
    E.prefetch(cur, ebuf, wid, lane);
    PG8_STAGE(PG8_SB(0, 0), cB, voffB); PG8_STAGE(PG8_SB(0, 1), cB + hstepB, voffB); PG8_STAGE(PG8_SA(0, 0), cA, va[0]); PG8_STAGE(PG8_SA(0, 1), cA, va[1]);
    if (wr == 1) PG8_BAR;
    PG8_WAIT_V(2); PG8_BAR;
    PG8_STAGE(PG8_SB(1, 0), cB + kstep, voffB); PG8_STAGE(PG8_SA(1, 0), cA + kstep, va[0]); PG8_STAGE(PG8_SB(1, 1), cB + hstepB + kstep, voffB);
    PG8_WAIT_V(6); PG8_BAR;
    for (;;) {
        const bool has_next = S.next(ui + 1, nxt);
        const char* nA = (GATHER || !has_next) ? cA : (const char*)Aptr + (size_t)nxt.pm * tstepA; const char* nB = has_next ? (const char*)Btptr + (size_t)nxt.pn * tstepB : cB;
        if (GATHER && has_next) {
#pragma unroll
            for (int h = 0; h < 2; ++h)
#pragma unroll
                for (int i = 0; i < 2; ++i) vn[h][i] = idxtab[(ui + 1) * BM + h * HALF + RA[i]] + cA2[i];
        }
#pragma unroll 1
        for (int t = 0; t < nt; t += 2) {
            const bool last = (t == nt - 2);
            const char* a1 = cA + (size_t)(t + 1) * kstep;
            const char* a2 = last ? nA : cA + (size_t)(t + 2) * kstep; const char* b2 = last ? nB : cB + (size_t)(t + 2) * kstep;
            const char* a3 = a2 + kstep; const char* b3 = b2 + kstep;
            unsigned s2[2][2];
#pragma unroll
            for (int h = 0; h < 2; ++h)
#pragma unroll
                for (int i = 0; i < 2; ++i) s2[h][i] = (GATHER && last) ? vn[h][i] : va[h][i];
            if (last && has_next) S.a_ready(nxt);
            PG8_LDB(B0, 0, 0); PG8_LDB(B1, 0, 1); PG8_SCHED; PG8_LDA(At, 0, 0); PG8_STAGE(PG8_SA(1, 1), a1, va[1]);
            PG8_WAIT_V(8); PG8_WAIT_L(0); PG8_BAR; PG8_MMA(0, 0, At, B0); PG8_MMA(0, 1, At, B1); PG8_BAR; PG8_SCHED;
            PG8_LDA(At, 0, 1); PG8_STAGE(PG8_SB(0, 0), b2, voffB); PG8_STAGE(PG8_SB(0, 1), b2 + hstepB, voffB); PG8_STAGE(PG8_SA(0, 0), a2, s2[0]);
            PG8_WAIT_V(8); PG8_WAIT_L(0); PG8_BAR; PG8_MMA(1, 0, At, B0); PG8_MMA(1, 1, At, B1); PG8_BAR; PG8_SCHED;
            PG8_LDB(B0, 1, 0); PG8_LDB(B1, 1, 1); PG8_SCHED; PG8_LDA(At, 1, 0); PG8_STAGE(PG8_SA(0, 1), a2, s2[1]);
            PG8_WAIT_V(8); PG8_WAIT_L(0); PG8_BAR; PG8_MMA(0, 0, At, B0); PG8_MMA(0, 1, At, B1); PG8_BAR; PG8_SCHED;
            PG8_LDA(At, 1, 1); PG8_STAGE(PG8_SB(1, 0), b3, voffB); PG8_STAGE(PG8_SB(1, 1), b3 + hstepB, voffB); PG8_STAGE(PG8_SA(1, 0), a3, s2[0]);
            PG8_WAIT_V(8); PG8_WAIT_L(0); PG8_BAR; PG8_MMA(1, 0, At, B0); PG8_MMA(1, 1, At, B1); PG8_BAR; PG8_SCHED;
        }
        if (wr == 0) PG8_BAR;
        if constexpr (FP8) { asm volatile("s_nop 15\n\ts_nop 7" ::: "memory"); PG8_SCHED; }
        if (has_next) E.prefetch(nxt, ebuf + ((ui + 1) & 1) * 2048, wid, lane);
        E(acc, cur, wr, wc, fr, fq, ebuf + (ui & 1) * 2048); S.done(cur);
        if (!has_next) break;
#pragma unroll
        for (int a = 0; a < 2; ++a)
#pragma unroll
            for (int b = 0; b < 2; ++b)
#pragma unroll
                for (int m = 0; m < 4; ++m)
#pragma unroll
                    for (int n = 0; n < 2; ++n) acc[a][b][m][n] = (f32x4){0.f, 0.f, 0.f, 0.f};
        cur = nxt; cA = nA; cB = nB; ++ui;
#pragma unroll
        for (int h = 0; h < 2; ++h)
#pragma unroll
            for (int i = 0; i < 2; ++i) va[h][i] = vn[h][i];
        if (wr == 1) PG8_BAR;
    }
    PG8_WAIT_V(0);
    PG8_BAR;
#undef PG8_SA
#undef PG8_SB
#undef PG8_STAGE
#undef PG8_LDA
#undef PG8_LDB
#undef PG8_CAT
#undef PG8_MMA
#undef PG8_WAIT_V
#undef PG8_WAIT_L
#undef PG8_BAR
#undef PG8_SCHED
}
}
#define GAS __attribute__((address_space(1)))
#define LAS __attribute__((address_space(3)))
typedef unsigned short bf16;
typedef unsigned v4u __attribute__((ext_vector_type(4)));
typedef float f32x4 __attribute__((ext_vector_type(4)));
typedef short bf16x8 __attribute__((ext_vector_type(8)));
typedef GAS unsigned gu32;
typedef GAS unsigned long long gu64;
#define RLX_AGENT __ATOMIC_RELAXED, __HIP_MEMORY_SCOPE_AGENT
#define LDS_WAIT() asm volatile("s_waitcnt lgkmcnt(0)" ::: "memory")
#define VM_WAIT() asm volatile("s_waitcnt vmcnt(0)" ::: "memory")
__device__ __forceinline__ unsigned long long rt() { return __builtin_amdgcn_s_memrealtime(); }
__device__ __forceinline__ unsigned f2bf(float f) { unsigned u = __builtin_bit_cast(unsigned, f); return (u + 0x7fffu + ((u >> 16) & 1u)) >> 16; }
__device__ __forceinline__ unsigned pk2(float lo, float hi) { return f2bf(lo) | (f2bf(hi) << 16); }

#define XB_TMO      128
#define XB_XCNT(j)  (256  + 64 * (j))
#define XB_XSUB(j)  (1280 + 64 * (j))
#define XB_XGEN(j)  (2304 + 64 * (j))
#define XB_TOP      3328
#define XB_TOPGEN   3392
#define XCD_BAR_WORDS 3456
#define XB_SPIN_CAP (1u << 18)

__device__ __forceinline__ unsigned xb_ld(unsigned* p)              { return __hip_atomic_load(p, __ATOMIC_RELAXED, __HIP_MEMORY_SCOPE_AGENT); }
__device__ __forceinline__ unsigned xb_add(unsigned* p, unsigned v) { return __hip_atomic_fetch_add(p, v, __ATOMIC_RELAXED, __HIP_MEMORY_SCOPE_AGENT); }
__device__ __forceinline__ unsigned xb_xcc_id() { return (unsigned)__builtin_amdgcn_s_getreg((3 << 11) | 20) & 0xFu; }
#define XB_SPIN(cond, bar) do { unsigned _sp = 0; while (cond) { __builtin_amdgcn_s_sleep(1); \
    if ((++_sp & 255u) == 0u) { if (xb_ld(&(bar)[XB_TMO])) break; if (_sp > XB_SPIN_CAP) { atomicAdd(&(bar)[XB_TMO], 1u); break; } } } } while (0)

struct XcdBarrier {
    unsigned* bar; unsigned x;
    volatile LAS unsigned* st;
};

__device__ __forceinline__ XcdBarrier xcd_barrier_post(unsigned* bar, volatile LAS unsigned* st) {
    XcdBarrier b; b.bar = bar; b.x = xb_xcc_id(); b.st = st;
    if (threadIdx.x == 0) (void)xb_add(&bar[XB_XCNT(b.x)], 1u);
    return b;
}
__device__ __forceinline__ void xcd_barrier_complete(unsigned* bar, unsigned x, unsigned& nloc, unsigned& nx) {
    const unsigned G = gridDim.x * gridDim.y * gridDim.z;
    unsigned sum, cnt, mine, sp = 0u;
    for (;;) {
        sum = 0u; cnt = 0u; mine = 0u;
#pragma unroll
        for (unsigned j = 0; j < 16; ++j) { const unsigned c = xb_ld(&bar[XB_XCNT(j)]); sum += c; cnt += (c > 0u) ? 1u : 0u; mine = (j == x) ? c : mine; }
        if (sum == G) break;
        __builtin_amdgcn_s_sleep(1);
        if ((++sp & 255u) == 0u) { if (xb_ld(&bar[XB_TMO])) break; if (sp > XB_SPIN_CAP) { atomicAdd(&bar[XB_TMO], 1u); break; } }
    }
    nloc = mine > 0u ? mine : 1u; nx = cnt > 0u ? cnt : 1u;
}

__device__ __forceinline__ void xcd_barrier(const XcdBarrier& b) {
    asm volatile("s_waitcnt vmcnt(0)" ::: "memory");
    __syncthreads();
    if (threadIdx.x == 0) {
        unsigned* bar = b.bar;
        __builtin_amdgcn_s_waitcnt(0);
        unsigned nloc = b.st[0], nx = b.st[1];
        if (nloc == 0u) { xcd_barrier_complete(bar, b.x, nloc, nx); b.st[0] = nloc; b.st[1] = nx; }
        const unsigned old = xb_add(&bar[XB_XSUB(b.x)], 1u);
        const unsigned gen = old / nloc;
        if (old + 1u == (gen + 1u) * nloc) {
            __builtin_amdgcn_fence(__ATOMIC_RELEASE, "agent");
            asm volatile("s_waitcnt vmcnt(0)" ::: "memory");
            const unsigned og = xb_add(&bar[XB_TOP], 1u);
            const unsigned tg = og / nx;
            if (og + 1u == (tg + 1u) * nx) xb_add(&bar[XB_TOPGEN], 1u);
            else XB_SPIN(xb_ld(&bar[XB_TOPGEN]) == tg, bar);
            __builtin_amdgcn_fence(__ATOMIC_ACQUIRE, "agent");
            xb_add(&bar[XB_XGEN(b.x)], 1u);
            asm volatile("s_waitcnt vmcnt(0)" ::: "memory");
        } else {
            XB_SPIN(xb_ld(&bar[XB_XGEN(b.x)]) == gen, bar);
            __builtin_amdgcn_fence(__ATOMIC_ACQUIRE, "agent");
            asm volatile("s_waitcnt vmcnt(0)" ::: "memory");
        }
    }
    __syncthreads();
}

constexpr size_t MiB = 1u << 20;
constexpr size_t WS_CTL = 0, CTL_ZERO_BYTES = 1 * MiB;
constexpr size_t WS_ROPE = 1 * MiB;
constexpr size_t WS_WRH = 3 * MiB;
constexpr size_t WS_BDN32 = 3 * MiB + 256 * 1024;
constexpr size_t WS_ONES = 3 * MiB + 512 * 1024;
constexpr size_t WS_GINV = 3 * MiB + 640 * 1024;
constexpr size_t WS_RINV = 3 * MiB + 768 * 1024;
constexpr size_t WS_TOPI = 4 * MiB;
constexpr size_t WS_GATE = WS_TOPI + 512 * 1024;
constexpr size_t WS_OFF = WS_GATE + 512 * 1024;
constexpr size_t WS_WIN = 8 * MiB;
constexpr size_t WS_WOUT = 14 * MiB;
constexpr size_t WS_WGU = 16 * MiB;
constexpr size_t WS_WDN = 144 * MiB;
constexpr size_t WS_XN = 208 * MiB;
constexpr size_t WS_QKV = 272 * MiB;
constexpr size_t WS_OP = 464 * MiB;
constexpr size_t WS_LSE = 560 * MiB;
constexpr size_t WS_XB = 272 * MiB;
constexpr size_t WS_ACT = 564 * MiB;
constexpr size_t WS_H16 = 836 * MiB;
constexpr size_t WS_H8 = 908 * MiB;
constexpr size_t WS_ROWTOK = 900 * MiB;
constexpr size_t WS_RSCALE = 904 * MiB;
constexpr size_t WS_MIX = 940 * MiB;
constexpr size_t WS_END = 1004 * MiB;
static_assert(WS_OFF + 512 * 1024 <= WS_WIN && WS_XB + (size_t)PMAX * 2048 <= WS_LSE + 3 * MiB && WS_LSE + 3 * MiB <= WS_ACT && WS_ACT + (size_t)PMAX * 2048 <= WS_H16, "ws map");
constexpr size_t QKV_STRIDE = (size_t)T * 512;
constexpr int CW_FILL = 64;
constexpr int CW_BAR = 4096;

constexpr int RING_OFF = 0, RING_BYTES = 131072;
constexpr int MISC_OFF = RING_BYTES;
constexpr int LDS_TSTART = MISC_OFF + 256;
constexpr int LDS_TEXP = MISC_OFF + 512;
constexpr int LDS_TCNT = MISC_OFF + 128;
constexpr int LDS_WSC = MISC_OFF + 4096;
constexpr int LDS_IDX = MISC_OFF + 8192;
constexpr int LDS_BYTES = 163840;

typedef float f32x16 __attribute__((ext_vector_type(16)));
typedef short s16x4 __attribute__((ext_vector_type(4)));
typedef unsigned u32x2 __attribute__((ext_vector_type(2)));
__device__ __forceinline__ float bflo(unsigned w) { return __builtin_bit_cast(float, w << 16); }
__device__ __forceinline__ float bfhi(unsigned w) { return __builtin_bit_cast(float, w & 0xffff0000u); }
__device__ __forceinline__ float wave_sum(float v) {
#pragma unroll
    for (int o = 1; o < 64; o <<= 1) v += __shfl_xor(v, o);
    return v;
}

struct Frame {
    LAS unsigned char* lds;
    int tid, lane, wave, vcu, G;
    const float *x, *g1, *w_in, *attn_g, *conv_w, *conv_g, *w_out, *g2, *w_r, *b_r, *w_gu, *b_gu, *w_dn, *b_dn, *gf;
    float* out; unsigned char* ws; gu32* ctl;
};

__device__ __forceinline__ void p0_transpose_item(const float* W, int K, int N, bf16* WT, int k0, int n0, int drow0, LAS float* scr, int lane, const float* kscale) {
    { const int kq = lane >> 3, n4 = lane & 7; f32x4 v[8];
#pragma unroll
      for (int i = 0; i < 8; ++i) v[i] = *(const f32x4*)(W + (size_t)(k0 + 8 * i + kq) * N + n0 + 4 * n4);
#pragma unroll
      for (int i = 0; i < 8; ++i) { LAS float* d = scr + (8 * i + kq) * 33 + 4 * n4; d[0] = v[i].x; d[1] = v[i].y; d[2] = v[i].z; d[3] = v[i].w; } }
    const int c = lane & 7;
    f32x4 s0 = {1.f, 1.f, 1.f, 1.f}, s1 = {1.f, 1.f, 1.f, 1.f};
    if (kscale) { s0 = *(const f32x4*)(kscale + k0 + 8 * c); s1 = *(const f32x4*)(kscale + k0 + 8 * c + 4); }
    LDS_WAIT(); asm volatile("" ::: "memory");
#pragma unroll
    for (int j = 0; j < 4; ++j) { const int n = (lane >> 3) + 8 * j; const LAS float* s = scr + (8 * c) * 33 + n;
        v4u o; o.x = pk2(s[0 * 33] * s0.x, s[1 * 33] * s0.y); o.y = pk2(s[2 * 33] * s0.z, s[3 * 33] * s0.w); o.z = pk2(s[4 * 33] * s1.x, s[5 * 33] * s1.y); o.w = pk2(s[6 * 33] * s1.z, s[7 * 33] * s1.w);
        *(v4u*)(WT + (size_t)(drow0 + n) * K + k0 + 8 * c) = o; }
    LDS_WAIT(); asm volatile("" ::: "memory");
}
struct Item8 { const float* W; unsigned char* WT; const float* ks; int N, k0, n0, drow; };
constexpr int ITEM_KC = 4, ITEM_PITCH = 136;
__device__ __forceinline__ void item8_load(const Item8& d, int lane, f32x4 (&v)[4 * ITEM_KC], f32x4 (&s)[ITEM_KC]) {
    const int kq = lane >> 3, n4 = lane & 7;
#pragma unroll
    for (int ci = 0; ci < ITEM_KC; ++ci) {
#pragma unroll
        for (int r = 0; r < 4; ++r) v[4 * ci + r] = __builtin_nontemporal_load((const f32x4*)(d.W + (size_t)(d.k0 + 4 * (kq + 8 * ci) + r) * d.N + d.n0 + 4 * n4));
        s[ci] = *(const f32x4*)(d.ks + d.k0 + 4 * (kq + 8 * ci));
    }
}
__device__ __forceinline__ void item8_store(const Item8& d, LAS float* scr, int lane, const f32x4 (&v)[4 * ITEM_KC], const f32x4 (&s)[ITEM_KC], float wscale) {
    const int kq = lane >> 3, n4 = lane & 7;
    LAS unsigned char* tile = (LAS unsigned char*)scr;
#pragma unroll
    for (int ci = 0; ci < ITEM_KC; ++ci) { const f32x4 sc = s[ci] * wscale;
#pragma unroll
        for (int e = 0; e < 4; ++e)
            *(LAS unsigned*)(tile + (4 * n4 + e) * ITEM_PITCH + 4 * (kq + 8 * ci)) = pg8::pk4_fp8(v[4 * ci + 0][e] * sc.x, v[4 * ci + 1][e] * sc.y, v[4 * ci + 2][e] * sc.z, v[4 * ci + 3][e] * sc.w); }
    LDS_WAIT(); asm volatile("" ::: "memory");
    const int c = lane & 7;
#pragma unroll
    for (int j = 0; j < 4; ++j) { const int n = (lane >> 3) + 8 * j; const LAS unsigned char* p = tile + n * ITEM_PITCH + 16 * c;
        const pg8::u32x2_t lo = *(const LAS pg8::u32x2_t*)p, hi = *(const LAS pg8::u32x2_t*)(p + 8);
        v4u o; o.x = lo.x; o.y = lo.y; o.z = hi.x; o.w = hi.y;
        __builtin_nontemporal_store(o, (v4u*)(d.WT + (size_t)(d.drow + n) * 1024 + d.k0 + 16 * c)); }
    LDS_WAIT(); asm volatile("" ::: "memory");
}
__device__ const double INV_FREQ_REV[32] = {
    1.0 / 6.283185307179586, 0.7498942093324559 / 6.283185307179586, 0.5623413251903491 / 6.283185307179586, 0.4216965034285822 / 6.283185307179586,
    0.31622776601683794 / 6.283185307179586, 0.23713737056616552 / 6.283185307179586, 0.1778279410038923 / 6.283185307179586, 0.1333521432163324 / 6.283185307179586,
    0.1 / 6.283185307179586, 0.07498942093324558 / 6.283185307179586, 0.05623413251903491 / 6.283185307179586, 0.042169650342858224 / 6.283185307179586,
    0.03162277660168379 / 6.283185307179586, 0.023713737056616554 / 6.283185307179586, 0.01778279410038923 / 6.283185307179586, 0.01333521432163324 / 6.283185307179586,
    0.01 / 6.283185307179586, 0.007498942093324558 / 6.283185307179586, 0.005623413251903491 / 6.283185307179586, 0.004216965034285823 / 6.283185307179586,
    0.0031622776601683794 / 6.283185307179586, 0.0023713737056616554 / 6.283185307179586, 0.0017782794100389228 / 6.283185307179586, 0.001333521432163324 / 6.283185307179586,
    0.001 / 6.283185307179586, 0.0007498942093324559 / 6.283185307179586, 0.0005623413251903491 / 6.283185307179586, 0.00042169650342858224 / 6.283185307179586,
    0.00031622776601683794 / 6.283185307179586, 0.00023713737056616554 / 6.283185307179586, 0.00017782794100389227 / 6.283185307179586, 0.0001333521432163324 / 6.283185307179586};

__device__ __forceinline__ void p0_prologue(Frame& F) {
    LAS float* scr = (LAS float*)(F.lds + RING_OFF + F.wave * 16384);
    const int gw = F.vcu * 8 + F.wave, NGW = F.G * 8;
    bf16* win_t = (bf16*)(F.ws + WS_WIN);
    constexpr int I_IN = 16 * 96, I_OUT = 16 * 32, I_GU = 16 * 64, I_DN = 16 * 32;
    constexpr int NITEMS = I_IN;
    for (int it = gw; it < NITEMS; it += NGW) {
        int r = it;
        if (r < I_IN) { const int kb = r / 96, nb = r % 96, n0 = 32 * nb; int drow = n0;
            if (n0 < 1024) { const int pn = n0 >> 8, w = n0 & 255, hh = w >> 6, bj = (w >> 5) & 1; drow = 256 * pn + 128 * bj + 32 * hh; }
            else if (n0 >= 1536 && n0 < 2048) { const int c = n0 - 1536, j = c >> 7; drow = 256 * (j < 2 ? 6 + j : 8 + j) + (c & 127); }
            else if (n0 >= 2560) { const int c = n0 - 2560, j = c >> 7; drow = 256 * (j < 2 ? 6 + j : 8 + j) + 128 + (c & 127); }
            p0_transpose_item(F.w_in, 1024, NPROJ, win_t, 64 * kb, n0, drow, scr, F.lane, nullptr); continue; }
    }
    { const int gt = F.vcu * 512 + F.tid, NGT = F.G * 512;
      float* rope = (float*)(F.ws + WS_ROPE);
      for (int i = gt; i < SEQ * 32; i += NGT) { const int pos = i >> 5, fi = i & 31; const double rev = (double)pos * INV_FREQ_REV[fi]; const float fr = (float)(rev - __builtin_rint(rev));
          rope[2 * i] = __builtin_amdgcn_cosf(fr); rope[2 * i + 1] = __builtin_amdgcn_sinf(fr); }
      float* ginv = (float*)(F.ws + WS_GINV);
      for (int i = gt; i < 1024; i += NGT) ginv[i] = 1.0f / F.g1[i];
      float* ones = (float*)(F.ws + WS_ONES);
      for (int i = gt; i < 1024; i += NGT) ones[i] = 1.0f;
      float* bdn32 = (float*)(F.ws + WS_BDN32);
      for (int i = gt; i < NE * 1024; i += NGT) bdn32[i] = 32.0f * F.b_dn[i];
      bf16* wrh = (bf16*)(F.ws + WS_WRH);
      for (int i = gt; i < NE * 1024; i += NGT) { const int e = i >> 10, k = i & 1023; const float v = F.g2[k] * F.w_r[k * NE + e]; const unsigned hi = f2bf(v); const float rem = v - __builtin_bit_cast(float, hi << 16);
          wrh[i] = (bf16)hi; wrh[NE * 1024 + i] = (bf16)f2bf(rem); }
    }
    bf16* XN = (bf16*)(F.ws + WS_XN);
    f32x4 gv[4];
#pragma unroll
    for (int j = 0; j < 4; ++j) gv[j] = ((const f32x4*)F.g1)[F.lane + 64 * j];
    for (int m = gw; m < T; m += 2 * NGW) {
        const int m2 = m + NGW; const bool two = m2 < T;
        const f32x4* xr = (const f32x4*)(F.x + (size_t)m * DM) + F.lane; const f32x4* xr2 = (const f32x4*)(F.x + (size_t)(two ? m2 : m) * DM) + F.lane;
        f32x4 v[4], v2[4]; float s2 = 0.f, t2 = 0.f;
#pragma unroll
        for (int j = 0; j < 4; ++j) { v[j] = __builtin_nontemporal_load(xr + 64 * j); v2[j] = __builtin_nontemporal_load(xr2 + 64 * j); }
#pragma unroll
        for (int j = 0; j < 4; ++j) { s2 += (v[j].x * v[j].x + v[j].y * v[j].y) + (v[j].z * v[j].z + v[j].w * v[j].w); t2 += (v2[j].x * v2[j].x + v2[j].y * v2[j].y) + (v2[j].z * v2[j].z + v2[j].w * v2[j].w); }
#pragma unroll
        for (int o = 1; o < 64; o <<= 1) { s2 += __shfl_xor(s2, o); t2 += __shfl_xor(t2, o); }
        const float rstd = 1.0f / sqrtf(s2 * (1.f / DM) + NORM_EPS), rstd2 = 1.0f / sqrtf(t2 * (1.f / DM) + NORM_EPS);
        if (F.lane == 0) { float* rinv = (float*)(F.ws + WS_RINV); rinv[m] = sqrtf(s2 * (1.f / DM) + NORM_EPS); if (two) rinv[m2] = sqrtf(t2 * (1.f / DM) + NORM_EPS); }
        if (two) {
            const int odd = F.lane & 1; bf16* rowp = XN + (size_t)(odd ? m2 : m) * DM + 4 * (F.lane & ~1);
#pragma unroll
            for (int j = 0; j < 4; ++j) {
                const unsigned a0 = pg8::cvt_pk_bf16(v[j].x * rstd * gv[j].x, v[j].y * rstd * gv[j].y), a1 = pg8::cvt_pk_bf16(v[j].z * rstd * gv[j].z, v[j].w * rstd * gv[j].w);
                const unsigned b0 = pg8::cvt_pk_bf16(v2[j].x * rstd2 * gv[j].x, v2[j].y * rstd2 * gv[j].y), b1 = pg8::cvt_pk_bf16(v2[j].z * rstd2 * gv[j].z, v2[j].w * rstd2 * gv[j].w);
                const unsigned s0 = odd ? a0 : b0, s1 = odd ? a1 : b1;
                const unsigned n0 = (unsigned)__builtin_amdgcn_mov_dpp((int)s0, 0xB1, 0xF, 0xF, true), n1 = (unsigned)__builtin_amdgcn_mov_dpp((int)s1, 0xB1, 0xF, 0xF, true);
                v4u w; if (odd) { w.x = n0; w.y = n1; w.z = b0; w.w = b1; } else { w.x = a0; w.y = a1; w.z = n0; w.w = n1; }
                *(v4u*)(rowp + 256 * j) = w; }
        } else {
            u32x2* o8 = (u32x2*)(XN + (size_t)m * DM) + F.lane;
#pragma unroll
            for (int j = 0; j < 4; ++j) { u32x2 w; w.x = pg8::cvt_pk_bf16(v[j].x * rstd * gv[j].x, v[j].y * rstd * gv[j].y); w.y = pg8::cvt_pk_bf16(v[j].z * rstd * gv[j].z, v[j].w * rstd * gv[j].w); o8[64 * j] = w; }
        }
    }
}

__device__ __forceinline__ Item8 moe_item(const Frame& F, int r) {
    constexpr int I_GU = 8 * 64, I_DN = 8 * 32;
    Item8 d;
    if (r < NE * I_GU) { const int e = r / I_GU, q = r % I_GU, kb = q / 64, nb = q % 64, n0 = 32 * nb; const int up = n0 >> 10, f = n0 & 1023;
        d.W = F.w_gu + (size_t)e * 1024 * 2048; d.WT = F.ws + WS_WGU + (size_t)e * 2048 * 1024; d.ks = F.g2; d.N = 2048; d.k0 = 128 * kb; d.n0 = n0; d.drow = 256 * (f >> 7) + 128 * up + (f & 127); }
    else if (r >= NE * (I_GU + I_DN)) { const int q = r - NE * (I_GU + I_DN), kb = q / 32, nb = q % 32;
        const int c0 = 32 * nb, wq = c0 & 255;
        d.W = F.w_out; d.WT = F.ws + WS_WOUT; d.ks = (const float*)(F.ws + WS_ONES); d.N = 1024; d.k0 = 128 * kb; d.n0 = c0; d.drow = (c0 & ~255) + 128 * ((wq >> 5) & 1) + 32 * (wq >> 6); }
    else { const int r2 = r - NE * I_GU, e = r2 / I_DN, q = r2 % I_DN, kb = q / 32, nb = q % 32;
        d.W = F.w_dn + (size_t)e * 1024 * 1024; d.WT = F.ws + WS_WDN + (size_t)e * 1024 * 1024; d.ks = (const float*)(F.ws + WS_ONES); d.N = 1024; d.k0 = 128 * kb; d.n0 = 32 * nb; d.drow = 32 * nb; }
    return d;
}
__device__ __forceinline__ void p0_moe_slice(Frame& F) {
    const float wsc = 32.0f;
    LAS float* scr = (LAS float*)(F.lds + RING_OFF + F.wave * 16384);
    constexpr int NMOE = NE * (8 * 64 + 8 * 32) + 8 * 32;
    const int per = (NMOE + F.G - 1) / F.G, lo = F.vcu * per, hi = (lo + per < NMOE) ? lo + per : NMOE;
    const int r0 = lo + F.wave;
    if (r0 >= hi) return;
    const int cnt = (hi - r0 + 7) / 8, last = r0 + 8 * (cnt - 1), pairs = (cnt + 1) / 2;
    Item8 d0 = moe_item(F, r0), d1 = d0; f32x4 va[4 * ITEM_KC], vb[4 * ITEM_KC], sa[ITEM_KC], sb[ITEM_KC];
    item8_load(d0, F.lane, va, sa);
    for (int p = 0; p < pairs; ++p) {
        const int r1 = r0 + 16 * p + 8, r2 = r0 + 16 * p + 16;
        d1 = moe_item(F, r1 < last ? r1 : last); item8_load(d1, F.lane, vb, sb);
        item8_store(d0, scr, F.lane, va, sa, wsc);
        d0 = moe_item(F, r2 < last ? r2 : last); item8_load(d0, F.lane, va, sa);
        item8_store(d1, scr, F.lane, vb, sb, wsc);
    }
}

constexpr int ATT_NSEG = BATCH * NH * 48, ATT_VREG = 0, ATT_KREG = 65536;
__device__ __forceinline__ s16x4 tr_read(const LAS unsigned char* p) { typedef short v4i16_t __attribute__((ext_vector_type(4))); return __builtin_bit_cast(s16x4, __builtin_amdgcn_ds_read_tr16_b64_v4i16((LAS v4i16_t*)p)); }
__device__ __forceinline__ float max3f(float a, float b, float c) { float r; asm("v_max3_f32 %0, %1, %2, %3" : "=v"(r) : "v"(a), "v"(b), "v"(c)); return r; }
struct AttSeg { int p, dil, n0, key; unsigned base, tok0, h; };
__device__ __forceinline__ void att_decode(int s, AttSeg& d) {
    const int bh = s / 48, ws = s % 48, j = ws & 15, b = bh >> 3, h = bh & 7; int r;
    d.p = ws >> 4;
    if (d.p == 0) { d.dil = 1; r = 0; d.n0 = 4 * j; } else if (d.p == 1) { d.dil = 4; r = j >> 2; d.n0 = 4 * (j & 3); } else { d.dil = 16; r = j; d.n0 = 0; }
    d.key = s - (d.n0 >> 2); d.tok0 = (unsigned)(b * SEQ + r); d.h = (unsigned)h; d.base = (d.tok0 * 512u + (unsigned)h * 64u) * 2u;
}

__device__ __forceinline__ void p2_attention(Frame& F) {
    const int lane = F.lane, w = __builtin_amdgcn_readfirstlane(F.wave), li = lane & 15, g = lane >> 4;
    LAS unsigned char* ring = F.lds + RING_OFF;
    const char* Qc = (const char*)(F.ws + WS_QKV); const char* Kc = Qc + QKV_STRIDE * 2; const char* Vc = Kc + QKV_STRIDE * 2;
    char* OPc = (char*)(F.ws + WS_OP); char* LSEc = (char*)(F.ws + WS_LSE);
    const int per = (ATT_NSEG + F.G - 1) / F.G;
    const int s_lo = F.vcu * per, s_hi = (s_lo + per < ATT_NSEG) ? s_lo + per : ATT_NSEG;
    if (s_lo >= s_hi) return;
    const bool xl = (F.G % 8 == 0) && (ATT_NSEG % F.G == 0);
    const int cpx = F.G / 8, xq = xl ? F.vcu / cpx : 0, xr = xl ? F.vcu % cpx : 0;
#define ATT_SEG(i_) (xl ? (xq * per * cpx + ((i_) - s_lo) * cpx + xr) : (i_))
    const int fk = li >> 1;
    const unsigned ringa = (unsigned)(unsigned long)ring;
    const unsigned ka0 = ringa + ATT_KREG + w * 2048 + li * 128 + ((g ^ fk) << 4), ka1 = ringa + ATT_KREG + w * 2048 + li * 128 + (((g + 4) ^ fk) << 4);
    const int vq = li >> 2, vp = li & 3;
    const int fv = (((2 * g + (li >> 3)) & 3) << 1);
    unsigned va[4];
#pragma unroll
    for (int d0 = 0; d0 < 4; ++d0) va[d0] = (unsigned)(unsigned long)ring + ATT_VREG + w * 2048 + (4 * g + vq) * 128 + 8 * (vp & 1) + (((2 * d0 + (vp >> 1)) ^ fv) << 4);
    unsigned drow[2], dck[2], dcv[2];
#pragma unroll
    for (int j = 0; j < 2; ++j) { const int row = 16 * w + 8 * j + (lane >> 3), ps = lane & 7; drow[j] = (unsigned)row; dck[j] = (unsigned)((ps ^ ((row >> 1) & 7)) << 4); dcv[j] = (unsigned)((ps ^ (((row >> 1) & 3) << 1)) << 4); }
    const unsigned qrow = (unsigned)(16 * w + li);
#define ATT_DMA(sd_, blk_, slot_) do { const unsigned bo_ = (sd_).base + (unsigned)(blk_) * ((unsigned)(sd_).dil << 17); const char* kg_ = Kc + bo_; const char* vg_ = Vc + bo_; \
        _Pragma("unroll") for (int j_ = 0; j_ < 2; ++j_) { const unsigned ro_ = drow[j_] * ((unsigned)(sd_).dil << 10); \
            __builtin_amdgcn_global_load_lds((const unsigned*)(kg_ + (ro_ + dck[j_])), (LAS unsigned*)(ring + ATT_KREG + (slot_) * 16384 + w * 2048 + j_ * 1024), 16, 0, 0); \
            __builtin_amdgcn_global_load_lds((const unsigned*)(vg_ + (ro_ + dcv[j_])), (LAS unsigned*)(ring + ATT_VREG + (slot_) * 16384 + w * 2048 + j_ * 1024), 16, 0, 0); } } while (0)
#define ATT_QLD(sd_, blk_, dst_) do { const char* qg_ = Qc + ((sd_).base + (unsigned)(blk_) * ((unsigned)(sd_).dil << 17)); const unsigned qo_ = qrow * ((unsigned)(sd_).dil << 10) + 16 * g; \
        dst_[0] = *(const bf16x8*)(qg_ + qo_); dst_[1] = *(const bf16x8*)(qg_ + qo_ + 64); } while (0)
#define ATT_SCV(k_) sc[(k_) >> 2][(k_) & 3]
#define ATT_WAITV(imm_) do { asm volatile("" ::: "memory"); __builtin_amdgcn_s_waitcnt(imm_); asm volatile("" ::: "memory"); } while (0)
#define ATT_BAR asm volatile("s_barrier" ::: "memory")
    AttSeg cur, nxt; att_decode(ATT_SEG(s_lo), cur);
    bf16x8 q[4][2]; v4u kr[2], vr[2];
    { const int nb0 = cur.n0 > 0 ? cur.n0 - 1 : 0; ATT_DMA(cur, nb0, 0); ATT_DMA(cur, cur.n0, 1); ATT_DMA(cur, cur.n0 + 1, 2); ATT_QLD(cur, cur.n0, q[0]); ATT_QLD(cur, cur.n0 + 1, q[1]); }
    ATT_WAITV(0x0F70); ATT_BAR;
    for (int s = s_lo; s < s_hi; ++s) {
        const int sn = (s + 1 < s_hi) ? s + 1 : s; att_decode(ATT_SEG(sn), nxt);
#pragma unroll
        for (int i = 0; i < 4; ++i) {
            if (i == 0) { ATT_DMA(cur, cur.n0 + 2, 3); ATT_QLD(cur, cur.n0 + 2, q[2]); }
            else if (i == 1) { ATT_DMA(cur, cur.n0 + 3, 0); ATT_QLD(cur, cur.n0 + 3, q[3]); }
            else if (i == 2) { ATT_DMA(nxt, nxt.n0, 1); ATT_QLD(nxt, nxt.n0, q[0]);
                { const unsigned m = nxt.n0 > 0 ? 1u : 0u, bo = (nxt.base + (unsigned)(nxt.n0 - 1) * ((unsigned)nxt.dil << 17)) * m;
#pragma unroll
                  for (int j = 0; j < 2; ++j) { const unsigned ro = drow[j] * ((unsigned)nxt.dil << 10); kr[j] = *(const v4u*)(Kc + bo + (ro + dck[j]) * m); vr[j] = *(const v4u*)(Vc + bo + (ro + dcv[j]) * m); } } }
            else { ATT_DMA(nxt, nxt.n0 + 1, 2); ATT_QLD(nxt, nxt.n0 + 1, q[1]); }
#define ATT_TOFF(kt_) ((i < 3) ? (8 * i + (kt_)) * 2048 : (((kt_) == 8 || w + (kt_) >= 8) ? ((kt_) - 8) * 2048 : (24 + (kt_)) * 2048))
            const bf16x8 qf0 = q[i][0], qf1 = q[i][1];
            f32x4 sc[9];
            v4u kf[6][2];
#define ATT_KRD(kt_) do { if (i < 3) { asm volatile("ds_read_b128 %0, %1 offset:%2" : "=v"(kf[(kt_) % 6][0]) : "v"(ka0), "i"((8 * i + (kt_)) * 2048) : "memory"); \
            asm volatile("ds_read_b128 %0, %1 offset:%2" : "=v"(kf[(kt_) % 6][1]) : "v"(ka1), "i"((8 * i + (kt_)) * 2048) : "memory"); } \
        else { const unsigned a0_ = ka0 + ATT_TOFF(kt_), a1_ = ka1 + ATT_TOFF(kt_); asm volatile("ds_read_b128 %0, %1" : "=v"(kf[(kt_) % 6][0]) : "v"(a0_) : "memory"); asm volatile("ds_read_b128 %0, %1" : "=v"(kf[(kt_) % 6][1]) : "v"(a1_) : "memory"); } } while (0)
#define ATT_KWAIT(n_, s_) asm volatile("s_waitcnt lgkmcnt(" #n_ ")" : "+v"(kf[s_][0]), "+v"(kf[s_][1]) :: "memory")
            ATT_KRD(0); ATT_KRD(1); ATT_KRD(2); ATT_KRD(3); ATT_KRD(4);
#pragma unroll
            for (int kt = 0; kt < 9; ++kt) {
                if (kt + 5 < 9) ATT_KRD(kt + 5);
                if (kt < 4) { if (kt % 6 == 0) ATT_KWAIT(10, 0); else if (kt % 6 == 1) ATT_KWAIT(10, 1); else if (kt % 6 == 2) ATT_KWAIT(10, 2); else ATT_KWAIT(10, 3); }
                else if (kt == 4) ATT_KWAIT(8, 4); else if (kt == 5) ATT_KWAIT(6, 5); else if (kt == 6) ATT_KWAIT(4, 0); else if (kt == 7) ATT_KWAIT(2, 1); else ATT_KWAIT(0, 2);
                f32x4 z = {0.f, 0.f, 0.f, 0.f};
                z = __builtin_amdgcn_mfma_f32_16x16x32_bf16(__builtin_bit_cast(bf16x8, kf[kt % 6][0]), qf0, z, 0, 0, 0);
                sc[kt] = __builtin_amdgcn_mfma_f32_16x16x32_bf16(__builtin_bit_cast(bf16x8, kf[kt % 6][1]), qf1, z, 0, 0, 0);
            }
#undef ATT_KRD
#undef ATT_KWAIT
            u32x2 xr[3][8];
#define ATT_TR(dst_, kt_, d0_) do { if (i < 3) asm volatile("ds_read_b64_tr_b16 %0, %1 offset:%2" : "=v"(dst_) : "v"(va[d0_]), "i"((8 * i + (kt_)) * 2048) : "memory"); \
        else { const unsigned ad_ = va[d0_] + ATT_TOFF(kt_); asm volatile("ds_read_b64_tr_b16 %0, %1" : "=v"(dst_) : "v"(ad_) : "memory"); } } while (0)
#define ATT_ISSUE(ks_) do { _Pragma("unroll") for (int d0 = 0; d0 < 4; ++d0) { ATT_TR(xr[(ks_) % 3][2 * d0], 2 * (ks_), d0); if ((ks_) < 4) ATT_TR(xr[(ks_) % 3][2 * d0 + 1], 2 * (ks_) + 1, d0); } } while (0)
#define ATT_WAITL(n_, s_) asm volatile("s_waitcnt lgkmcnt(" #n_ ")" : "+v"(xr[s_][0]), "+v"(xr[s_][1]), "+v"(xr[s_][2]), "+v"(xr[s_][3]), "+v"(xr[s_][4]), "+v"(xr[s_][5]), "+v"(xr[s_][6]), "+v"(xr[s_][7]) :: "memory")
            ATT_ISSUE(0); ATT_ISSUE(1);
            const float NEG = -INFINITY;
#pragma unroll
            for (int e = 0; e < 4; ++e) { const int ik = 4 * g + e; if (ik < li) sc[0][e] = NEG; if (ik > li) sc[8][e] = NEG; }
            if (i == 0 && cur.n0 == 0) {
#pragma unroll
                for (int kt = 0; kt < 8; ++kt) if (w + kt < 8) sc[kt] = (f32x4){NEG, NEG, NEG, NEG};
            }
            float mx = max3f(ATT_SCV(0), ATT_SCV(1), ATT_SCV(2));
#pragma unroll
            for (int k = 3; k < 35; k += 2) mx = max3f(mx, ATT_SCV(k), ATT_SCV(k + 1));
            mx = max3f(mx, ATT_SCV(35), ATT_SCV(35));
            { auto r16 = __builtin_amdgcn_permlane16_swap(__float_as_uint(mx), __float_as_uint(mx), false, false); mx = max3f(__uint_as_float(r16[0]), __uint_as_float(r16[1]), __uint_as_float(r16[1]));
              auto r32 = __builtin_amdgcn_permlane32_swap(__float_as_uint(mx), __float_as_uint(mx), false, false); mx = max3f(__uint_as_float(r32[0]), __uint_as_float(r32[1]), __uint_as_float(r32[1])); }
            pg8::f32x2 ls2 = {0.f, 0.f}; const pg8::f32x2 mx2 = {mx, mx};
#pragma unroll
            for (int kt = 0; kt < 9; ++kt)
#pragma unroll
                for (int hh = 0; hh < 2; ++hh) { const pg8::f32x2 d = (pg8::f32x2){sc[kt][2 * hh], sc[kt][2 * hh + 1]} - mx2; pg8::f32x2 e; e.x = __builtin_amdgcn_exp2f(d.x); e.y = __builtin_amdgcn_exp2f(d.y);
                    ls2 += e; sc[kt][2 * hh] = e.x; sc[kt][2 * hh + 1] = e.y; }
            float lsum = ls2.x + ls2.y;
            { auto r16 = __builtin_amdgcn_permlane16_swap(__float_as_uint(lsum), __float_as_uint(lsum), false, false); lsum = __uint_as_float(r16[0]) + __uint_as_float(r16[1]);
              auto r32 = __builtin_amdgcn_permlane32_swap(__float_as_uint(lsum), __float_as_uint(lsum), false, false); lsum = __uint_as_float(r32[0]) + __uint_as_float(r32[1]); }
            f32x4 oacc[4];
#pragma unroll
            for (int d0 = 0; d0 < 4; ++d0) oacc[d0] = (f32x4){0.f, 0.f, 0.f, 0.f};
#pragma unroll
            for (int ks = 0; ks < 5; ++ks) {
                v4u pw; pw.x = pg8::cvt_pk_bf16(sc[2 * ks][0], sc[2 * ks][1]); pw.y = pg8::cvt_pk_bf16(sc[2 * ks][2], sc[2 * ks][3]);
                if (ks < 4) { pw.z = pg8::cvt_pk_bf16(sc[2 * ks + 1][0], sc[2 * ks + 1][1]); pw.w = pg8::cvt_pk_bf16(sc[2 * ks + 1][2], sc[2 * ks + 1][3]); } else { pw.z = 0u; pw.w = 0u; }
                const bf16x8 pf = __builtin_bit_cast(bf16x8, pw);
                if (ks == 0) ATT_WAITL(8, 0); else if (ks == 1) ATT_WAITL(8, 1); else if (ks == 2) ATT_WAITL(8, 2); else if (ks == 3) ATT_WAITL(4, 0); else { ATT_WAITL(0, 1); xr[1][1] = xr[1][0]; xr[1][3] = xr[1][2]; xr[1][5] = xr[1][4]; xr[1][7] = xr[1][6]; }
#pragma unroll
                for (int d0 = 0; d0 < 4; ++d0) {
                    const u32x2 xa = xr[ks % 3][2 * d0], xb = xr[ks % 3][2 * d0 + 1];
                    const v4u vw = {xa.x, xa.y, xb.x, xb.y};
                    oacc[d0] = __builtin_amdgcn_mfma_f32_16x16x32_bf16(__builtin_bit_cast(bf16x8, vw), pf, oacc[d0], 0, 0, 0); }
                if (ks == 0) ATT_ISSUE(2); else if (ks == 1) ATT_ISSUE(3); else if (ks == 2) ATT_ISSUE(4);
            }
#undef ATT_TR
#undef ATT_ISSUE
#undef ATT_WAITL
#undef ATT_TOFF
            if (i == 2) ATT_WAITV(0x0F7A); else ATT_WAITV(0x0F76);
            const float inv = __builtin_amdgcn_rcpf(lsum);
            const unsigned nb = (unsigned)(cur.n0 + i) * ((unsigned)cur.dil << 17);
            char* opu = OPc + ((size_t)cur.p * T * 1024 + cur.base + nb);
            const unsigned olane = qrow * ((unsigned)cur.dil << 10) + 8 * (g & ~1) + 32 * (g & 1);
            pg8::u32x2_t ow[4];
#pragma unroll
            for (int d0 = 0; d0 < 4; ++d0) { ow[d0].x = pg8::cvt_pk_bf16(oacc[d0][0] * inv, oacc[d0][1] * inv); ow[d0].y = pg8::cvt_pk_bf16(oacc[d0][2] * inv, oacc[d0][3] * inv); }
            { const pg8::u32x4_t p0 = pg8::widen_rows16(ow[0], ow[1]), p1 = pg8::widen_rows16(ow[2], ow[3]);
              const bool lo8 = li < 8; const pg8::u32x4_t snd = lo8 ? p1 : p0; pg8::u32x4_t rcv;
              rcv.x = (unsigned)__builtin_amdgcn_mov_dpp((int)snd.x, 0x128, 0xF, 0xF, true); rcv.y = (unsigned)__builtin_amdgcn_mov_dpp((int)snd.y, 0x128, 0xF, 0xF, true);
              rcv.z = (unsigned)__builtin_amdgcn_mov_dpp((int)snd.z, 0x128, 0xF, 0xF, true); rcv.w = (unsigned)__builtin_amdgcn_mov_dpp((int)snd.w, 0x128, 0xF, 0xF, true);
              const unsigned rs8 = (unsigned)cur.dil << 13;
              char* q0 = opu + ((qrow & ~8u) * ((unsigned)cur.dil << 10) + 8 * (g & ~1) + 32 * (g & 1) + (lo8 ? 0 : 64));
              __builtin_nontemporal_store(lo8 ? p0 : rcv, (pg8::u32x4_t*)q0); __builtin_nontemporal_store(lo8 ? rcv : p1, (pg8::u32x4_t*)(q0 + rs8)); }
            if (g == 0) { char* lsu = LSEc + (((size_t)cur.p * T + cur.tok0) * 32 + 4 * cur.h + (size_t)(cur.n0 + i) * cur.dil * 4096);
                *(float*)(lsu + qrow * ((unsigned)cur.dil * 32)) = mx + __builtin_amdgcn_logf(lsum); }
            ATT_BAR;
        }
        if (nxt.n0 > 0) {
#pragma unroll
            for (int j = 0; j < 2; ++j) { const unsigned lo = drow[j] * 128 + (lane & 7) * 16;
                *(LAS v4u*)(ring + ATT_KREG + lo) = kr[j]; *(LAS v4u*)(ring + ATT_VREG + lo) = vr[j]; }
            asm volatile("s_waitcnt lgkmcnt(0)" ::: "memory"); ATT_BAR; }
        cur = nxt;
    }
    ATT_WAITV(0x0F70); ATT_BAR;
}
#undef ATT_DMA
#undef ATT_QLD
#undef ATT_SCV
#undef ATT_BAR
#undef ATT_SEG
#undef ATT_WAITV
__device__ __forceinline__ void unpack8(const v4u w, float (&f)[8]) { f[0] = bflo(w.x); f[1] = bfhi(w.x); f[2] = bflo(w.y); f[3] = bfhi(w.y); f[4] = bflo(w.z); f[5] = bfhi(w.z); f[6] = bflo(w.w); f[7] = bfhi(w.w); }
__device__ __forceinline__ void p3_merge(Frame& F) {
    const int lane = F.lane, c0 = 8 * lane, head = lane >> 3;
    const int gw = F.vcu * 8 + F.wave, NGW = F.G * 8;
    const bf16* QKV = (const bf16*)(F.ws + WS_QKV);
    const bf16* Zb = QKV + 3 * QKV_STRIDE; const bf16* Bb = QKV + 4 * QKV_STRIDE;
    const bf16* OP = (const bf16*)(F.ws + WS_OP); const float* LSE = (const float*)(F.ws + WS_LSE);
    unsigned char* MX = F.ws + WS_MIX;
    float ag[8], cg[8], w0[8], w1[8], w2[8];
#pragma unroll
    for (int j = 0; j < 8; ++j) { ag[j] = F.attn_g[c0 + j]; cg[j] = F.conv_g[c0 + j]; w0[j] = F.conv_w[c0 + j]; w1[j] = F.conv_w[512 + c0 + j]; w2[j] = F.conv_w[1024 + c0 + j]; }
    for (int run = gw; run < T / 16; run += NGW) {
        const int t0 = run * 16;
        float z1[8], z2[8];
        if ((t0 & (SEQ - 1)) != 0) { unpack8(*(const v4u*)(Zb + (size_t)(t0 - 1) * 512 + c0), z1); unpack8(*(const v4u*)(Zb + (size_t)(t0 - 2) * 512 + c0), z2); }
        else {
#pragma unroll
            for (int j = 0; j < 8; ++j) { z1[j] = 0.f; z2[j] = 0.f; }
        }
        float nl0, nl1, nl2; v4u no0, no1, no2, nz, nb;
#define P3_LOAD(t_) do { const size_t q_ = (size_t)(t_); nl0 = LSE[q_ * 8 + head]; nl1 = LSE[((size_t)T + q_) * 8 + head]; nl2 = LSE[((size_t)2 * T + q_) * 8 + head]; \
            no0 = __builtin_nontemporal_load((const v4u*)(OP + q_ * 512 + c0)); no1 = __builtin_nontemporal_load((const v4u*)(OP + ((size_t)T + q_) * 512 + c0)); no2 = __builtin_nontemporal_load((const v4u*)(OP + ((size_t)2 * T + q_) * 512 + c0)); \
            nz = __builtin_nontemporal_load((const v4u*)(Zb + q_ * 512 + c0)); nb = __builtin_nontemporal_load((const v4u*)(Bb + q_ * 512 + c0)); } while (0)
        P3_LOAD(t0);
#pragma unroll 2
        for (int tt = 0; tt < 16; ++tt) {
            const size_t t = (size_t)t0 + tt;
            const float l0 = nl0, l1 = nl1, l2 = nl2; const v4u vo0 = no0, vo1 = no1, vo2 = no2, vz = nz, vb = nb;
            if (tt + 1 < 16) P3_LOAD(t + 1);
            const float lm = fmaxf(l0, fmaxf(l1, l2));
            float e0 = __builtin_amdgcn_exp2f(l0 - lm), e1 = __builtin_amdgcn_exp2f(l1 - lm), e2 = __builtin_amdgcn_exp2f(l2 - lm);
            const float es = 1.0f / (e0 + e1 + e2); e0 *= es; e1 *= es; e2 *= es;
            float o0[8], o1[8], o2[8], at[8];
            unpack8(vo0, o0); unpack8(vo1, o1); unpack8(vo2, o2);
            float sa = 0.f;
#pragma unroll
            for (int j = 0; j < 8; ++j) { at[j] = e0 * o0[j] + e1 * o1[j] + e2 * o2[j]; sa += at[j] * at[j]; }
            float zz[8], bb[8], co[8];
            unpack8(vz, zz); unpack8(vb, bb);
            float sv = 0.f;
#pragma unroll
            for (int j = 0; j < 8; ++j) { const float z0 = zz[j]; const float cv = z2[j] * w0[j] + z1[j] * w1[j] + z0 * w2[j]; co[j] = bb[j] * cv; sv += co[j] * co[j]; z2[j] = z1[j]; z1[j] = z0; }
#pragma unroll
            for (int o = 1; o < 64; o <<= 1) { sa += __shfl_xor(sa, o); sv += __shfl_xor(sv, o); }
            const float ra = 1.0f / sqrtf(sa * (1.f / 512.f) + NORM_EPS), rc = 1.0f / sqrtf(sv * (1.f / 512.f) + NORM_EPS);
            u32x2 wa, wc;
            wa.x = pg8::pk4_fp8(at[0] * ra * ag[0], at[1] * ra * ag[1], at[2] * ra * ag[2], at[3] * ra * ag[3]); wa.y = pg8::pk4_fp8(at[4] * ra * ag[4], at[5] * ra * ag[5], at[6] * ra * ag[6], at[7] * ra * ag[7]);
            wc.x = pg8::pk4_fp8(co[0] * rc * cg[0], co[1] * rc * cg[1], co[2] * rc * cg[2], co[3] * rc * cg[3]); wc.y = pg8::pk4_fp8(co[4] * rc * cg[4], co[5] * rc * cg[5], co[6] * rc * cg[6], co[7] * rc * cg[7]);
            *(u32x2*)(MX + t * 1024 + c0) = wa; *(u32x2*)(MX + t * 1024 + 512 + c0) = wc;
        }
#undef P3_LOAD
    }
}

#define P5_LOAD(c, ra, rb) do { _Pragma("unroll") for (int i_ = 0; i_ < 4; ++i_) ra[i_] = __builtin_nontemporal_load((const v4u*)(H + (size_t)(tok0 + prow + 32 * i_) * 1024 + (c) * 128 + pcc * 8)); \
                        _Pragma("unroll") for (int i_ = 0; i_ < 2; ++i_) rb[i_] = *(const v4u*)(WRH + (size_t)(prow + 32 * i_) * 1024 + (c) * 128 + pcc * 8); } while (0)
#define P5_H8(c, ra) do { _Pragma("unroll") for (int i_ = 0; i_ < 4; ++i_) { const v4u q_ = ra[i_]; u32x2 o_; \
        o_.x = pg8::pk4_fp8(bflo(q_.x), bfhi(q_.x), bflo(q_.y), bfhi(q_.y)); o_.y = pg8::pk4_fp8(bflo(q_.z), bfhi(q_.z), bflo(q_.w), bfhi(q_.w)); \
        *(u32x2*)(H8 + (size_t)(tok0 + prow + 32 * i_) * 1024 + (c) * 128 + pcc * 8) = o_; } } while (0)
#define P5_STORE(b_, ra, rb) do { _Pragma("unroll") for (int i_ = 0; i_ < 4; ++i_) { const int row_ = prow + 32 * i_; *(LAS v4u*)(lb + (b_) * 49152 + row_ * 256 + ((pcc ^ (row_ & 15)) << 4)) = ra[i_]; } \
                          _Pragma("unroll") for (int i_ = 0; i_ < 2; ++i_) { const int row_ = prow + 32 * i_; *(LAS v4u*)(lb + (b_) * 49152 + 32768 + row_ * 256 + ((pcc ^ (row_ & 15)) << 4)) = rb[i_]; } } while (0)
__device__ __forceinline__ void p5_router(Frame& F, int cwfill) {
    const int tid = F.tid, lane = F.lane, w = F.wave, li = lane & 15, g = lane >> 4;
    const bf16* H = (const bf16*)(F.ws + WS_H16); const bf16* WRH = (const bf16*)(F.ws + WS_WRH);
    unsigned char* H8 = F.ws + WS_H8;
    int* TOPI = (int*)(F.ws + WS_TOPI); float* GATE = (float*)(F.ws + WS_GATE); int* OFF = (int*)(F.ws + WS_OFF);
    int* ROWTOK = (int*)(F.ws + WS_ROWTOK); float* RSCALE = (float*)(F.ws + WS_RSCALE);
    LAS unsigned* wsc = (LAS unsigned*)(F.lds + LDS_WSC);
    LAS unsigned char* lb = F.lds + RING_OFF;
    const int prow = tid >> 4, pcc = tid & 15;
    float br[8];
#pragma unroll
    for (int r = 0; r < 8; ++r) br[r] = F.b_r[16 * (r >> 2) + 4 * g + (r & 3)];
    for (int blk = blockIdx.x; blk < T / 128; blk += F.G) {
        const int tok0 = blk * 128, tok = tok0 + 16 * w + li;
        v4u ra0[4], rb0[2], ra1[4], rb1[2];
        P5_LOAD(0, ra0, rb0); P5_LOAD(1, ra1, rb1); P5_STORE(0, ra0, rb0); P5_H8(0, ra0);
        __syncthreads();
        f32x4 a0 = {0.f, 0.f, 0.f, 0.f}, a1 = {0.f, 0.f, 0.f, 0.f};
        float ssq = 0.f;
#pragma unroll
        for (int c = 0; c < 8; ++c) {
            if (c + 2 < 8) { if (c & 1) P5_LOAD(c + 2, ra1, rb1); else P5_LOAD(c + 2, ra0, rb0); }
            const LAS unsigned char* ab = lb + (c & 1) * 49152 + (16 * w + li) * 256;
            const LAS unsigned char* bb = lb + (c & 1) * 49152 + 32768 + li * 256;
#pragma unroll
            for (int s4 = 0; s4 < 4; ++s4) {
                const int co = (((4 * s4 + g) ^ li) << 4);
                const bf16x8 hf = *(const LAS bf16x8*)(ab + co);
                const bf16x8 w0 = *(const LAS bf16x8*)(bb + co), w1 = *(const LAS bf16x8*)(bb + 16 * 256 + co), w2 = *(const LAS bf16x8*)(bb + 32 * 256 + co), w3 = *(const LAS bf16x8*)(bb + 48 * 256 + co);
                a0 = __builtin_amdgcn_mfma_f32_16x16x32_bf16(w0, hf, a0, 0, 0, 0); a0 = __builtin_amdgcn_mfma_f32_16x16x32_bf16(w2, hf, a0, 0, 0, 0);
                a1 = __builtin_amdgcn_mfma_f32_16x16x32_bf16(w1, hf, a1, 0, 0, 0); a1 = __builtin_amdgcn_mfma_f32_16x16x32_bf16(w3, hf, a1, 0, 0, 0);
#pragma unroll
                for (int j = 0; j < 8; ++j) { const float v = __builtin_bit_cast(float, (unsigned)(unsigned short)hf[j] << 16); ssq += v * v; }
            }
            if (c + 1 < 8) { if (c & 1) { P5_STORE(0, ra0, rb0); P5_H8(c + 1, ra0); } else { P5_STORE(1, ra1, rb1); P5_H8(c + 1, ra1); } }
            __syncthreads();
        }
        ssq += __shfl_xor(ssq, 16); ssq += __shfl_xor(ssq, 32);
        const float rstd = 1.0f / sqrtf(ssq * (1.f / 1024.f) + NORM_EPS);
        float lg[8];
#pragma unroll
        for (int i = 0; i < 4; ++i) { lg[i] = a0[i] * rstd + br[i]; lg[4 + i] = a1[i] * rstd + br[4 + i]; }
        float tv[4]; int te[4];
#pragma unroll
        for (int k = 0; k < 4; ++k) {
            float bv = lg[0]; int bi = 0;
#pragma unroll
            for (int r = 1; r < 8; ++r) if (lg[r] > bv) { bv = lg[r]; bi = r; }
            int be = 16 * (bi >> 2) + 4 * g + (bi & 3);
#pragma unroll
            for (int o = 16; o <= 32; o <<= 1) { const float ov = __shfl_xor(bv, o); const int oe = __shfl_xor(be, o); const bool take = (ov > bv) || (ov == bv && oe < be); bv = take ? ov : bv; be = take ? oe : be; }
            tv[k] = bv; te[k] = be;
            const int own_r = 4 * (be >> 4) + (be & 3); const bool own = (((be >> 2) & 3) == g);
#pragma unroll
            for (int r = 0; r < 8; ++r) if (own && r == own_r) lg[r] = -INFINITY;
        }
        const float e1 = __builtin_amdgcn_exp2f((tv[1] - tv[0]) * 1.4426950408889634f), e2 = __builtin_amdgcn_exp2f((tv[2] - tv[0]) * 1.4426950408889634f), e3 = __builtin_amdgcn_exp2f((tv[3] - tv[0]) * 1.4426950408889634f);
        const float gs = 1.0f / (1.0f + e1 + e2 + e3);
        if (tid < 32) wsc[tid] = 0u;
        __syncthreads();
        unsigned rk[4] = {0u, 0u, 0u, 0u};
        if (lane < 16) {
#pragma unroll
            for (int k = 0; k < 4; ++k) rk[k] = __hip_atomic_fetch_add(&wsc[te[k]], 1u, __ATOMIC_RELAXED, __HIP_MEMORY_SCOPE_WORKGROUP);
        }
        __syncthreads();
        if (tid < 32) { const unsigned c = wsc[tid]; unsigned base = 0u; if (c) base = __hip_atomic_fetch_add(F.ctl + cwfill + 64 * tid, c, __ATOMIC_RELAXED, __HIP_MEMORY_SCOPE_AGENT); wsc[32 + tid] = base; }
        __syncthreads();
        if (lane < 16) {
            typedef int i32x4 __attribute__((ext_vector_type(4)));
            i32x4 o; o.x = (int)(wsc[32 + te[0]] + rk[0]); o.y = (int)(wsc[32 + te[1]] + rk[1]); o.z = (int)(wsc[32 + te[2]] + rk[2]); o.w = (int)(wsc[32 + te[3]] + rk[3]);
            *(i32x4*)(OFF + (size_t)tok * 4) = o;
            *(i32x4*)(TOPI + (size_t)tok * 4) = (i32x4){te[0], te[1], te[2], te[3]};
            *(f32x4*)(GATE + (size_t)tok * 4) = (f32x4){gs, e1 * gs, e2 * gs, e3 * gs};
            ROWTOK[(size_t)te[0] * T + o.x] = tok; ROWTOK[(size_t)te[1] * T + o.y] = tok; ROWTOK[(size_t)te[2] * T + o.z] = tok; ROWTOK[(size_t)te[3] * T + o.w] = tok;
            RSCALE[(size_t)te[0] * T + o.x] = rstd; RSCALE[(size_t)te[1] * T + o.y] = rstd; RSCALE[(size_t)te[2] * T + o.z] = rstd; RSCALE[(size_t)te[3] * T + o.w] = rstd;
        }
        __syncthreads();
    }
}
#undef P5_LOAD
#undef P5_STORE
#undef P5_H8

__device__ __forceinline__ int build_tiles(Frame& F) {
    LAS int* tstart = (LAS int*)(F.lds + LDS_TSTART); LAS int* texp = (LAS int*)(F.lds + LDS_TEXP); LAS int* tcnt = (LAS int*)(F.lds + LDS_TCNT);
    __syncthreads();
    if (F.tid < 64) {
        const int e = F.tid & 31;
        const unsigned c = __hip_atomic_load(F.ctl + CW_FILL + 64 * e, __ATOMIC_RELAXED, __HIP_MEMORY_SCOPE_AGENT);
        const int nt = (int)((c + 255u) >> 8);
        int inc = nt;
#pragma unroll
        for (int o = 1; o < 32; o <<= 1) { const int v = __shfl_up(inc, o, 32); if (e >= o) inc += v; }
        if (F.tid < 32) { tcnt[e] = (int)c; tstart[e] = inc - nt; if (e == 31) tstart[32] = inc; }
    }
    __syncthreads();
    if (F.tid < NE) { const int a = tstart[F.tid], b = tstart[F.tid + 1]; for (int t = a; t < b; ++t) texp[t] = F.tid; }
    __syncthreads();
    return tstart[NE];
}
__device__ __forceinline__ void build_idx(Frame& F, const pg8::MoeOrder& S, unsigned pitch) {
    LAS unsigned* idxtab = (LAS unsigned*)(F.lds + LDS_IDX);
    LAS int* udesc = (LAS int*)(F.lds + LDS_WSC);
    const LAS int* tstart = (const LAS int*)(F.lds + LDS_TSTART); const LAS int* tcnt = (const LAS int*)(F.lds + LDS_TCNT);
    const int* ROWTOK = (const int*)(F.ws + WS_ROWTOK);
    if (F.tid < 24) { pg8::Unit u; const bool ok = S.next(F.tid, u); const int e = ok ? (u.pn >> 3) : -1; udesc[2 * F.tid] = e; udesc[2 * F.tid + 1] = ok ? 256 * (u.pm - tstart[e]) : 0; }
    __syncthreads();
#pragma unroll
    for (int i = 0; i < 12; ++i) { const int idx = i * 512 + F.tid, ui = idx >> 8, row = idx & 255; const int e = udesc[2 * ui];
        if (e >= 0) { const int lr = udesc[2 * ui + 1] + row; const int tok = (lr < tcnt[e]) ? ROWTOK[(size_t)e * T + lr] : 0; idxtab[idx] = (unsigned)tok * pitch; } }
    __syncthreads();
}

__device__ __forceinline__ void unpack8_fp8(const pg8::u32x2_t w, float (&f)[8]) {
    typedef float f32x2_ __attribute__((ext_vector_type(2)));
    const f32x2_ a = __builtin_amdgcn_cvt_pk_f32_fp8((int)w.x, false), b = __builtin_amdgcn_cvt_pk_f32_fp8((int)w.x, true), c = __builtin_amdgcn_cvt_pk_f32_fp8((int)w.y, false), d = __builtin_amdgcn_cvt_pk_f32_fp8((int)w.y, true);
    f[0] = a.x; f[1] = a.y; f[2] = b.x; f[3] = b.y; f[4] = c.x; f[5] = c.y; f[6] = d.x; f[7] = d.y;
}
__device__ __forceinline__ void p9_combine(Frame& F, float* outp) {
    if (N_LAUNCHES != 1) build_tiles(F);
    const LAS int* tstart = (const LAS int*)(F.lds + LDS_TSTART);
    const int lane = F.lane, gw = F.vcu * 8 + F.wave, NGW = F.G * 8;
    const int* TOPI = (const int*)(F.ws + WS_TOPI); const int* OFF = (const int*)(F.ws + WS_OFF); const float* GATE = (const float*)(F.ws + WS_GATE); const unsigned char* YB = F.ws + WS_XB;
    const bf16* H = (const bf16*)(F.ws + WS_H16);
    f32x4 gg[2][2];
#pragma unroll
    for (int j = 0; j < 2; ++j) { gg[j][0] = *(const f32x4*)(F.gf + 512 * j + 8 * lane); gg[j][1] = *(const f32x4*)(F.gf + 512 * j + 8 * lane + 4); }
    typedef int i32x4 __attribute__((ext_vector_type(4)));
    for (int tok0 = gw; tok0 < T; tok0 += 2 * NGW) {
        int tk[2]; tk[0] = tok0; tk[1] = (tok0 + NGW < T) ? tok0 + NGW : tok0;
        i32x4 d[2]; f32x4 gt[2]; v4u hw[2][2]; pg8::u32x2_t yw[2][2][4];
#pragma unroll
        for (int q = 0; q < 2; ++q) { const int tok = tk[q];
            const i32x4 te = *(const i32x4*)(TOPI + (size_t)tok * 4), of = *(const i32x4*)(OFF + (size_t)tok * 4); gt[q] = *(const f32x4*)(GATE + (size_t)tok * 4) * 0.125f;
            d[q].x = 256 * tstart[te.x] + of.x; d[q].y = 256 * tstart[te.y] + of.y; d[q].z = 256 * tstart[te.z] + of.z; d[q].w = 256 * tstart[te.w] + of.w; }
#pragma unroll
        for (int q = 0; q < 2; ++q)
#pragma unroll
            for (int j = 0; j < 2; ++j) { const size_t co = 512 * j + 8 * lane;
                hw[q][j] = __builtin_nontemporal_load((const v4u*)(H + (size_t)tk[q] * 1024 + co));
                yw[q][j][0] = __builtin_nontemporal_load((const pg8::u32x2_t*)(YB + (size_t)d[q].x * 1024 + co)); yw[q][j][1] = __builtin_nontemporal_load((const pg8::u32x2_t*)(YB + (size_t)d[q].y * 1024 + co));
                yw[q][j][2] = __builtin_nontemporal_load((const pg8::u32x2_t*)(YB + (size_t)d[q].z * 1024 + co)); yw[q][j][3] = __builtin_nontemporal_load((const pg8::u32x2_t*)(YB + (size_t)d[q].w * 1024 + co)); }
#pragma unroll
        for (int q = 0; q < 2; ++q) {
            if (q == 1 && tk[1] == tk[0]) break;
            float hv[2][8]; float ssq = 0.f;
#pragma unroll
            for (int j = 0; j < 2; ++j) {
                float h8[8], y0[8], y1[8], y2[8], y3[8];
                unpack8(hw[q][j], h8); unpack8_fp8(yw[q][j][0], y0); unpack8_fp8(yw[q][j][1], y1); unpack8_fp8(yw[q][j][2], y2); unpack8_fp8(yw[q][j][3], y3);
#pragma unroll
                for (int i = 0; i < 8; ++i) { const float v = h8[i] + (gt[q].x * y0[i] + gt[q].y * y1[i]) + (gt[q].z * y2[i] + gt[q].w * y3[i]); hv[j][i] = v; ssq += v * v; } }
            const float rstd = 1.0f / sqrtf(wave_sum(ssq) * (1.f / 1024.f) + NORM_EPS);
            LAS float* sc = (LAS float*)(F.lds + RING_OFF + F.wave * 16384) + q * 1024;
#pragma unroll
            for (int j = 0; j < 2; ++j) {
                f32x4 a, b; a.x = hv[j][0] * rstd * gg[j][0].x; a.y = hv[j][1] * rstd * gg[j][0].y; a.z = hv[j][2] * rstd * gg[j][0].z; a.w = hv[j][3] * rstd * gg[j][0].w;
                b.x = hv[j][4] * rstd * gg[j][1].x; b.y = hv[j][5] * rstd * gg[j][1].y; b.z = hv[j][6] * rstd * gg[j][1].z; b.w = hv[j][7] * rstd * gg[j][1].w;
                *(LAS f32x4*)(sc + 512 * j + 8 * lane) = a; *(LAS f32x4*)(sc + 512 * j + 8 * lane + 4) = b; }
            asm volatile("s_waitcnt lgkmcnt(0)" ::: "memory");
#pragma unroll
            for (int k = 0; k < 4; ++k) { const f32x4 o = *(const LAS f32x4*)(sc + 256 * k + 4 * lane); __builtin_nontemporal_store(o, (f32x4*)(outp + (size_t)tk[q] * 1024 + 256 * k + 4 * lane)); }
        }
    }
}

constexpr int PER_PHASE = 10;
struct Args { const float* in[15]; float* out; unsigned char* ws; int ph_lo, ph_hi; };
__global__ void __launch_bounds__(512, 2) hyb_fwd(Args args) {
    extern __shared__ __attribute__((aligned(16))) unsigned char lds[];
    Frame F;
    F.lds = (LAS unsigned char*)lds;
    F.tid = threadIdx.x; F.lane = F.tid & 63; F.wave = __builtin_amdgcn_readfirstlane(F.tid >> 6);
    F.G = gridDim.x; { const int bx = blockIdx.x; F.vcu = (F.G % 8 == 0) ? (bx % 8) * (F.G / 8) + bx / 8 : bx; }
    F.x = args.in[0]; F.g1 = args.in[1]; F.w_in = args.in[2]; F.attn_g = args.in[3]; F.conv_w = args.in[4]; F.conv_g = args.in[5]; F.w_out = args.in[6]; F.g2 = args.in[7];
    F.w_r = args.in[8]; F.b_r = args.in[9]; F.w_gu = args.in[10]; F.b_gu = args.in[11]; F.w_dn = args.in[12]; F.b_dn = args.in[13]; F.gf = args.in[14];
    F.out = args.out; F.ws = args.ws; F.ctl = (gu32*)(args.ws + WS_CTL);
    for (int u = F.tid; u < (LDS_BYTES - MISC_OFF) / 4; u += 512) ((LAS unsigned*)(F.lds + MISC_OFF))[u] = 0u;
    __syncthreads();
    XcdBarrier bar; bar.bar = (unsigned*)(F.ctl + CW_BAR); bar.x = 0; bar.st = nullptr;
    if (N_LAUNCHES == 1) bar = xcd_barrier_post((unsigned*)(F.ctl + CW_BAR), (volatile LAS unsigned*)(F.lds + MISC_OFF + 32));
    const int lo = args.ph_lo, hi = args.ph_hi;
#define IN(k) (lo <= (k) && (k) < hi)
#define SEAM(k) do { if (IN(k) && IN((k) + 1)) { xcd_barrier(bar); } } while (0)

    if (IN(0)) { p0_prologue(F); SEAM(0); }
    if (IN(1)) {
        pg8::Gemm g{(const pg8::bf16_t*)(F.ws + WS_XN), (const pg8::bf16_t*)(F.ws + WS_WIN), T, NPROJ, DM}; pg8::StaticOrder S; S.init(T, NPROJ, F.G, (int)blockIdx.x);
        pg8::EpiQKV E{(pg8::bf16_t*)(F.ws + WS_QKV), (const float*)(F.ws + WS_ROPE), QKV_STRIDE};
        { const int nun = (S.nwg > (int)blockIdx.x) ? (S.nwg - (int)blockIdx.x + F.G - 1) / F.G : 0, kcut = (int)blockIdx.x % (nun + 1);
          pg8::RangeOrder R0{S, 0, kcut}, R1{S, kcut, nun};
          pg8::gemm_phase<pg8::EpiQKV, pg8::RangeOrder, true, true>(F.lds + RING_OFF, g, R0, E);
          __syncthreads();
          p0_moe_slice(F);
          __syncthreads();
          pg8::gemm_phase<pg8::EpiQKV, pg8::RangeOrder, true, true>(F.lds + RING_OFF, g, R1, E); }
        SEAM(1);
    }
    if (IN(2)) { p2_attention(F); SEAM(2); }
    if (IN(3)) { p3_merge(F); SEAM(3); }
    if (IN(4)) {
        pg8::StaticOrder S; S.init(T, DM, F.G, (int)blockIdx.x);
        pg8::EpiRes8 E{(const pg8::bf16_t*)(F.ws + WS_XN), (const float*)(F.ws + WS_RINV), (const float*)(F.ws + WS_GINV), (pg8::bf16_t*)(F.ws + WS_H16), F.ws + WS_H8};
        pg8::gemm_phase2<pg8::EpiRes8, pg8::StaticOrder, false, true, 122>(F.lds + RING_OFF, F.ws + WS_MIX, F.ws + WS_WOUT, 1024, 1024, 8, S, E, nullptr, F.lds + LDS_IDX + 20480);
        SEAM(4);
    }
    if (IN(5)) { p5_router(F, CW_FILL); if (IN(7)) xcd_barrier(bar); }
    if (IN(7)) {
        const int ntiles = build_tiles(F);
        pg8::MoeOrder S; S.init(ntiles, 8, F.G, (int)blockIdx.x, (const LAS int*)(F.lds + LDS_TEXP));
        build_idx(F, S, 1024u);
        pg8::EpiSwiGLU E{F.ws + WS_ACT, F.b_gu, (const float*)(F.ws + WS_RSCALE), (const LAS int*)(F.lds + LDS_TSTART)};
        pg8::gemm_phase2<pg8::EpiSwiGLU, pg8::MoeOrder, true, true, 122>(F.lds + RING_OFF, F.ws + WS_H8, F.ws + WS_WGU, 1024, 1024, 8, S, E, (const LAS unsigned*)(F.lds + LDS_IDX), F.lds + LDS_IDX + 20480);
        SEAM(7);
    }
    if (IN(8)) {
        const int ntiles = (N_LAUNCHES != 1) ? build_tiles(F) : ((const LAS int*)(F.lds + LDS_TSTART))[NE];
        pg8::MoeOrder S; S.init(ntiles, 4, F.G, (int)blockIdx.x, (const LAS int*)(F.lds + LDS_TEXP));
        pg8::EpiOut8 E{F.ws + WS_XB, (const float*)(F.ws + WS_BDN32)};
        pg8::gemm_phase2<pg8::EpiOut8, pg8::MoeOrder, false, true, 122>(F.lds + RING_OFF, F.ws + WS_ACT, F.ws + WS_WDN, 1024, 1024, 8, S, E, nullptr, F.lds + LDS_IDX + 20480);
        SEAM(8);
    }
    if (IN(9)) { p9_combine(F, F.out); }
#undef IN
#undef SEAM
}

extern "C" void kernel_launch(void* const* d_in, const int* in_sizes, int n_in, void* d_out, int out_size, void* d_ws, size_t ws_size, hipStream_t stream) {
    static int grid = 0;
    if (grid == 0) {
        if (n_in != 15 || in_sizes[0] != T * DM || out_size != T * DM || ws_size < WS_END) { fprintf(stderr, "kernel_launch: unexpected shapes/workspace (n_in %d, ws %zu)\n", n_in, ws_size); grid = -1; return; }
        int dev = 0, cus = 0, per_cu = 0;
        if (hipGetDevice(&dev) != hipSuccess || hipDeviceGetAttribute(&cus, hipDeviceAttributeMultiprocessorCount, dev) != hipSuccess) { grid = -1; return; }
        if (hipFuncSetAttribute((const void*)hyb_fwd, hipFuncAttributeMaxDynamicSharedMemorySize, LDS_BYTES) != hipSuccess) { fprintf(stderr, "kernel_launch: hipFuncSetAttribute failed\n"); grid = -1; return; }
        if (hipOccupancyMaxActiveBlocksPerMultiprocessor(&per_cu, (const void*)hyb_fwd, 512, LDS_BYTES) != hipSuccess || per_cu < 1) { fprintf(stderr, "kernel_launch: occupancy query says %d\n", per_cu); per_cu = 1; }
        (void)hipGetLastError();
        grid = cus;
    }
    if (grid < 0) return;
    if (hipMemsetAsync((char*)d_ws + WS_CTL, 0, CTL_ZERO_BYTES, stream) != hipSuccess) { fprintf(stderr, "kernel_launch: memset failed\n"); return; }
    Args a{};
    for (int i = 0; i < 15; ++i) a.in[i] = (const float*)d_in[i];
    a.out = (float*)d_out; a.ws = (unsigned char*)d_ws;
    if (N_LAUNCHES == 1) {
        a.ph_lo = 0; a.ph_hi = PER_PHASE;
        void* kargs[] = {&a};
        const hipError_t le = hipLaunchCooperativeKernel((const void*)hyb_fwd, dim3(grid), dim3(512), kargs, LDS_BYTES, stream);
        if (le != hipSuccess) fprintf(stderr, "kernel_launch: cooperative launch failed: %s (grid %d)\n", hipGetErrorName(le), grid);
    } else {
        for (int li = 0; li < PER_PHASE; ++li) {
            a.ph_lo = li; a.ph_hi = li + 1;
            hipLaunchKernelGGL(hyb_fwd, dim3(grid), dim3(512), LDS_BYTES, stream, a);
        }
    }
}
```
